# Optimizing an MI355X kernel written in HIP

```python
import jax, jax.numpy as jnp
from jax import lax
import numpy as np

D_MODEL = 1024
BATCH = 8
SEQ = 2048
DEPTH = 4

N_MIXERS = 2
N_LAYERS_A = (DEPTH + 1) // 2
N_LAYERS_B = DEPTH // 2
FOX_HEADS = 16
FOX_HEAD_DIM = D_MODEL // FOX_HEADS
Q_BLOCK = 128
FOX_IN = 4 * D_MODEL + FOX_HEADS
RET_HEADS = 4
RET_QK_DIM = D_MODEL // RET_HEADS
RET_V_DIM = 2 * D_MODEL // RET_HEADS
RET_CHUNK = 128
RET_IN = 2 * RET_HEADS * RET_QK_DIM + 2 * RET_HEADS * RET_V_DIM
N_GROUPS = 4
EXPERTS_PER_GROUP = 8
N_EXPERTS = N_GROUPS * EXPERTS_PER_GROUP
TOP_K = 2
EXPERT_FF = D_MODEL // 2
MOE_BLOCK = 128

EPS = 1e-6
NEG_INF = -1e30
ROPE_BASE = 10000.0

kernel_name = "fox_retnet_hier_moe_trunk"

F32 = jnp.float32


def rms_norm(x, g):
    xf = x.astype(F32)
    y = xf * lax.rsqrt(jnp.mean(xf * xf, axis=-1, keepdims=True) + EPS)
    return (y * g.astype(F32)).astype(x.dtype)


def forgetting_attention(h, w_in, b_f, w_out):
    B, S, _ = h.shape
    H, dh = FOX_HEADS, FOX_HEAD_DIM
    proj = h @ w_in
    q, k, v, gate = jnp.split(proj[..., :4 * D_MODEL], 4, axis=-1)
    f_logit = (proj[..., 4 * D_MODEL:] + b_f).astype(F32)
    cum = jnp.cumsum(jax.nn.log_sigmoid(f_logit), axis=1).transpose(0, 2, 1)
    heads = lambda t: t.reshape(B, S, H, dh).transpose(0, 2, 1, 3)
    q, k, v = heads(q), heads(k), heads(v)
    scale = dh ** -0.5
    k_pos = jnp.arange(S)

    def query_block(i):
        start = i * Q_BLOCK
        q_b = lax.dynamic_slice_in_dim(q, start, Q_BLOCK, axis=2)
        c_b = lax.dynamic_slice_in_dim(cum, start, Q_BLOCK, axis=2)
        s = jnp.einsum('bhqd,bhkd->bhqk', q_b, k).astype(F32) * scale
        s = s + c_b[..., :, None] - cum[..., None, :]
        q_pos = start + jnp.arange(Q_BLOCK)
        s = jnp.where(k_pos[None, :] <= q_pos[:, None], s, NEG_INF)
        p = jax.nn.softmax(s, axis=-1)
        return jnp.einsum('bhqk,bhkd->bhqd', p.astype(v.dtype), v)

    o = lax.map(query_block, jnp.arange(S // Q_BLOCK))
    o = o.transpose(1, 0, 3, 2, 4).reshape(B, S, D_MODEL)
    o = o * jax.nn.sigmoid(gate)
    return o @ w_out


def rotary(t, pos):
    d = t.shape[-1]
    inv = 1.0 / (ROPE_BASE ** jnp.linspace(0.0, 1.0, d // 2, dtype=F32))
    ang = pos.astype(F32)[:, None] * inv[None, :]
    cos, sin = jnp.cos(ang), jnp.sin(ang)
    t1, t2 = t[..., :d // 2].astype(F32), t[..., d // 2:].astype(F32)
    return jnp.concatenate([t1 * cos - t2 * sin, t1 * sin + t2 * cos], axis=-1)


def retention(h, w_in, gn_gain, w_out):
    B, S, _ = h.shape
    H, dk, dv, C = RET_HEADS, RET_QK_DIM, RET_V_DIM, RET_CHUNK
    proj = h @ w_in
    q, k, v, gate = jnp.split(proj, [H * dk, 2 * H * dk, 2 * H * dk + H * dv], axis=-1)
    heads = lambda t, d: t.reshape(B, S, H, d).transpose(0, 2, 1, 3)
    pos = jnp.arange(S)
    q = rotary(heads(q, dk), pos)
    k = rotary(heads(k, dk), pos) * (dk ** -0.5)
    v = heads(v, dv).astype(F32)

    log_g = jnp.log(1.0 - 2.0 ** (-5.0 - jnp.arange(H, dtype=F32)))
    idx = jnp.arange(C, dtype=F32)
    rel = idx[:, None] - idx[None, :]
    intra = jnp.where(rel >= 0, jnp.exp(log_g[:, None, None] * jnp.maximum(rel, 0.0)), 0.0)
    q_decay = jnp.exp(log_g[:, None] * (idx + 1.0))[None, :, :, None]
    k_decay = jnp.exp(log_g[:, None] * (C - 1.0 - idx))[None, :, :, None]
    chunk_decay = jnp.exp(log_g * C)[None, :, None, None]

    n_chunks = S // C
    to_chunks = lambda t: t.reshape(B, H, n_chunks, C, t.shape[-1]).transpose(2, 0, 1, 3, 4)

    def step(R, qkv):
        q_n, k_n, v_n = qkv
        s = jnp.einsum('bhid,bhjd->bhij', q_n, k_n) * intra
        o = jnp.einsum('bhij,bhje->bhie', s, v_n)
        o = o + jnp.einsum('bhid,bhde->bhie', q_n, R) * q_decay
        R = R * chunk_decay + jnp.einsum('bhjd,bhje->bhde', k_n * k_decay, v_n)
        return R, o

    R0 = jnp.zeros((B, H, dk, dv), F32)
    _, o = lax.scan(step, R0, (to_chunks(q), to_chunks(k), to_chunks(v)))
    o = o.transpose(1, 0, 3, 2, 4).reshape(B, S, H, dv)
    mu = jnp.mean(o, axis=-1, keepdims=True)
    var = jnp.mean(jnp.square(o - mu), axis=-1, keepdims=True)
    o = ((o - mu) * lax.rsqrt(var + EPS)).reshape(B, S, H * dv) * gn_gain.astype(F32)
    o = jax.nn.silu(gate.astype(F32)) * o
    return o.astype(h.dtype) @ w_out


def grouped_experts(xf, expert_id, gates, w_gu, w_down):
    T, D = xf.shape
    A = T * TOP_K
    flat_e = expert_id.reshape(A)
    order = jnp.argsort(flat_e)
    sorted_e = flat_e[order]
    counts = jnp.bincount(flat_e, length=N_EXPERTS)
    padded = (counts + MOE_BLOCK - 1) // MOE_BLOCK * MOE_BLOCK
    pad_end = jnp.cumsum(padded)
    pad_start = pad_end - padded
    start = jnp.cumsum(counts) - counts
    dest = pad_start[sorted_e] + jnp.arange(A) - start[sorted_e]
    n_blocks = (A + N_EXPERTS * (MOE_BLOCK - 1) + MOE_BLOCK - 1) // MOE_BLOCK
    n_rows = n_blocks * MOE_BLOCK
    tok_sorted = (order // TOP_K).astype(jnp.int32)
    row_tok = jnp.full((n_rows,), T, jnp.int32).at[dest].set(tok_sorted)
    x_pad = jnp.concatenate([xf, jnp.zeros((1, D), xf.dtype)], axis=0)
    x_rows = x_pad[row_tok].reshape(n_blocks, MOE_BLOCK, D)
    block_e = jnp.minimum(jnp.searchsorted(pad_end, jnp.arange(n_blocks) * MOE_BLOCK, side='right'),
                          N_EXPERTS - 1)

    def expert_block(args):
        xb, e = args
        a, b = jnp.split(xb @ w_gu[e], 2, axis=-1)
        return (jax.nn.silu(a) * b) @ w_down[e]

    y_rows = lax.map(expert_block, (x_rows, block_e)).reshape(n_rows, D)
    w_sorted = gates.reshape(A)[order].astype(y_rows.dtype)
    return jax.ops.segment_sum(y_rows[dest] * w_sorted[:, None], tok_sorted, num_segments=T)


def hier_moe(h, wr_g, br_g, wr_e, br_e, w_gu, w_down):
    B, S, D = h.shape
    T = B * S
    xf = h.reshape(T, D)
    p_group = jax.nn.softmax((xf @ wr_g).astype(F32) + br_g.astype(F32), axis=-1)
    pg, gi = lax.top_k(p_group, 1)
    e_logits = ((xf @ wr_e).astype(F32) + br_e.astype(F32)).reshape(T, N_GROUPS, EXPERTS_PER_GROUP)
    e_in = jnp.einsum('tge,tg->te', e_logits, jax.nn.one_hot(gi[:, 0], N_GROUPS, dtype=F32))
    pv, pi = lax.top_k(jax.nn.softmax(e_in, axis=-1), TOP_K)
    gates = pg * pv / jnp.sum(pv, axis=-1, keepdims=True)
    expert_id = gi * EXPERTS_PER_GROUP + pi
    return grouped_experts(xf, expert_id, gates, w_gu, w_down).reshape(B, S, D)


def setup_inputs(seed: int = 0) -> dict:
    key = jax.random.key(seed)
    ks = jax.random.split(key, 17)
    nrm = lambda k, shape, fan_in: jax.random.normal(k, shape, F32) * (fan_in ** -0.5)
    out_scale = (2.0 * DEPTH) ** -0.5
    return {
        "x": jax.random.normal(ks[0], (BATCH, SEQ, D_MODEL), F32),
        "fox_w_in": nrm(ks[1], (N_LAYERS_A, D_MODEL, FOX_IN), D_MODEL),
        "fox_b_f": 3.0 + 0.5 * jax.random.normal(ks[2], (N_LAYERS_A, FOX_HEADS), F32),
        "fox_w_out": nrm(ks[3], (N_LAYERS_A, D_MODEL, D_MODEL), D_MODEL) * out_scale,
        "ret_w_in": nrm(ks[4], (N_LAYERS_B, D_MODEL, RET_IN), D_MODEL),
        "ret_gn_gain": 1.0 + 0.02 * jax.random.normal(ks[5], (N_LAYERS_B, RET_HEADS * RET_V_DIM), F32),
        "ret_w_out": nrm(ks[6], (N_LAYERS_B, RET_HEADS * RET_V_DIM, D_MODEL), RET_HEADS * RET_V_DIM) * out_scale,
        "norm_mix": 1.0 + 0.02 * jax.random.normal(ks[7], (DEPTH, D_MODEL), F32),
        "norm_ffn": 1.0 + 0.02 * jax.random.normal(ks[8], (DEPTH, D_MODEL), F32),
        "router_group_w": nrm(ks[9], (DEPTH, D_MODEL, N_GROUPS), D_MODEL),
        "router_group_b": 0.01 * jax.random.normal(ks[10], (DEPTH, N_GROUPS), F32),
        "router_expert_w": nrm(ks[11], (DEPTH, D_MODEL, N_EXPERTS), D_MODEL),
        "router_expert_b": 0.01 * jax.random.normal(ks[12], (DEPTH, N_EXPERTS), F32),
        "expert_w_gu": nrm(ks[13], (DEPTH, N_EXPERTS, D_MODEL, 2 * EXPERT_FF), D_MODEL),
        "expert_w_down": nrm(ks[14], (DEPTH, N_EXPERTS, EXPERT_FF, D_MODEL), EXPERT_FF) * out_scale,
        "norm_final": 1.0 + 0.02 * jax.random.normal(ks[15], (D_MODEL,), F32),
    }


def reference(x, fox_w_in, fox_b_f, fox_w_out, ret_w_in, ret_gn_gain, ret_w_out,
              norm_mix, norm_ffn, router_group_w, router_group_b, router_expert_w,
              router_expert_b, expert_w_gu, expert_w_down, norm_final):
    h = x
    for i in range(DEPTH):
        hn = rms_norm(h, norm_mix[i])
        j = i // N_MIXERS
        if i % N_MIXERS == 0:
            h = h + forgetting_attention(hn, fox_w_in[j], fox_b_f[j], fox_w_out[j])
        else:
            h = h + retention(hn, ret_w_in[j], ret_gn_gain[j], ret_w_out[j])
        hn = rms_norm(h, norm_ffn[i])
        h = h + hier_moe(hn, router_group_w[i], router_group_b[i], router_expert_w[i],
                         router_expert_b[i], expert_w_gu[i], expert_w_down[i])
    return rms_norm(h, norm_final)
```

```cpp
#include <hip/hip_runtime.h>
#include <cstdio>
#include <cstdint>
#include <cmath>
#define LAS __attribute__((address_space(3)))
#define GAS __attribute__((address_space(1)))
typedef _Float16 h16;
typedef _Float16 f16x8 __attribute__((ext_vector_type(8)));
typedef _Float16 f16x4 __attribute__((ext_vector_type(4)));
typedef _Float16 f16x2 __attribute__((ext_vector_type(2)));
typedef float f32x2 __attribute__((ext_vector_type(2)));
typedef float f32x4 __attribute__((ext_vector_type(4)));
typedef float f32x16 __attribute__((ext_vector_type(16)));
typedef unsigned u32x2 __attribute__((ext_vector_type(2)));
typedef unsigned u32x4 __attribute__((ext_vector_type(4)));
typedef short s16x4 __attribute__((ext_vector_type(4)));
__device__ __forceinline__ unsigned pk2h(float lo, float hi) { f32x2 v = {lo, hi}; f16x2 b = __builtin_convertvector(v, f16x2); return __builtin_bit_cast(unsigned, b); }

constexpr int DM = 1024, BATCH = 8, SEQ = 2048, DEPTH = 4, T = BATCH * SEQ;
constexpr int FOX_H = 16, FOX_D = 64, FOX_IN = 4 * DM + FOX_H;
constexpr int RET_H = 4, RET_DK = 256, RET_DV = 512, RET_IN = 6144;
constexpr int NG = 4, EPG = 8, NE = 32, EFF = 512;
constexpr int PAIRS = T * 2;
constexpr int LISTCAP = 16384;
constexpr int PROWS = PAIRS + NE * 256;
constexpr float EPS = 1e-6f;
constexpr float LOG2E = 1.4426950408889634f;

namespace pg8 {
constexpr int BM = 256, BK = 64, HALF = 128, HTB = HALF * BK * 2, STAGE_BYTES = 8 * HTB, NXCD = 8, WGM = 8;
__host__ __device__ __forceinline__ int lds_byte(int r, int c) { const int st = (r >> 4) * 2 + (c >> 5), rr = r & 15, cc = c & 31, ob = rr * 64 + cc * 2; return st * 1024 + (ob ^ (((ob >> 9) & 1) << 5)); }
__host__ __device__ __forceinline__ void stage_rc(int b, int& R, int& C) { const int st = b / 1024, sb = b % 1024, swz = sb ^ (((sb >> 9) & 1) << 5); R = (st >> 1) * 16 + swz / 64; C = (st & 1) * 32 + (swz % 64) / 2; }
__host__ __device__ __forceinline__ int perm32(int rho) { const int n = rho >> 4, i = rho & 15; return 8 * (i >> 2) + 4 * n + (i & 3); }

struct Unit { int pm, pn, e, mt; };

struct StaticOrder {
    int nM, nN, nwg, G, c, K; const char* A; const char* Bt;
    __device__ void init(const void* A_, const void* Bt_, int M, int N, int K_, int G_, int c_) { A = (const char*)A_; Bt = (const char*)Bt_; K = K_; nM = M / BM; nN = N / BM; nwg = nM * nN; G = G_; c = c_; }
    __device__ bool next(int i, Unit& u) const {
        const long L = (long)i * G + c; if (L >= nwg) return false;
        int wgid = (int)L; { const int q = nwg / NXCD, r = nwg % NXCD, xcd = wgid % NXCD, off = wgid / NXCD; wgid = (xcd < r ? xcd * (q + 1) : r * (q + 1) + (xcd - r) * q) + off; }
        const int nig = WGM * nN, gid = wgid / nig, fm = gid * WGM, gsz = (nM - fm) < WGM ? (nM - fm) : WGM;
        u.pm = fm + ((wgid % nig) % gsz); u.pn = (wgid % nig) / gsz; u.e = 0; u.mt = 0; return true;
    }
    __device__ __forceinline__ const char* abase() const { return A; }
    __device__ __forceinline__ void aoff(const Unit& u, const int (&R)[2], const int (&C)[2], unsigned (&ao)[2][2]) const {
#pragma unroll
        for (int h = 0; h < 2; ++h)
#pragma unroll
            for (int i = 0; i < 2; ++i) ao[h][i] = (unsigned)(((size_t)(u.pm * BM + h * HALF + R[i]) * K + C[i]) * 2);
    }
    __device__ __forceinline__ const char* bbase(const Unit& u) const { return Bt + (size_t)u.pn * BM * K * 2; }
};

#define PG8_WAIT_V(n) asm volatile("s_waitcnt vmcnt(" #n ")" ::: "memory")
#define PG8_WAIT_L(n) asm volatile("s_waitcnt lgkmcnt(" #n ")" ::: "memory")
#define PG8_BAR __builtin_amdgcn_s_barrier()
#define PG8_SCHED __builtin_amdgcn_sched_barrier(0)

template <class Epi, class Sched, bool ALIGN_EPI>
__device__ __forceinline__ void gemm_phase(LAS unsigned char* lds, const int K, const Sched& S, const Epi& E, const int tid) {
    const int wid = __builtin_amdgcn_readfirstlane(tid >> 6), lane = tid & 63, wr = wid >> 2, wc = wid & 3, fr = lane & 15, fq = lane >> 4;
    const int nt = K / BK;
    int Rr[2], Cc[2]; unsigned voffB[2];
#pragma unroll
    for (int i = 0; i < 2; ++i) { int R, C; stage_rc(tid * 16 + i * 8192, R, C); Rr[i] = R; Cc[i] = C; const int Rb = Epi::PERM ? ((R & ~31) + perm32(R & 31)) : R; voffB[i] = (unsigned)(Rb * K + C) * 2u; }
    const size_t kstep = (size_t)(BK * 2);
    const size_t hstep = (size_t)HALF * K * 2;
    const unsigned ldsw = (unsigned)wid * 1024u;
    const int aoff_l = lds_byte(wr * 64 + fr, fq * 8), boff_l = lds_byte(wc * 32 + fr, fq * 8);
    const char* const gA = S.abase();
#define PG8_SA(b, h) (((b) * 2 + (h)) * HTB)
#define PG8_SB(b, h) ((4 + (b) * 2 + (h)) * HTB)
#define PG8_STAGE(bufoff, gbase, voff) do { _Pragma("unroll") for (int _i = 0; _i < 2; ++_i) \
        __builtin_amdgcn_global_load_lds((const unsigned*)((const char*)(gbase) + (voff)[_i]), (LAS unsigned*)(lds + (bufoff) + ldsw + _i * 8192), 16, 0, 0); } while (0)
#define PG8_STAGEA(bufoff, o0, o1, kb) do { \
        __builtin_amdgcn_global_load_lds((const unsigned*)((gA + (kb)) + (o0)), (LAS unsigned*)(lds + (bufoff) + ldsw), 16, 0, 0); \
        __builtin_amdgcn_global_load_lds((const unsigned*)((gA + (kb)) + (o1)), (LAS unsigned*)(lds + (bufoff) + ldsw + 8192), 16, 0, 0); } while (0)
#define PG8_LDA(dst, b, h) do { _Pragma("unroll") for (int m = 0; m < 4; ++m) _Pragma("unroll") for (int k = 0; k < 2; ++k) dst[m][k] = *(const LAS f16x8*)(lds + PG8_SA(b, h) + aoff_l + m * 2048 + k * 1024); } while (0)
#define PG8_LDB(dst, b, h) do { _Pragma("unroll") for (int n = 0; n < 2; ++n) _Pragma("unroll") for (int k = 0; k < 2; ++k) dst[n][k] = *(const LAS f16x8*)(lds + PG8_SB(b, h) + boff_l + n * 2048 + k * 1024); } while (0)
#define PG8_MMA(ai, bj, At, Bt) do { __builtin_amdgcn_s_setprio(1); _Pragma("unroll") for (int m = 0; m < 4; ++m) _Pragma("unroll") for (int n = 0; n < 2; ++n) _Pragma("unroll") for (int k = 0; k < 2; ++k) \
        acc[ai][bj][m][n] = __builtin_amdgcn_mfma_f32_16x16x32_f16(Bt[n][k], At[m][k], acc[ai][bj][m][n], 0, 0, 0); __builtin_amdgcn_s_setprio(0); } while (0)
    Unit cur, nxt; int ui = 0;
    if (!S.next(0, cur)) return;
    f32x4 acc[2][2][4][2];
#pragma unroll
    for (int a = 0; a < 2; ++a)
#pragma unroll
        for (int b = 0; b < 2; ++b)
#pragma unroll
            for (int m = 0; m < 4; ++m)
#pragma unroll
                for (int n = 0; n < 2; ++n) acc[a][b][m][n] = (f32x4){0.f, 0.f, 0.f, 0.f};
    f16x8 At[4][2], B0[2][2], B1[2][2];
    unsigned aoC[2][2], aoN[2][2];
    S.aoff(cur, Rr, Cc, aoC);
    const char* cB = S.bbase(cur);
    PG8_STAGE(PG8_SB(0, 0), cB, voffB); PG8_STAGE(PG8_SB(0, 1), cB + hstep, voffB); PG8_STAGEA(PG8_SA(0, 0), aoC[0][0], aoC[0][1], 0); PG8_STAGEA(PG8_SA(0, 1), aoC[1][0], aoC[1][1], 0);
    if (wr == 1) PG8_BAR;
    PG8_WAIT_V(2); PG8_BAR;
    PG8_STAGE(PG8_SB(1, 0), cB + kstep, voffB); PG8_STAGEA(PG8_SA(1, 0), aoC[0][0], aoC[0][1], kstep); PG8_STAGE(PG8_SB(1, 1), cB + hstep + kstep, voffB);
    PG8_WAIT_V(6); PG8_BAR;
    for (;;) {
        const bool has_next = S.next(ui + 1, nxt);
        const char* nB = cB;
#pragma unroll
        for (int h = 0; h < 2; ++h)
#pragma unroll
            for (int i = 0; i < 2; ++i) aoN[h][i] = aoC[h][i];
        if (has_next) { S.aoff(nxt, Rr, Cc, aoN); nB = S.bbase(nxt); }
        for (int t = 0; t < nt; t += 2) {
            const bool last = (t == nt - 2);
            const size_t k1 = (size_t)(t + 1) * kstep;
            const size_t k2 = last ? 0 : (size_t)(t + 2) * kstep, k3 = k2 + kstep;
            const unsigned a2_00 = last ? aoN[0][0] : aoC[0][0], a2_01 = last ? aoN[0][1] : aoC[0][1], a2_10 = last ? aoN[1][0] : aoC[1][0], a2_11 = last ? aoN[1][1] : aoC[1][1];
            const char* b2 = (last ? nB : cB) + k2; const char* b3 = b2 + kstep;
            PG8_LDB(B0, 0, 0); PG8_LDB(B1, 0, 1); PG8_SCHED; PG8_LDA(At, 0, 0); PG8_STAGEA(PG8_SA(1, 1), aoC[1][0], aoC[1][1], k1);
            PG8_WAIT_V(8); PG8_WAIT_L(0); PG8_BAR; PG8_MMA(0, 0, At, B0); PG8_MMA(0, 1, At, B1); PG8_BAR; PG8_SCHED;
            PG8_LDA(At, 0, 1); PG8_STAGE(PG8_SB(0, 0), b2, voffB); PG8_STAGE(PG8_SB(0, 1), b2 + hstep, voffB); PG8_STAGEA(PG8_SA(0, 0), a2_00, a2_01, k2);
            PG8_WAIT_V(8); PG8_WAIT_L(0); PG8_BAR; PG8_MMA(1, 0, At, B0); PG8_MMA(1, 1, At, B1); PG8_BAR; PG8_SCHED;
            PG8_LDB(B0, 1, 0); PG8_LDB(B1, 1, 1); PG8_SCHED; PG8_LDA(At, 1, 0); PG8_STAGEA(PG8_SA(0, 1), a2_10, a2_11, k2);
            PG8_WAIT_V(8); PG8_WAIT_L(0); PG8_BAR; PG8_MMA(0, 0, At, B0); PG8_MMA(0, 1, At, B1); PG8_BAR; PG8_SCHED;
            PG8_LDA(At, 1, 1); PG8_STAGE(PG8_SB(1, 0), b3, voffB); PG8_STAGE(PG8_SB(1, 1), b3 + hstep, voffB); PG8_STAGEA(PG8_SA(1, 0), a2_00, a2_01, k3);
            PG8_WAIT_V(8); PG8_WAIT_L(0); PG8_BAR; PG8_MMA(1, 0, At, B0); PG8_MMA(1, 1, At, B1); PG8_BAR; PG8_SCHED;
        }
        if constexpr (ALIGN_EPI) { if (wr == 0) PG8_BAR; }
        E(acc, cur, wr, wc, fr, fq);
        if (!has_next) break;
#pragma unroll
        for (int a = 0; a < 2; ++a)
#pragma unroll
            for (int b = 0; b < 2; ++b)
#pragma unroll
                for (int m = 0; m < 4; ++m)
#pragma unroll
                    for (int n = 0; n < 2; ++n) acc[a][b][m][n] = (f32x4){0.f, 0.f, 0.f, 0.f};
        cur = nxt; cB = nB; ++ui;
#pragma unroll
        for (int h = 0; h < 2; ++h)
#pragma unroll
            for (int i = 0; i < 2; ++i) aoC[h][i] = aoN[h][i];
        if constexpr (ALIGN_EPI) { if (wr == 1) PG8_BAR; }
    }
    PG8_WAIT_V(0);
    if constexpr (!ALIGN_EPI) { if (wr == 0) PG8_BAR; }
    PG8_BAR;
#undef PG8_SA
#undef PG8_SB
#undef PG8_STAGE
#undef PG8_STAGEA
#undef PG8_LDA
#undef PG8_LDB
#undef PG8_MMA
}

struct EpiH16 {
    static constexpr bool PERM = true;
    h16* O; int ldc; int split_cols; size_t split_stride; const float* rstd; float scale0, scale1; int rot; const float* ct; const float* st;
    __device__ __forceinline__ void operator()(const f32x4 (&acc)[2][2][4][2], const Unit& u, int wr, int wc, int fr, int fq) const {
        const int row0 = u.pm * BM + wr * 64 + fr; int colt = u.pn * BM; h16* base = O;
        const int t = colt / split_cols; base += (size_t)t * split_stride; colt -= t * split_cols;
        const float sc = (t == 0) ? scale0 : ((t == 1) ? scale1 : 1.f);
        const int col0 = colt + wc * 32 + 8 * fq;
        const bool dorot = rot && (t < 2);
#pragma unroll
        for (int ai = 0; ai < 2; ++ai)
#pragma unroll
            for (int m = 0; m < 4; ++m) {
                const int row = row0 + ai * HALF + m * 16; const float rs = rstd[row] * sc;
                h16* rowp = base + (size_t)row * ldc + col0;
                if (dorot) {
                    const int pos = row & (SEQ - 1); const int d0 = wc * 32 + 8 * fq;
                    const f32x4 c0 = *(const f32x4*)(ct + pos * 128 + d0), c1 = *(const f32x4*)(ct + pos * 128 + d0 + 4);
                    const f32x4 s0 = *(const f32x4*)(st + pos * 128 + d0), s1 = *(const f32x4*)(st + pos * 128 + d0 + 4);
                    const f32x4 a0 = acc[ai][0][m][0] * rs, a1 = acc[ai][0][m][1] * rs, b0 = acc[ai][1][m][0] * rs, b1 = acc[ai][1][m][1] * rs;
                    const f32x4 o10 = a0 * c0 - b0 * s0, o11 = a1 * c1 - b1 * s1, o20 = a0 * s0 + b0 * c0, o21 = a1 * s1 + b1 * c1;
                    u32x4 w; w.x = pk2h(o10[0], o10[1]); w.y = pk2h(o10[2], o10[3]); w.z = pk2h(o11[0], o11[1]); w.w = pk2h(o11[2], o11[3]);
                    *(u32x4*)(rowp) = w;
                    w.x = pk2h(o20[0], o20[1]); w.y = pk2h(o20[2], o20[3]); w.z = pk2h(o21[0], o21[1]); w.w = pk2h(o21[2], o21[3]);
                    *(u32x4*)(rowp + HALF) = w;
                } else {
#pragma unroll
                    for (int bj = 0; bj < 2; ++bj) { const f32x4 v0 = acc[ai][bj][m][0] * rs, v1 = acc[ai][bj][m][1] * rs;
                        u32x4 w; w.x = pk2h(v0[0], v0[1]); w.y = pk2h(v0[2], v0[3]); w.z = pk2h(v1[0], v1[1]); w.w = pk2h(v1[2], v1[3]);
                        *(u32x4*)(rowp + bj * HALF) = w; }
                }
            }
    }
};
struct EpiResid {
    static constexpr bool PERM = false;
    float* H; int ldc;
    __device__ __forceinline__ void operator()(const f32x4 (&acc)[2][2][4][2], const Unit& u, int wr, int wc, int fr, int fq) const {
        const int col0 = u.pn * BM + wc * 32 + 4 * fq, row0 = u.pm * BM + wr * 64 + fr;
#pragma unroll
        for (int ai = 0; ai < 2; ++ai)
#pragma unroll
            for (int m = 0; m < 4; ++m) { float* rp = H + (size_t)(row0 + ai * HALF + m * 16) * ldc + col0;
#pragma unroll
                for (int bj = 0; bj < 2; ++bj)
#pragma unroll
                    for (int n = 0; n < 2; ++n) { f32x4* p = (f32x4*)(rp + bj * HALF + n * 16); *p = *p + acc[ai][bj][m][n]; } }
    }
};
struct EpiStoreF32 {
    static constexpr bool PERM = false;
    float* Y; int ldc;
    __device__ __forceinline__ void operator()(const f32x4 (&acc)[2][2][4][2], const Unit& u, int wr, int wc, int fr, int fq) const {
        const int col0 = u.pn * BM + wc * 32 + 4 * fq, row0 = u.pm * BM + wr * 64 + fr;
#pragma unroll
        for (int ai = 0; ai < 2; ++ai)
#pragma unroll
            for (int m = 0; m < 4; ++m) { float* rp = Y + (size_t)(row0 + ai * HALF + m * 16) * ldc + col0;
#pragma unroll
                for (int bj = 0; bj < 2; ++bj)
#pragma unroll
                    for (int n = 0; n < 2; ++n) *(f32x4*)(rp + bj * HALF + n * 16) = acc[ai][bj][m][n]; }
    }
};
struct EpiSwiGLU {
    static constexpr bool PERM = true;
    h16* ACT; const float* rstd; const int* list; const int* cnt;
    __device__ __forceinline__ void operator()(const f32x4 (&acc)[2][2][4][2], const Unit& u, int wr, int wc, int fr, int fq) const {
        const int row0 = u.pm * BM + wr * 64 + fr, rank0 = u.mt * BM + wr * 64 + fr; const int c = cnt[u.e];
        const int col0 = u.pn * 128 + wc * 16 + 4 * fq;
#pragma unroll
        for (int ai = 0; ai < 2; ++ai)
#pragma unroll
            for (int m = 0; m < 4; ++m) {
                const int rank = rank0 + ai * HALF + m * 16; float rs = 0.f;
                if (rank < c) rs = rstd[list[u.e * LISTCAP + rank] >> 1];
                h16* rowp = ACT + (size_t)(row0 + ai * HALF + m * 16) * EFF + col0;
#pragma unroll
                for (int bj = 0; bj < 2; ++bj) { const f32x4 a = acc[ai][bj][m][0] * rs, b = acc[ai][bj][m][1] * rs; f32x4 o;
#pragma unroll
                    for (int q = 0; q < 4; ++q) o[q] = a[q] * __builtin_amdgcn_rcpf(1.0f + __builtin_amdgcn_exp2f(-a[q] * LOG2E)) * b[q];
                    u32x2 w; w.x = pk2h(o[0], o[1]); w.y = pk2h(o[2], o[3]); *(u32x2*)(rowp + bj * 64) = w; }
            }
    }
};
}
namespace attn_body {
constexpr int D = 64, DMP = 1024;
constexpr int NW = 8, QBLK = 32, QB = QBLK * NW, KVBLK = 64, NQB = SEQ / QB;
__device__ __forceinline__ int crow(int r, int hi) { return (r & 3) + 8 * (r >> 2) + 4 * hi; }
#define SBAR() __builtin_amdgcn_sched_barrier(0)
__device__ __forceinline__ void cmask(f32x16& p0, f32x16& p1, int jb, int qrel, int hi) {
    const float NEG = -INFINITY; int kb = 64 * jb + 4 * hi;
#pragma unroll
    for (int r = 0; r < 16; ++r) { int kv = kb + (r & 3) + 8 * (r >> 2); if (kv > qrel) p0[r] = NEG; if (kv + 32 > qrel) p1[r] = NEG; }
}
constexpr int NSLOT = 3, SLOTB = 8192;
constexpr int LDS_K = 0, LDS_V = NSLOT * SLOTB, LDS_WS = 2 * NSLOT * SLOTB, LDS_OST = LDS_WS + NW * 64 * 4, LDS_BIAS = LDS_OST + NW * 4096, LDS_BYTES = LDS_BIAS + SEQ * 4;
constexpr float C2 = 0.125f * LOG2E;
__device__ __forceinline__ void glds16(const void* gsrc, unsigned lds_dst) { unsigned keep;
    asm volatile("s_mov_b32 %0, m0\n\ts_mov_b32 m0, %2\n\ts_nop 0\n\tglobal_load_lds_dwordx4 %1, off\n\ts_mov_b32 m0, %0" : "=&s"(keep) : "v"(gsrc), "s"(lds_dst) : "memory"); }
__device__ __forceinline__ float max3f(float a, float b, float c) { float r; asm("v_max3_f32 %0, %1, %2, %3" : "=v"(r) : "v"(a), "v"(b), "v"(c)); return r; }
__device__ __forceinline__ float max2f(float a, float b) { float r; asm("v_max_f32_e32 %0, %1, %2" : "=v"(r) : "v"(a), "v"(b)); return r; }
__device__ __forceinline__ float fadd_s(float a, float b) { float r; asm("v_add_f32_e32 %0, %1, %2" : "=v"(r) : "v"(a), "v"(b)); return r; }
__device__ __forceinline__ float fsub_s(float a, float b) { float r; asm("v_sub_f32_e32 %0, %1, %2" : "=v"(r) : "v"(a), "v"(b)); return r; }
__device__ __forceinline__ unsigned split_hl(float v) { const h16 hi = (h16)v; const h16 lo = (h16)(v - (float)hi); return (unsigned)__builtin_bit_cast(unsigned short, hi) | ((unsigned)__builtin_bit_cast(unsigned short, lo) << 16); }
#define WAIT_BAR(N) asm volatile("s_waitcnt vmcnt(" #N ") lgkmcnt(0)\n\ts_barrier" ::: "memory")
#define MF16(a, b, c) __builtin_amdgcn_mfma_f32_32x32x16_f16(a, b, c, 0, 0, 0)
typedef LAS const char* lds_cptr;
typedef short v4i16_t __attribute__((ext_vector_type(4)));
__device__ __forceinline__ void kload8(f16x8* kf, lds_cptr kp) {
    kf[0] = *(const LAS f16x8*)(kp);        kf[1] = *(const LAS f16x8*)(kp + 512);
    kf[2] = *(const LAS f16x8*)(kp + 2048); kf[3] = *(const LAS f16x8*)(kp + 2560);
    kf[4] = *(const LAS f16x8*)(kp + 4096); kf[5] = *(const LAS f16x8*)(kp + 4608);
    kf[6] = *(const LAS f16x8*)(kp + 6144); kf[7] = *(const LAS f16x8*)(kp + 6656);
}
__device__ __forceinline__ void kload2(f16x8* kf, lds_cptr kp, int j) { kf[2 * j] = *(const LAS f16x8*)(kp + j * 2048); kf[2 * j + 1] = *(const LAS f16x8*)(kp + j * 2048 + 512); }
__device__ __forceinline__ s16x4 vtr(lds_cptr p) { return __builtin_bit_cast(s16x4, __builtin_amdgcn_ds_read_tr16_b64_v4i16((LAS v4i16_t*)p)); }
__device__ __forceinline__ f16x8 mk8(s16x4 lo, s16x4 hi) { typedef short s16x8 __attribute__((ext_vector_type(8))); s16x8 t = {lo[0], lo[1], lo[2], lo[3], hi[0], hi[1], hi[2], hi[3]}; return __builtin_bit_cast(f16x8, t); }
__device__ __forceinline__ f16x4 ext_frag(unsigned w0, unsigned w1) { u32x2 t = {w0, w1}; return __builtin_bit_cast(f16x4, t); }
#define MF8(a, b, c) __builtin_amdgcn_mfma_f32_32x32x8f16(a, b, c, 0, 0, 0)
__device__ __forceinline__ float rowmax(const f32x16& p0, const f32x16& p1) {
    float a = max3f(p0[0], p0[1], p1[0]), b = max3f(p0[2], p0[3], p1[1]); a = max3f(a, p1[2], p1[3]);
#pragma unroll
    for (int r = 4; r < 16; r += 4) { a = max3f(a, p0[r], p0[r + 1]); b = max3f(b, p0[r + 2], p0[r + 3]); a = max3f(a, p1[r], p1[r + 1]); b = max3f(b, p1[r + 2], p1[r + 3]); }
    const float m = max2f(a, b);
    auto rr = __builtin_amdgcn_permlane32_swap(__float_as_uint(m), __float_as_uint(m), false, false);
    return max2f(__uint_as_float(rr[0]), __uint_as_float(rr[1]));
}
__device__ __forceinline__ void qkt(f32x16& p0, f32x16& p1, const char* Kslot, const f16x8* qr, f16x4 kb0, f16x4 kb1, f16x4 qe, int r32, int hi) {
    const char* kb = Kslot + hi * 1024 + r32 * 16;
    const f32x16 z = {};
    p0 = MF8(kb0, qe, z); p1 = MF8(kb1, qe, z);
#pragma unroll
    for (int d0 = 0; d0 < 4; ++d0) {
        const f16x8 b0 = *reinterpret_cast<const f16x8*>(kb + d0 * 2048);
        const f16x8 b1 = *reinterpret_cast<const f16x8*>(kb + d0 * 2048 + 512);
        p0 = MF16(b0, qr[d0], p0); p1 = MF16(b1, qr[d0], p1); }
}
__device__ __forceinline__ void pv(f32x16* o, int vb, f16x8 pa0, f16x8 pa1, f16x8 pa2, f16x8 pa3) {
#pragma unroll
    for (int d0 = 0; d0 < 2; ++d0) { s16x4 lo[4], hi[4];
#pragma unroll
        for (int ks = 0; ks < 4; ++ks) {
            asm volatile("ds_read_b64_tr_b16 %0,%1 offset:%c2" : "=&v"(lo[ks]) : "v"(vb), "i"(d0 * 4096 + ks * 1024) : "memory");
            asm volatile("ds_read_b64_tr_b16 %0,%1 offset:%c2" : "=&v"(hi[ks]) : "v"(vb), "i"(d0 * 4096 + ks * 1024 + 512) : "memory"); }
        asm volatile("s_waitcnt lgkmcnt(0)" ::: "memory"); SBAR();
        o[d0] = MF16(pa0, mk8(lo[0], hi[0]), o[d0]);
        o[d0] = MF16(pa1, mk8(lo[1], hi[1]), o[d0]);
        o[d0] = MF16(pa2, mk8(lo[2], hi[2]), o[d0]);
        o[d0] = MF16(pa3, mk8(lo[3], hi[3]), o[d0]);
    }
}
#define ATTN_ONES 0x3C003C00u
template <int THRL> __device__ __forceinline__ void attn_unit(int b, int h, int qb, const h16* Q, const h16* __restrict__ K, const h16* __restrict__ V, const h16* __restrict__ G, const float* __restrict__ cum, h16* O, char* shm, const int tid) {
    const int lane = tid & 63, r32 = lane & 31, hi = lane >> 5; const int wid = __builtin_amdgcn_readfirstlane(tid >> 6);
    const long rowbase = (long)b * SEQ; const int q0 = qb * QB;
    const h16* Qw = Q + (rowbase + q0 + wid * QBLK) * DMP + h * D;
    const h16* Kh = K + rowbase * DMP + h * D, *Vh = V + rowbase * DMP + h * D;
    const unsigned lds0 = (unsigned)(uintptr_t)shm;
    float* wsf = (float*)(shm + LDS_WS) + wid * 64;
    const h16* ksrc = Kh + (long)lane * DMP + wid * 8;
    const h16* vsrc = Vh + (long)(16 * (wid & 3) + (lane >> 2)) * DMP + (wid >> 2) * 32 + (lane & 3) * 8;
    const unsigned kdst = lds0 + LDS_K + wid * 1024, vdst = lds0 + LDS_V + wid * 1024;
#define DMA_K(t, slot) glds16(ksrc + (long)(t) * KVBLK * DMP, (unsigned)__builtin_amdgcn_readfirstlane(kdst + (slot)))
#define DMA_V(t, slot) glds16(vsrc + (long)(t) * KVBLK * DMP, (unsigned)__builtin_amdgcn_readfirstlane(vdst + (slot)))
    const int vb0 = (int)(lds0 + LDS_V) + ((lane >> 4) & 1) * 32 + (lane & 3) * 8 + (4 * hi + ((lane & 15) >> 2)) * 64;
    const char* Kbase = shm + LDS_K; f16x8 kf[8];
    const lds_cptr shm3 = (lds_cptr)shm; const lds_cptr kp0 = shm3 + LDS_K + hi * 1024 + r32 * 16; const lds_cptr vp0 = shm3 + LDS_V + ((lane >> 4) & 1) * 32 + (lane & 3) * 8 + (4 * hi + ((lane & 15) >> 2)) * 64;
    const LAS unsigned* biasw = (const LAS unsigned*)(shm3 + LDS_BIAS);
    const int NT = (q0 + QB) / KVBLK;
    DMA_K(0, 0); DMA_V(0, 0); DMA_K(1, SLOTB);
    { const float* cb = cum + (long)(b * FOX_H + h) * SEQ; const float cref = cb[q0];
      LAS unsigned* bw = (LAS unsigned*)(shm3 + LDS_BIAS);
      for (int j = tid; j < q0 + QB; j += NW * 64) bw[j] = split_hl(fmaxf((cref - cb[j]) * LOG2E, -30000.f)); }
    f16x8 qr[4];
#pragma unroll
    for (int d0 = 0; d0 < 4; ++d0) qr[d0] = *reinterpret_cast<const f16x8*>(&Qw[(long)r32 * DMP + d0 * 16 + hi * 8]);
    float mhat = 0.f, l_reg = 0.f; f32x16 o[2]; o[0] = f32x16{}; o[1] = f32x16{};
    unsigned qew1 = 0u;
    const unsigned qew0 = hi ? 0u : ATTN_ONES, kew1 = hi ? 0u : ATTN_ONES;
#define QE() ext_frag(qew0, qew1)
#define KE(w) ext_frag(hi ? 0u : (w), kew1)
#define SETM() do { qew1 = hi ? 0u : split_hl(-mhat); } while (0)
    const int qrel = wid * QBLK + r32;
#define CMASK(P0, P1, t) do { int jb_ = (t) - (NT - 4); if (jb_ >= 0) cmask(P0, P1, jb_, qrel, hi); } while (0)
    bool resc = false;
#define START(P0, P1) do { const float rm = rowmax(P0, P1); resc = false; \
    { const float dl = rm; mhat = fadd_s(mhat, dl); \
      _Pragma("unroll") for (int r = 0; r < 16; ++r) { P0[r] = fsub_s(P0[r], dl); P1[r] = fsub_s(P1[r], dl); } \
      SETM(); } \
    _Pragma("unroll") for (int r = 0; r < 16; ++r) P0[r] = __builtin_amdgcn_exp2f(P0[r]); } while (0)
#define RESC() do { if (resc) { asm volatile("s_waitcnt lgkmcnt(0)" ::: "memory"); \
      _Pragma("unroll") for (int d_ = 0; d_ < 2; ++d_) _Pragma("unroll") for (int r = 0; r < 16; ++r) o[d_][r] *= wsf[crow(r, hi)]; } } while (0)
    f32x16 pA0, pA1, pB0, pB1;
    int sl_prev = 0, sl_cur = 0, sl_next = SLOTB;
#define ROT() do { sl_prev = sl_cur; sl_cur = sl_next; sl_next = (sl_next == (NSLOT - 1) * SLOTB) ? 0 : sl_next + SLOTB; } while (0)
    DMA_K(2, 2 * SLOTB);
    WAIT_BAR(3);
    unsigned bw0 = biasw[r32], bw1 = biasw[32 + r32];
    qkt(pA0, pA1, Kbase, qr, KE(bw0), KE(bw1), QE(), r32, hi); asm volatile("s_nop 15\n\ts_nop 7" : "+v"(pA0), "+v"(pA1)); CMASK(pA0, pA1, 0);
    START(pA0, pA1);
    _Pragma("unroll") for (int r = 0; r < 16; ++r) pA1[r] = __builtin_amdgcn_exp2f(pA1[r]);
    WAIT_BAR(0);
    DMA_K(3, 0); DMA_V(1, SLOTB);
    ROT();
    kload8(kf, kp0 + sl_cur);
    bw0 = biasw[64 + r32]; bw1 = biasw[96 + r32];
    WAIT_BAR(2);
    s16x4 vlo[8], vhi[8]; u32x4 pw0, pw1, pw2, pw3;
#define PKW(P, B) pk2h(P[B], P[B + 1])
#define PAF(k) __builtin_bit_cast(f16x8, pw##k)
#define VFR(i) mk8(vlo[i], vhi[i])
#define PIN(x) asm volatile("" : "+v"(x))
#define MX3(a, b, c) __builtin_fmaxf(__builtin_fmaxf((a), (b)), (c))
#define GAPA(MF, A0, A1, A2, A3, W0, W1, PW) do { MF; sacc += A0; sacc += A1; sacc += A2; sacc += A3; PIN(sacc); W0; W1; PIN(PW); SBAR(); } while (0)
#define EX(v) __builtin_amdgcn_exp2f(v)
#define GAPB(MF, X, B) do { MF; X[B] = EX(X[B]); X[B + 1] = EX(X[B + 1]); X[B + 2] = EX(X[B + 2]); X[B + 3] = EX(X[B + 3]); PIN(X); SBAR(); } while (0)
#define VRD(i) do { vlo[i] = vtr(vp_ + (((i) >> 2) * 4096 + ((i) & 3) * 1024)); vhi[i] = vtr(vp_ + (((i) >> 2) * 4096 + ((i) & 3) * 1024 + 512)); } while (0)
#define KRD(G_, j) do { if (G_) { kload2(kf, kp0 + sl_next, j); SBAR(); } } while (0)
#define STEP(C0, C1, P0, P1, t, GK, GV, GL) do { SBAR(); \
    const lds_cptr vp_ = vp0 + sl_prev; const f32x16 z_ = {}; \
    C0 = MF8(KE(bw0), QE(), z_); C1 = MF8(KE(bw1), QE(), z_); SBAR(); \
    VRD(0); SBAR(); float sacc = (P0[0] + P0[1]); \
    GAPA(C0 = MF16(kf[0], qr[0], C0), P0[2], P0[3], P0[4], P0[5],     pw0[0] = PKW(P0, 0), pw0[1] = PKW(P0, 2), pw0); \
    VRD(4); SBAR(); GAPA(C1 = MF16(kf[1], qr[0], C1), P0[6], P0[7], P0[8], P0[9],     pw0[2] = PKW(P0, 4), pw0[3] = PKW(P0, 6), pw0); \
    VRD(1); SBAR(); GAPA(C0 = MF16(kf[2], qr[1], C0),   P0[10], P0[11], P0[12], P0[13], pw1[0] = PKW(P0, 8), pw1[1] = PKW(P0, 10), pw1); \
    VRD(5); SBAR(); GAPA(C1 = MF16(kf[3], qr[1], C1),   P0[14], P0[15], P1[0], P1[1],   pw1[2] = PKW(P0, 12), pw1[3] = PKW(P0, 14), pw1); \
    VRD(2); SBAR(); GAPA(C0 = MF16(kf[4], qr[2], C0),   P1[2], P1[3], P1[4], P1[5],     pw2[0] = PKW(P1, 0), pw2[1] = PKW(P1, 2), pw2); \
    VRD(6); SBAR(); GAPA(C1 = MF16(kf[5], qr[2], C1),   P1[6], P1[7], P1[8], P1[9],     pw2[2] = PKW(P1, 4), pw2[3] = PKW(P1, 6), pw2); \
    VRD(3); SBAR(); GAPA(C0 = MF16(kf[6], qr[3], C0),   P1[10], P1[11], P1[12], P1[13], pw3[0] = PKW(P1, 8), pw3[1] = PKW(P1, 10), pw3); \
    VRD(7); SBAR(); GAPA(C1 = MF16(kf[7], qr[3], C1),   P1[14], P1[15], 0.f, 0.f,       pw3[2] = PKW(P1, 12), pw3[3] = PKW(P1, 14), pw3); \
    l_reg += sacc; \
    if (GK) { DMA_K((t) + 3, sl_cur); } if (GV) { DMA_V((t) + 1, sl_next); } \
    CMASK(C0, C1, t); \
    { float a = MX3(C0[0], C0[1], C1[0]), b_ = MX3(C0[2], C0[3], C1[1]); a = MX3(a, C1[2], C1[3]); \
      _Pragma("unroll") for (int r = 4; r < 16; r += 4) { a = MX3(a, C0[r], C0[r + 1]); b_ = MX3(b_, C0[r + 2], C0[r + 3]); a = MX3(a, C1[r], C1[r + 1]); b_ = MX3(b_, C1[r + 2], C1[r + 3]); } \
      float rm = __builtin_fmaxf(a, b_); { auto rr = __builtin_amdgcn_permlane32_swap(__float_as_uint(rm), __float_as_uint(rm), false, false); rm = __builtin_fmaxf(__uint_as_float(rr[0]), __uint_as_float(rr[1])); } \
      resc = false; \
      if (__builtin_expect(__any(rm > (float)THRL), 0)) { const float dl = __builtin_fmaxf(rm, 0.f); mhat += dl; \
        _Pragma("unroll") for (int r = 0; r < 16; ++r) { C0[r] -= dl; C1[r] -= dl; } \
        SETM(); \
        const float f = __builtin_amdgcn_exp2f(-dl); l_reg *= f; if (hi == 0) wsf[r32] = f; resc = true; } } \
    SBAR(); \
    if (GL) { bw0 = biasw[((t) + 1) * 64 + r32]; bw1 = biasw[((t) + 1) * 64 + 32 + r32]; } \
    GAPB(o[0] = MF16(PAF(0), VFR(0), o[0]), C0, 0); \
    GAPB(o[1] = MF16(PAF(0), VFR(4), o[1]), C0, 4); \
    KRD(GL, 0); GAPB(o[0] = MF16(PAF(1), VFR(1), o[0]), C0, 8); \
    KRD(GL, 1); GAPB(o[1] = MF16(PAF(1), VFR(5), o[1]), C0, 12); \
    KRD(GL, 2); GAPB(o[0] = MF16(PAF(2), VFR(2), o[0]), C1, 0); \
    KRD(GL, 3); GAPB(o[1] = MF16(PAF(2), VFR(6), o[1]), C1, 4); \
    GAPB(o[0] = MF16(PAF(3), VFR(3), o[0]), C1, 8); \
    GAPB(o[1] = MF16(PAF(3), VFR(7), o[1]), C1, 12); \
    } while (0)
    int t = 1;
#undef CMASK
#define CMASK(P0, P1, t) do {} while (0)
    for (; t + 5 < NT; t += 2) {
        STEP(pB0, pB1, pA0, pA1, t, true, true, true);     WAIT_BAR(2); RESC(); ROT();
        STEP(pA0, pA1, pB0, pB1, t + 1, true, true, true); WAIT_BAR(2); RESC(); ROT();
    }
#undef CMASK
#define CMASK(P0, P1, t) do { int jb_ = (t) - (NT - 4); if (jb_ >= 0) cmask(P0, P1, jb_, qrel, hi); } while (0)
#define ENDW(tt) do { if ((tt) + 3 < NT) { WAIT_BAR(2); } else if ((tt) + 2 < NT) { WAIT_BAR(1); } else { WAIT_BAR(0); } } while (0)
    for (; t + 1 < NT; t += 2) {
        STEP(pB0, pB1, pA0, pA1, t, (t + 3 < NT), (t + 1 < NT), (t + 1 < NT));         ENDW(t);     RESC(); ROT();
        STEP(pA0, pA1, pB0, pB1, t + 1, (t + 4 < NT), (t + 2 < NT), (t + 2 < NT));     ENDW(t + 1); RESC(); ROT();
    }
    STEP(pB0, pB1, pA0, pA1, NT - 1, false, false, false); RESC();
    { float sacc = pB0[0] + pB0[1]; _Pragma("unroll") for (int r = 2; r < 16; ++r) sacc += pB0[r]; _Pragma("unroll") for (int r = 0; r < 16; ++r) sacc += pB1[r]; l_reg += sacc;
      pw0 = (u32x4){PKW(pB0, 0), PKW(pB0, 2), PKW(pB0, 4), PKW(pB0, 6)}; pw1 = (u32x4){PKW(pB0, 8), PKW(pB0, 10), PKW(pB0, 12), PKW(pB0, 14)}; pw2 = (u32x4){PKW(pB1, 0), PKW(pB1, 2), PKW(pB1, 4), PKW(pB1, 6)}; pw3 = (u32x4){PKW(pB1, 8), PKW(pB1, 10), PKW(pB1, 12), PKW(pB1, 14)};
      SBAR(); pv(o, vb0 + sl_cur, PAF(0), PAF(1), PAF(2), PAF(3)); }
#undef PKW
#undef PAF
#undef VFR
#undef PIN
#undef MX3
#undef GAPA
#undef GAPB
#undef EX
#undef VRD
#undef KRD
#undef STEP
#undef ENDW
    { auto rr = __builtin_amdgcn_permlane32_swap(__float_as_uint(l_reg), __float_as_uint(l_reg), false, false); l_reg = __uint_as_float(rr[0]) + __uint_as_float(rr[1]); }
    if (hi == 0) wsf[32 + r32] = l_reg; asm volatile("s_waitcnt lgkmcnt(0)" ::: "memory");
    float rli[16];
#pragma unroll
    for (int r = 0; r < 16; ++r) rli[r] = __builtin_amdgcn_rcpf(wsf[32 + crow(r, hi)]);
    h16* Ow = O + (rowbase + q0 + wid * QBLK) * DMP + h * D;
    const h16* Gw = G + (rowbase + q0 + wid * QBLK) * DMP + h * D;
    { h16* stg = (h16*)(shm + LDS_OST) + wid * 2048;
#pragma unroll
      for (int r = 0; r < 16; ++r) { const int orow = crow(r, hi);
#pragma unroll
        for (int d0 = 0; d0 < 2; ++d0) stg[orow * 64 + d0 * 32 + r32] = (h16)(o[d0][r] * rli[r]); }
      asm volatile("s_waitcnt lgkmcnt(0)" ::: "memory");
#pragma unroll
      for (int i = 0; i < 4; ++i) { const int row = i * 8 + (lane >> 3), ch = lane & 7; const f16x8 v = *(const f16x8*)(stg + row * 64 + ch * 8); const f16x8 g = *(const f16x8*)(Gw + (long)row * DMP + ch * 8);
        float r8[8];
#pragma unroll
        for (int e = 0; e < 8; ++e) { const float gg = (float)g[e]; r8[e] = (float)v[e] * __builtin_amdgcn_rcpf(1.0f + __builtin_amdgcn_exp2f(-gg * LOG2E)); }
        u32x4 w; w.x = pk2h(r8[0], r8[1]); w.y = pk2h(r8[2], r8[3]); w.z = pk2h(r8[4], r8[5]); w.w = pk2h(r8[6], r8[7]);
        *(u32x4*)(Ow + (long)row * DMP + ch * 8) = w; } }
    asm volatile("s_waitcnt lgkmcnt(0)\n\ts_barrier" ::: "memory");
#undef DMA_K
#undef DMA_V
#undef CMASK
#undef START
#undef RESC
#undef ROT
#undef QE
#undef KE
#undef SETM
}
#undef SBAR
#undef WAIT_BAR
#undef MF16
#undef MF8
}
constexpr int NWAVES = 8;
#ifndef MK_N_LAUNCHES
#define MK_N_LAUNCHES 1
#endif
constexpr int NPHASE = 2 + 8 * DEPTH;
constexpr size_t MiB = 1u << 20;
constexpr size_t WS_CTL = 0, CTL_ZERO_BYTES = 1 * MiB;
constexpr size_t SZ_WFOX = (size_t)4096 * 1024 * 2, SZ_WFO = (size_t)1024 * 1024 * 2, SZ_WRET = (size_t)6144 * 1024 * 2, SZ_WRO = (size_t)1024 * 2048 * 2;
constexpr size_t SZ_WGU = (size_t)1024 * 1024 * 2, SZ_WD = (size_t)1024 * 512 * 2;
constexpr size_t WS_WFOX = 1 * MiB, WS_WFO = WS_WFOX + 2 * SZ_WFOX, WS_WRET = WS_WFO + 2 * SZ_WFO, WS_WRO = WS_WRET + 2 * SZ_WRET;
constexpr size_t WS_WGU = WS_WRO + 2 * SZ_WRO, WS_WD = WS_WGU + (size_t)DEPTH * NE * SZ_WGU, WS_WEND = WS_WD + (size_t)DEPTH * NE * SZ_WD;
constexpr size_t SZ_RW = (size_t)32 * 64 * 24 * 4, SZ_FW = (size_t)32 * 64 * 8 * 4;
constexpr size_t WS_RW = WS_WEND, WS_FW = WS_RW + DEPTH * SZ_RW, WS_ROPE = WS_FW + 2 * SZ_FW;
constexpr size_t WS_H = WS_ROPE + 2 * (size_t)SEQ * 128 * 4;
constexpr size_t WS_HN = WS_H + (size_t)T * DM * 4;
constexpr size_t WS_RSTD = WS_HN + (size_t)(T + 8) * DM * 2;
constexpr size_t WS_FLOG = WS_RSTD + (size_t)T * 4, WS_CUM = WS_FLOG + (size_t)T * 16 * 4;
constexpr size_t WS_EID = WS_CUM + (size_t)BATCH * FOX_H * SEQ * 4, WS_RANK = WS_EID + PAIRS * 4, WS_GATE = WS_RANK + PAIRS * 4, WS_LIST = WS_GATE + PAIRS * 4;
constexpr size_t WS_QKVG = (WS_LIST + (size_t)NE * LISTCAP * 4 + 255) & ~(size_t)255;
constexpr size_t SZ_T1K = (size_t)T * 1024 * 2;
constexpr size_t WS_OG = WS_QKVG + 6 * SZ_T1K;
constexpr size_t WS_RO = WS_OG + 2 * SZ_T1K;
constexpr size_t WS_END = WS_RO + 2 * SZ_T1K;
constexpr size_t WS_Y = WS_QKVG;
constexpr size_t WS_ACT = WS_RO;
static_assert((size_t)PROWS * 1024 * 4 <= 6 * SZ_T1K && (size_t)PROWS * 512 * 2 <= 2 * SZ_T1K, "overlays");
constexpr int CW_TMO = 0, CW_BAR = 4096, CW_CNT = 16384;
constexpr int RING_BYTES = 147456;
constexpr int LDSCTL_OFF = RING_BYTES, MISC_OFF = LDSCTL_OFF;
constexpr int LDS_BYTES = RING_BYTES + 1024;

typedef GAS unsigned gu32;
#define RLX_AGENT __ATOMIC_RELAXED, __HIP_MEMORY_SCOPE_AGENT
#define LDS_WAIT() asm volatile("s_waitcnt lgkmcnt(0)" ::: "memory")

#define XB_TMO      128
#define XB_XCNT(j)  (256  + 64 * (j))
#define XB_XSUB(j)  (1280 + 64 * (j))
#define XB_XGEN(j)  (2304 + 64 * (j))
#define XB_TOP      3328
#define XB_TOPGEN   3392
#define XCD_BAR_WORDS 3456
#define XB_SPIN_CAP (1u << 18)
__device__ __forceinline__ unsigned xb_ld(unsigned* p)              { return __hip_atomic_load(p, __ATOMIC_RELAXED, __HIP_MEMORY_SCOPE_AGENT); }
__device__ __forceinline__ unsigned xb_add(unsigned* p, unsigned v) { return __hip_atomic_fetch_add(p, v, __ATOMIC_RELAXED, __HIP_MEMORY_SCOPE_AGENT); }
__device__ __forceinline__ unsigned xb_xcc_id() { return (unsigned)__builtin_amdgcn_s_getreg((3 << 11) | 20) & 0xFu; }
#define XB_SPIN(cond, bar) do { unsigned _sp = 0; while (cond) { __builtin_amdgcn_s_sleep(1); \
    if ((++_sp & 255u) == 0u) { if (xb_ld(&(bar)[XB_TMO])) break; if (_sp > XB_SPIN_CAP) { atomicAdd(&(bar)[XB_TMO], 1u); break; } } } } while (0)
struct XcdBarrier { unsigned* bar; unsigned x; volatile LAS unsigned* st; };
__device__ __forceinline__ XcdBarrier xcd_barrier_post(unsigned* bar, volatile LAS unsigned* st) {
    XcdBarrier b; b.bar = bar; b.x = xb_xcc_id(); b.st = st;
    if (threadIdx.x == 0) (void)xb_add(&bar[XB_XCNT(b.x)], 1u);
    return b;
}
__device__ __forceinline__ void xcd_barrier_complete(unsigned* bar, unsigned x, unsigned& nloc, unsigned& nx) {
    const unsigned G = gridDim.x * gridDim.y * gridDim.z;
    unsigned sum, cnt, mine, sp = 0u;
    for (;;) {
        sum = 0u; cnt = 0u; mine = 0u;
#pragma unroll
        for (unsigned j = 0; j < 16; ++j) { const unsigned c = xb_ld(&bar[XB_XCNT(j)]); sum += c; cnt += (c > 0u) ? 1u : 0u; mine = (j == x) ? c : mine; }
        if (sum == G) break;
        __builtin_amdgcn_s_sleep(1);
        if ((++sp & 255u) == 0u) { if (xb_ld(&bar[XB_TMO])) break; if (sp > XB_SPIN_CAP) { atomicAdd(&bar[XB_TMO], 1u); break; } }
    }
    nloc = mine > 0u ? mine : 1u; nx = cnt > 0u ? cnt : 1u;
}
__device__ __forceinline__ void xcd_barrier(const XcdBarrier& b) {
    asm volatile("s_waitcnt vmcnt(0)" ::: "memory");
    __syncthreads();
    if (threadIdx.x == 0) {
        unsigned* bar = b.bar;
        __builtin_amdgcn_s_waitcnt(0);
        unsigned nloc = b.st[0], nx = b.st[1];
        if (nloc == 0u) { xcd_barrier_complete(bar, b.x, nloc, nx); b.st[0] = nloc; b.st[1] = nx; }
        const unsigned old = xb_add(&bar[XB_XSUB(b.x)], 1u);
        const unsigned gen = old / nloc;
        if (old + 1u == (gen + 1u) * nloc) {
            __builtin_amdgcn_fence(__ATOMIC_RELEASE, "agent");
            asm volatile("s_waitcnt vmcnt(0)" ::: "memory");
            const unsigned og = xb_add(&bar[XB_TOP], 1u);
            const unsigned tg = og / nx;
            if (og + 1u == (tg + 1u) * nx) xb_add(&bar[XB_TOPGEN], 1u);
            else XB_SPIN(xb_ld(&bar[XB_TOPGEN]) == tg, bar);
            __builtin_amdgcn_fence(__ATOMIC_ACQUIRE, "agent");
            xb_add(&bar[XB_XGEN(b.x)], 1u);
            asm volatile("s_waitcnt vmcnt(0)" ::: "memory");
        } else {
            XB_SPIN(xb_ld(&bar[XB_XGEN(b.x)]) == gen, bar);
            __builtin_amdgcn_fence(__ATOMIC_ACQUIRE, "agent");
            asm volatile("s_waitcnt vmcnt(0)" ::: "memory");
        }
    }
    __syncthreads();
}

struct Args { const float* in[16]; float* out; unsigned char* ws; int ph_lo, ph_hi, li, pad; };

template <bool GU>
__device__ __forceinline__ void transpose_item(const float* W, int K, int ld, h16* WT, LAS float* scr, int kb, int nb, int lane) {
    const int k0 = 64 * kb, n0 = 64 * nb;
    const int lc = (lane & 15) * 4;
    const int srccol = GU ? ((lc < 32) ? (n0 / 2 + lc) : (512 + n0 / 2 + (lc - 32))) : (n0 + lc);
#pragma unroll 4
    for (int it = 0; it < 16; ++it) { const int kk = 4 * it + (lane >> 4);
        const f32x4 v = *(const f32x4*)(W + (size_t)(k0 + kk) * ld + srccol);
        scr[kk * 65 + lc + 0] = v[0]; scr[kk * 65 + lc + 1] = v[1]; scr[kk * 65 + lc + 2] = v[2]; scr[kk * 65 + lc + 3] = v[3]; }
    LDS_WAIT(); asm volatile("" ::: "memory");
    const int c = lane & 7;
#pragma unroll
    for (int j = 0; j < 8; ++j) { const int nn = 8 * j + (lane >> 3);
        const int cc = GU ? (((nn & 7) < 4) ? (4 * (nn >> 3) + (nn & 7)) : (32 + 4 * (nn >> 3) + ((nn & 7) - 4))) : nn;
        const LAS float* s = scr + (8 * c) * 65 + cc;
        u32x4 o; o.x = pk2h(s[0 * 65], s[1 * 65]); o.y = pk2h(s[2 * 65], s[3 * 65]); o.z = pk2h(s[4 * 65], s[5 * 65]); o.w = pk2h(s[6 * 65], s[7 * 65]);
        *(GAS u32x4*)(WT + (size_t)(n0 + nn) * K + k0 + 8 * c) = o; }
    LDS_WAIT(); asm volatile("" ::: "memory");
}

__device__ __forceinline__ float shfl_idx(float v, int src) { return __int_as_float(__builtin_amdgcn_ds_bpermute(src << 2, __float_as_int(v))); }
__device__ __forceinline__ float wave_sum(float v, int lane) {
#pragma unroll
    for (int o = 1; o < 64; o <<= 1) v += shfl_idx(v, lane ^ o);
    return v;
}
__device__ __forceinline__ void rope_cs(int pos, int m, float& c, float& s) {
    const float e = -(float)m * (13.287712379549449f / 127.0f);
    const float inv = exp2f(e);
    const float ang = (float)pos * inv;
    const float k = rintf(ang * 0.6366197723675814f);
    float r = fmaf(-k, 1.5703125f, ang); r = fmaf(-k, 4.837512969970703125e-4f, r); r = fmaf(-k, 7.54978995489188216e-8f, r);
    const float z = r * r;
    const float sp = fmaf(r * z, fmaf(z, fmaf(z, -1.9515295891e-4f, 8.3321608736e-3f), -1.6666654611e-1f), r);
    const float cp = fmaf(z * z, fmaf(z, fmaf(z, 2.443315711809948e-5f, -1.388731625493765e-3f), 4.166664568298827e-2f), fmaf(z, -0.5f, 1.0f));
    const int q = ((int)k) & 3;
    c = (q == 0) ? cp : (q == 1) ? -sp : (q == 2) ? -cp : sp;
    s = (q == 0) ? sp : (q == 1) ? cp : (q == 2) ? -sp : -cp;
}
struct RowArgs {
    const float* src; float* h; h16* hn; float* rstd; const float* gnorm;
    const float* y; const int* eidp; const int* rankp; const float* gatep;
    const float* tab; const float* bias0; const float* bias1; float* flog;
    int* eid; int* rank; float* gate; unsigned* counts; int* list;
};
template <bool COMBINE, bool STORE_H, int NT_>
__device__ __forceinline__ void row_pass(const RowArgs& A, int g, int lane, LAS float* scr, const volatile LAS unsigned* padstart) {
    const int r = lane & 15, kq = lane >> 4; const int t = 16 * g + r;
    const float* srow = A.src + (size_t)t * DM + 8 * kq; float* hrow = A.h + (size_t)t * DM + 8 * kq; h16* nrow = A.hn + (size_t)t * DM + 8 * kq;
    const float* y0 = nullptr; const float* y1 = nullptr; float g0 = 0.f, g1 = 0.f;
    if (COMBINE) { const int e0 = A.eidp[2 * t], e1 = A.eidp[2 * t + 1]; const int p0 = (int)padstart[e0] + A.rankp[2 * t], p1 = (int)padstart[e1] + A.rankp[2 * t + 1];
        g0 = A.gatep[2 * t]; g1 = A.gatep[2 * t + 1]; y0 = A.y + (size_t)p0 * DM + 8 * kq; y1 = A.y + (size_t)p1 * DM + 8 * kq; }
    f32x4 acc[NT_ > 0 ? NT_ : 1];
#pragma unroll
    for (int i = 0; i < (NT_ > 0 ? NT_ : 1); ++i) acc[i] = (f32x4){0.f, 0.f, 0.f, 0.f};
    float ss = 0.f;
    const float* tabp = A.tab + (size_t)lane * (8 * (NT_ > 0 ? NT_ : 1));
#pragma unroll 2
    for (int it = 0; it < 32; ++it) {
        f32x4 v0 = *(const f32x4*)(srow + 32 * it), v1 = *(const f32x4*)(srow + 32 * it + 4);
        if (COMBINE) { const f32x4 a0 = *(const f32x4*)(y0 + 32 * it), a1 = *(const f32x4*)(y0 + 32 * it + 4), b0 = *(const f32x4*)(y1 + 32 * it), b1 = *(const f32x4*)(y1 + 32 * it + 4);
            v0 = v0 + a0 * g0 + b0 * g1; v1 = v1 + a1 * g0 + b1 * g1; }
        if (STORE_H) { *(f32x4*)(hrow + 32 * it) = v0; *(f32x4*)(hrow + 32 * it + 4) = v1; }
        ss += (v0[0] * v0[0] + v0[1] * v0[1]) + (v0[2] * v0[2] + v0[3] * v0[3]) + (v1[0] * v1[0] + v1[1] * v1[1]) + (v1[2] * v1[2] + v1[3] * v1[3]);
        const f32x4 gn0 = *(const f32x4*)(A.gnorm + 32 * it + 8 * kq), gn1 = *(const f32x4*)(A.gnorm + 32 * it + 8 * kq + 4);
        const f32x4 a0 = v0 * gn0, a1 = v1 * gn1;
        u32x4 w; w.x = pk2h(a0[0], a0[1]); w.y = pk2h(a0[2], a0[3]); w.z = pk2h(a1[0], a1[1]); w.w = pk2h(a1[2], a1[3]);
        *(u32x4*)(nrow + 32 * it) = w;
        if (NT_ > 0) {
            const float* tp = tabp + (size_t)it * 64 * 8 * NT_;
            f32x4 bf[2 * (NT_ > 0 ? NT_ : 1)];
#pragma unroll
            for (int q = 0; q < 2 * NT_; ++q) bf[q] = *(const f32x4*)(tp + 4 * q);
#pragma unroll
            for (int tl = 0; tl < NT_; ++tl) {
#pragma unroll
                for (int i = 0; i < 4; ++i) acc[tl] = __builtin_amdgcn_mfma_f32_16x16x4f32(a0[i], bf[2 * tl][i], acc[tl], 0, 0, 0);
#pragma unroll
                for (int i = 0; i < 4; ++i) acc[tl] = __builtin_amdgcn_mfma_f32_16x16x4f32(a1[i], bf[2 * tl + 1][i], acc[tl], 0, 0, 0);
            }
        }
    }
    ss += shfl_idx(ss, lane ^ 16); ss += shfl_idx(ss, lane ^ 32);
    const float rs = 1.0f / sqrtf(ss * (1.0f / DM) + EPS);
    if (kq == 0) A.rstd[t] = rs;
    if (NT_ > 0) {
        float rst[4];
#pragma unroll
        for (int q = 0; q < 4; ++q) rst[q] = shfl_idx(rs, 4 * kq + q);
        if (NT_ == 1) {
            const float bb = A.bias0[r];
#pragma unroll
            for (int q = 0; q < 4; ++q) A.flog[(size_t)(16 * g + 4 * kq + q) * 16 + r] = acc[0][q] * rst[q] + bb;
        } else {
#pragma unroll
            for (int tl = 0; tl < NT_; ++tl)
#pragma unroll
                for (int q = 0; q < 4; ++q) scr[(4 * kq + q) * 48 + 16 * tl + r] = acc[tl][q] * rst[q];
            LDS_WAIT(); asm volatile("" ::: "memory");
            if (lane < 16) {
                const LAS float* sr = scr + r * 48;
                float gl[4];
#pragma unroll
                for (int q = 0; q < 4; ++q) gl[q] = sr[32 + q] + A.bias0[q];
                int gi = 0; float gmax = gl[0];
#pragma unroll
                for (int q = 1; q < 4; ++q) if (gl[q] > gmax) { gmax = gl[q]; gi = q; }
                float gs = 0.f;
#pragma unroll
                for (int q = 0; q < 4; ++q) gs += __expf(gl[q] - gmax);
                const float pg = 1.0f / gs;
                float el[8];
#pragma unroll
                for (int e = 0; e < 8; ++e) el[e] = sr[gi * 8 + e] + A.bias1[gi * 8 + e];
                int i0 = 0; float emax = el[0];
#pragma unroll
                for (int e = 1; e < 8; ++e) if (el[e] > emax) { emax = el[e]; i0 = e; }
                int i1 = -1; float b1 = -3.0e38f;
#pragma unroll
                for (int e = 0; e < 8; ++e) if (e != i0 && el[e] > b1) { b1 = el[e]; i1 = e; }
                const float p1 = __expf(b1 - emax);
                const float ga = pg / (1.0f + p1), gb = pg * p1 / (1.0f + p1);
                const int e0 = gi * 8 + i0, e1 = gi * 8 + i1;
                const int r0 = (int)atomicAdd(A.counts + e0, 1u), r1 = (int)atomicAdd(A.counts + e1, 1u);
                A.list[e0 * LISTCAP + r0] = 2 * t; A.list[e1 * LISTCAP + r1] = 2 * t + 1;
                A.eid[2 * t] = e0; A.eid[2 * t + 1] = e1; A.rank[2 * t] = r0; A.rank[2 * t + 1] = r1; A.gate[2 * t] = ga; A.gate[2 * t + 1] = gb;
            }
            LDS_WAIT(); asm volatile("" ::: "memory");
        }
    }
}

__device__ __forceinline__ void final_row(const float* h, const float* y, const int* eidp, const int* rankp, const float* gatep, const volatile LAS unsigned* padstart, const float* gf, float* out, int t, int lane) {
    const int e0 = eidp[2 * t], e1 = eidp[2 * t + 1]; const int p0 = (int)padstart[e0] + rankp[2 * t], p1 = (int)padstart[e1] + rankp[2 * t + 1];
    const float g0 = gatep[2 * t], g1 = gatep[2 * t + 1];
    const f32x4* hr = (const f32x4*)(h + (size_t)t * DM) + lane; const f32x4* ya = (const f32x4*)(y + (size_t)p0 * DM) + lane; const f32x4* yb = (const f32x4*)(y + (size_t)p1 * DM) + lane;
    f32x4 v[4]; float s = 0.f;
#pragma unroll
    for (int j = 0; j < 4; ++j) { v[j] = hr[64 * j] + ya[64 * j] * g0 + yb[64 * j] * g1; s += (v[j][0] * v[j][0] + v[j][1] * v[j][1]) + (v[j][2] * v[j][2] + v[j][3] * v[j][3]); }
    const float rs = 1.0f / sqrtf(wave_sum(s, lane) * (1.0f / DM) + EPS);
    f32x4* o = (f32x4*)(out + (size_t)t * DM) + lane;
#pragma unroll
    for (int j = 0; j < 4; ++j) o[64 * j] = v[j] * rs * ((const f32x4*)gf)[lane + 64 * j];
}
__device__ __forceinline__ void ret_gn_item(const h16* ro, const h16* gate, const float* gain, h16* og, int w, int lane) {
    const int t = w >> 2, h = w & 3;
    const f16x8 ov = *(const f16x8*)(ro + (size_t)t * 2048 + h * 512 + lane * 8);
    const f16x8 gv = *(const f16x8*)(gate + (size_t)(h >> 1) * T * 1024 + (size_t)t * 1024 + (h & 1) * 512 + lane * 8);
    float v[8]; float s = 0.f;
#pragma unroll
    for (int j = 0; j < 8; ++j) { v[j] = (float)ov[j]; s += v[j]; }
    const float mu = wave_sum(s, lane) * (1.0f / RET_DV); float q = 0.f;
#pragma unroll
    for (int j = 0; j < 8; ++j) { v[j] -= mu; q += v[j] * v[j]; }
    const float rs = 1.0f / sqrtf(wave_sum(q, lane) * (1.0f / RET_DV) + EPS);
    const f32x4 ga = *(const f32x4*)(gain + h * 512 + lane * 8), gb = *(const f32x4*)(gain + h * 512 + lane * 8 + 4);
    float o[8];
#pragma unroll
    for (int j = 0; j < 8; ++j) { const float gg = (float)gv[j]; const float gn = (j < 4) ? ga[j & 3] : gb[j & 3];
        o[j] = v[j] * rs * gn * gg * __builtin_amdgcn_rcpf(1.0f + __builtin_amdgcn_exp2f(-gg * LOG2E)); }
    u32x4 wv; wv.x = pk2h(o[0], o[1]); wv.y = pk2h(o[2], o[3]); wv.z = pk2h(o[4], o[5]); wv.w = pk2h(o[6], o[7]);
    *(u32x4*)(og + (size_t)t * 2048 + h * 512 + lane * 8) = wv;
}

namespace ret_body {
constexpr int KLP = 528, VLP = 144, RLP = 528;
constexpr int OFF_KL = 0, OFF_VL = 128 * KLP, OFF_VD = OFF_VL + 128 * VLP, OFF_RL = OFF_VD + 128 * VLP, END = OFF_RL + 64 * RLP, OFF_OS = 0;
static_assert(END <= RING_BYTES, "retention LDS");
#define MF16(a, b, c) __builtin_amdgcn_mfma_f32_32x32x16_f16(a, b, c, 0, 0, 0)
__device__ __forceinline__ int crow(int r, int hi) { return (r & 3) + 8 * (r >> 2) + 4 * hi; }
typedef short v4i16_t __attribute__((ext_vector_type(4)));
__device__ __forceinline__ s16x4 vtr(LAS const char* p) { return __builtin_bit_cast(s16x4, __builtin_amdgcn_ds_read_tr16_b64_v4i16((LAS v4i16_t*)p)); }
__device__ __forceinline__ f16x8 mk8(s16x4 lo, s16x4 hi) { typedef short s16x8 __attribute__((ext_vector_type(8))); s16x8 t = {lo[0], lo[1], lo[2], lo[3], hi[0], hi[1], hi[2], hi[3]}; return __builtin_bit_cast(f16x8, t); }
__device__ __forceinline__ f16x8 pack8(const f32x16& S, int b) { u32x4 w; w.x = pk2h(S[b], S[b + 1]); w.y = pk2h(S[b + 2], S[b + 3]); w.z = pk2h(S[b + 4], S[b + 5]); w.w = pk2h(S[b + 6], S[b + 7]); return __builtin_bit_cast(f16x8, w); }
__device__ __forceinline__ void ret_item(int b, int h, int sl, const h16* __restrict__ Qr, const h16* __restrict__ Kr, const h16* __restrict__ Vb, h16* __restrict__ O, LAS unsigned char* lds, const int tid_arg) {
    const int tid_in = tid_arg;
    const float lg2 = log2f(1.0f - exp2f(-5.0f - (float)h));
    const float cd = exp2f(128.0f * lg2);
    f32x16 R0 = {}, R1 = {};
    for (int n = 0; n < SEQ / 128; ++n) {
        int tid = tid_in; asm volatile("" : "+v"(tid));
        const int lane = tid & 63, r32 = lane & 31, hi = lane >> 5; const int wid = __builtin_amdgcn_readfirstlane(tid >> 6);
        const int wi = wid & 3, wj = wid >> 2;
        const bool act_s = !(wj == 1 && wi < 2);
        const int trq = (lane & 15) >> 2, trp = lane & 3, trg = (lane >> 4) & 1;
        const size_t t0 = (size_t)b * SEQ + (size_t)n * 128;
#pragma unroll
        for (int i = 0; i < 8; ++i) { const int p = tid + 512 * i, j = p >> 5, c16 = p & 31;
            const u32x4 v = *(const u32x4*)(Kr + (t0 + j) * 1024 + h * 256 + c16 * 8);
            *(LAS u32x4*)(lds + OFF_KL + j * KLP + c16 * 16) = v; }
#pragma unroll
        for (int i = 0; i < 2; ++i) { const int p = tid + 512 * i, j = p >> 3, c16 = p & 7;
            const f16x8 v = *(const f16x8*)(Vb + (t0 + j) * 1024 + c16 * 8);
            *(LAS f16x8*)(lds + OFF_VL + j * VLP + c16 * 16) = v;
            const float kd = exp2f(lg2 * (float)(127 - j));
            u32x4 w; w.x = pk2h((float)v[0] * kd, (float)v[1] * kd); w.y = pk2h((float)v[2] * kd, (float)v[3] * kd); w.z = pk2h((float)v[4] * kd, (float)v[5] * kd); w.w = pk2h((float)v[6] * kd, (float)v[7] * kd);
            *(LAS u32x4*)(lds + OFF_VD + j * VLP + c16 * 16) = w; }
        const h16* qp = Qr + (t0 + 32 * wi + r32) * 1024 + h * 256 + 8 * hi;
        f16x8 qf[8];
#pragma unroll
        for (int s = 0; s < 8; ++s) qf[s] = *(const f16x8*)(qp + 16 * (8 * (1 - wj) + s));
        __syncthreads();
        f16x8 sf[2][2];
        {
            f32x16 S0 = {}, S1 = {};
            const LAS unsigned char* kp = lds + OFF_KL + (64 * wj + r32) * KLP + 16 * hi + 256 * (1 - wj);
            if (act_s) {
#pragma unroll
                for (int s = 0; s < 8; ++s) { const f16x8 a0 = *(const LAS f16x8*)(kp + 32 * s), a1 = *(const LAS f16x8*)(kp + 32 * KLP + 32 * s);
                    S0 = MF16(a0, qf[s], S0); S1 = MF16(a1, qf[s], S1); if ((s & 3) == 3) __builtin_amdgcn_sched_barrier(0); }
            }
#pragma unroll
            for (int s = 0; s < 8; ++s) qf[s] = *(const f16x8*)(qp + 16 * (8 * wj + s));
            if (act_s) {
                const LAS unsigned char* kp2 = lds + OFF_KL + (64 * wj + r32) * KLP + 16 * hi + 256 * wj;
#pragma unroll
                for (int s = 0; s < 8; ++s) { const f16x8 a0 = *(const LAS f16x8*)(kp2 + 32 * s), a1 = *(const LAS f16x8*)(kp2 + 32 * KLP + 32 * s);
                    S0 = MF16(a0, qf[s], S0); S1 = MF16(a1, qf[s], S1); if ((s & 3) == 3) __builtin_amdgcn_sched_barrier(0); }
                const int ig = 32 * wi + r32;
#pragma unroll
                for (int r = 0; r < 16; ++r) { const int j0 = 64 * wj + crow(r, hi), j1 = j0 + 32;
                    S0[r] = (ig >= j0) ? S0[r] * exp2f(lg2 * (float)(ig - j0)) : 0.f;
                    S1[r] = (ig >= j1) ? S1[r] * exp2f(lg2 * (float)(ig - j1)) : 0.f; }
            }
            sf[0][0] = pack8(S0, 0); sf[0][1] = pack8(S0, 8); sf[1][0] = pack8(S1, 0); sf[1][1] = pack8(S1, 8);
        }
        __builtin_amdgcn_sched_barrier(0);
        f32x16 OT0 = {}, OT1 = {};
        if (n > 0) {
            const LAS unsigned char* rp = lds + OFF_RL + r32 * RLP + 16 * hi + 256 * wj;
#pragma unroll
            for (int s = 0; s < 8; ++s) {
                const f16x8 a0 = *(const LAS f16x8*)(rp + 32 * s), a1 = *(const LAS f16x8*)(rp + 32 * RLP + 32 * s);
                OT0 = MF16(a0, qf[s], OT0); OT1 = MF16(a1, qf[s], OT1); if ((s & 3) == 3) __builtin_amdgcn_sched_barrier(0); }
            const float qd = exp2f(lg2 * (float)(32 * wi + r32 + 1));
#pragma unroll
            for (int r = 0; r < 16; ++r) { OT0[r] *= qd; OT1[r] *= qd; }
        }
        __builtin_amdgcn_sched_barrier(0);
        if (act_s) {
#pragma unroll
            for (int jt = 0; jt < 2; ++jt)
#pragma unroll
                for (int s2 = 0; s2 < 2; ++s2) {
                    const int jb = 64 * wj + 32 * jt + 16 * s2 + 4 * hi + trq;
                    const LAS char* vp = (const LAS char*)(lds + OFF_VL + jb * VLP + (16 * trg + 4 * trp) * 2);
                    const f16x8 v0 = mk8(vtr(vp), vtr(vp + 8 * VLP)), v1 = mk8(vtr(vp + 64), vtr(vp + 64 + 8 * VLP));
                    OT0 = MF16(v0, sf[jt][s2], OT0); OT1 = MF16(v1, sf[jt][s2], OT1); }
        }
        __builtin_amdgcn_sched_barrier(0);
#pragma unroll
        for (int r = 0; r < 16; ++r) { R0[r] *= cd; R1[r] *= cd; }
#pragma unroll
        for (int s = 0; s < 8; ++s) {
            const int jb = 16 * s + 8 * hi + trq;
            const LAS char* kp = (const LAS char*)(lds + OFF_KL + jb * KLP + (32 * wid + 16 * trg + 4 * trp) * 2);
            const LAS char* vp = (const LAS char*)(lds + OFF_VD + jb * VLP + (16 * trg + 4 * trp) * 2);
            const f16x8 ka = mk8(vtr(kp), vtr(kp + 4 * KLP));
            const f16x8 v0 = mk8(vtr(vp), vtr(vp + 4 * VLP)), v1 = mk8(vtr(vp + 64), vtr(vp + 64 + 4 * VLP));
            R0 = MF16(ka, v0, R0); R1 = MF16(ka, v1, R1); if ((s & 1) == 1) __builtin_amdgcn_sched_barrier(0); }
        __syncthreads();
        {
#pragma unroll
            for (int g4 = 0; g4 < 4; ++g4) {
                u32x2 w; w.x = pk2h(R0[4 * g4], R0[4 * g4 + 1]); w.y = pk2h(R0[4 * g4 + 2], R0[4 * g4 + 3]);
                *(LAS u32x2*)(lds + OFF_RL + r32 * RLP + (32 * wid + 8 * g4 + 4 * hi) * 2) = w;
                w.x = pk2h(R1[4 * g4], R1[4 * g4 + 1]); w.y = pk2h(R1[4 * g4 + 2], R1[4 * g4 + 3]);
                *(LAS u32x2*)(lds + OFF_RL + (32 + r32) * RLP + (32 * wid + 8 * g4 + 4 * hi) * 2) = w; }
            LAS float* os = (LAS float*)(lds + OFF_OS) + wid * 1024 + lane;
#pragma unroll
            for (int r = 0; r < 16; ++r) os[64 * r] = wj ? OT0[r] : OT1[r];
        }
        __syncthreads();
        {
            const LAS float* os = (const LAS float*)(lds + OFF_OS) + (wid ^ 4) * 1024 + lane;
            h16* op = O + (t0 + 32 * wi + r32) * 2048 + h * 512 + sl * 64 + 32 * wj + 4 * hi;
#pragma unroll
            for (int g4 = 0; g4 < 4; ++g4) { float f[4];
#pragma unroll
                for (int q = 0; q < 4; ++q) f[q] = (wj ? OT1[4 * g4 + q] : OT0[4 * g4 + q]) + os[64 * (4 * g4 + q)];
                u32x2 w; w.x = pk2h(f[0], f[1]); w.y = pk2h(f[2], f[3]); *(u32x2*)(op + 8 * g4) = w; }
        }
        __syncthreads();
    }
}
#undef MF16
}

struct MoeOrder {
    const volatile LAS unsigned* cnt; const volatile LAS unsigned* tstart; int G, c, K; const char* A; const char* Bt; size_t bstride; const int* list; int gather;
    __device__ bool next(int i, pg8::Unit& u) const {
        const int NTt = __builtin_amdgcn_readfirstlane((int)tstart[NE]); const long L = (long)i * G + c; if (L >= (long)NTt * 4) return false;
        const int mtg = (int)(L >> 2); int e = 0;
        while (e < NE - 1 && mtg >= __builtin_amdgcn_readfirstlane((int)tstart[e + 1])) ++e;
        u.pm = mtg; u.pn = (int)(L & 3); u.e = e; u.mt = mtg - __builtin_amdgcn_readfirstlane((int)tstart[e]); return true;
    }
    __device__ __forceinline__ const char* abase() const { return A; }
    __device__ __forceinline__ void aoff(const pg8::Unit& u, const int (&R)[2], const int (&C)[2], unsigned (&ao)[2][2]) const {
        if (gather) { const int cn = (int)cnt[u.e];
#pragma unroll
            for (int h = 0; h < 2; ++h)
#pragma unroll
                for (int i = 0; i < 2; ++i) { const int rank = u.mt * 256 + h * 128 + R[i]; int row = T; if (rank < cn) row = list[u.e * LISTCAP + rank] >> 1;
                    ao[h][i] = (unsigned)(((size_t)row * K + C[i]) * 2); }
        } else {
#pragma unroll
            for (int h = 0; h < 2; ++h)
#pragma unroll
                for (int i = 0; i < 2; ++i) ao[h][i] = (unsigned)(((size_t)(u.pm * 256 + h * 128 + R[i]) * K + C[i]) * 2);
        }
    }
    __device__ __forceinline__ const char* bbase(const pg8::Unit& u) const { return Bt + (size_t)u.e * bstride + (size_t)u.pn * 256 * K * 2; }
};
__device__ __forceinline__ void moe_setup(volatile LAS unsigned* MISC, const unsigned* counts, const int tid) {
    __syncthreads();
    if (tid < NE) MISC[16 + tid] = __hip_atomic_load(counts + tid, RLX_AGENT);
    __syncthreads();
    if (tid == 0) { unsigned a = 0; for (int e = 0; e < NE; ++e) { MISC[48 + e] = a; MISC[96 + e] = a * 256u; a += (MISC[16 + e] + 255u) >> 8; } MISC[48 + NE] = a; }
    __syncthreads();
}

__global__ void __launch_bounds__(NWAVES * 64, 2) mk_fwd(Args args) {
    extern __shared__ __attribute__((aligned(16))) unsigned char lds_raw[];
    LAS unsigned char* lds = (LAS unsigned char*)lds_raw;
    volatile LAS unsigned* MISC = (volatile LAS unsigned*)(lds + MISC_OFF);
    const int G = gridDim.x; const int bx = blockIdx.x; const int vcu = (G % 8 == 0) ? (bx % 8) * (G / 8) + bx / 8 : bx;
    { gu32* ctl0 = (gu32*)(args.ws + WS_CTL);
      for (int u = threadIdx.x; u < (LDS_BYTES - LDSCTL_OFF) / 4; u += NWAVES * 64) ((LAS unsigned*)(lds + LDSCTL_OFF))[u] = 0u;
      __syncthreads();
      (void)ctl0; }
    XcdBarrier bar; bar.bar = (unsigned*)((gu32*)(args.ws + WS_CTL) + CW_BAR) + args.li * XCD_BAR_WORDS; bar.x = 0; bar.st = nullptr;
    const bool use_bar = (args.ph_hi - args.ph_lo) > 1;
    if (use_bar) bar = xcd_barrier_post((unsigned*)((gu32*)(args.ws + WS_CTL) + CW_BAR) + args.li * XCD_BAR_WORDS, MISC + 8);
    for (int ph = args.ph_lo; ph < args.ph_hi; ++ph) {
        bool did = true;
        int tid = threadIdx.x; asm volatile("" : "+v"(tid));
        size_t zoff = 0; asm volatile("" : "+s"(zoff));
        unsigned char* ws = args.ws + zoff;
        const int lane = tid & 63, wave = __builtin_amdgcn_readfirstlane(tid >> 6);
        gu32* ctl = (gu32*)(ws + WS_CTL);
        const float* x = args.in[0]; const float* fox_w_in = args.in[1]; const float* fox_b_f = args.in[2]; const float* fox_w_out = args.in[3];
        const float* ret_w_in = args.in[4]; const float* ret_gn = args.in[5]; const float* ret_w_out = args.in[6];
        const float* norm_mix = args.in[7]; const float* norm_ffn = args.in[8];
        const float* rg_w = args.in[9]; const float* rg_b = args.in[10]; const float* re_w = args.in[11]; const float* re_b = args.in[12];
        const float* w_gu = args.in[13]; const float* w_down = args.in[14]; const float* norm_final = args.in[15];
        h16* WfoxT = (h16*)(ws + WS_WFOX); h16* WfoT = (h16*)(ws + WS_WFO); h16* WretT = (h16*)(ws + WS_WRET); h16* WroT = (h16*)(ws + WS_WRO); h16* WguT = (h16*)(ws + WS_WGU); h16* WdT = (h16*)(ws + WS_WD);
        float* RW = (float*)(ws + WS_RW); float* FW = (float*)(ws + WS_FW); float* ctab = (float*)(ws + WS_ROPE); float* stab = ctab + SEQ * 128;
        float* H = (float*)(ws + WS_H); h16* HN = (h16*)(ws + WS_HN); float* RSTD = (float*)(ws + WS_RSTD); float* FLOG = (float*)(ws + WS_FLOG); float* CUM = (float*)(ws + WS_CUM);
        int* EID = (int*)(ws + WS_EID); int* RANK = (int*)(ws + WS_RANK); float* GATE = (float*)(ws + WS_GATE); int* LIST = (int*)(ws + WS_LIST);
        h16* QKVG = (h16*)(ws + WS_QKVG); h16* OG = (h16*)(ws + WS_OG); h16* RO = (h16*)(ws + WS_RO); float* Y = (float*)(ws + WS_Y); h16* ACT = (h16*)(ws + WS_ACT);
        unsigned* COUNTS = (unsigned*)(ctl + CW_CNT);
        const int gw = vcu * NWAVES + wave, NGW = G * NWAVES;

        if (ph == 0) {
            LAS float* scr = (LAS float*)(lds + wave * 16640);
            constexpr int I_FOX = 2 * 16 * 64, I_FO = 2 * 16 * 16, I_RET = 2 * 16 * 96, I_RO = 2 * 32 * 16, I_GU = DEPTH * NE * 16 * 16, I_D = DEPTH * NE * 8 * 16;
            constexpr int NITEMS = I_FOX + I_FO + I_RET + I_RO + I_GU + I_D;
            for (int it = gw; it < NITEMS; it += NGW) {
                int r = it;
                if (r < I_FOX) { const int j = r / (16 * 64), q = r % (16 * 64); transpose_item<false>(fox_w_in + (size_t)j * DM * FOX_IN, DM, FOX_IN, WfoxT + (size_t)j * 4096 * 1024, scr, q / 64, q % 64, lane); continue; } r -= I_FOX;
                if (r < I_FO) { const int j = r / 256, q = r % 256; transpose_item<false>(fox_w_out + (size_t)j * DM * DM, DM, DM, WfoT + (size_t)j * 1024 * 1024, scr, q / 16, q % 16, lane); continue; } r -= I_FO;
                if (r < I_RET) { const int j = r / (16 * 96), q = r % (16 * 96); transpose_item<false>(ret_w_in + (size_t)j * DM * RET_IN, DM, RET_IN, WretT + (size_t)j * 6144 * 1024, scr, q / 96, q % 96, lane); continue; } r -= I_RET;
                if (r < I_RO) { const int j = r / 512, q = r % 512; transpose_item<false>(ret_w_out + (size_t)j * 2048 * DM, 2048, DM, WroT + (size_t)j * 1024 * 2048, scr, q / 16, q % 16, lane); continue; } r -= I_RO;
                if (r < I_GU) { const int m = r / 256, q = r % 256; transpose_item<true>(w_gu + (size_t)m * DM * 1024, DM, 1024, WguT + (size_t)m * 1024 * 1024, scr, q / 16, q % 16, lane); continue; } r -= I_GU;
                { const int m = r / 128, q = r % 128; transpose_item<false>(w_down + (size_t)m * EFF * DM, EFF, DM, WdT + (size_t)m * 1024 * 512, scr, q / 16, q % 16, lane); }
            }
            const int gt = vcu * NWAVES * 64 + tid, NGT = G * NWAVES * 64;
            for (int idx = gt; idx < DEPTH * 32 * 64 * 24; idx += NGT) { const int v = idx % 24, ln = (idx / 24) % 64, it = (idx / (24 * 64)) % 32, L = idx / (24 * 64 * 32);
                const int tl = v >> 3, i = v & 7, k = 32 * it + 8 * (ln >> 4) + i, c = ln & 15;
                float val = 0.f; if (tl < 2) val = re_w[((size_t)L * DM + k) * NE + 16 * tl + c]; else if (c < 4) val = rg_w[((size_t)L * DM + k) * NG + c];
                RW[idx] = val; }
            for (int idx = gt; idx < 2 * 32 * 64 * 8; idx += NGT) { const int i = idx % 8, ln = (idx / 8) % 64, it = (idx / 512) % 32, j = idx / (512 * 32);
                const int k = 32 * it + 8 * (ln >> 4) + i, c = ln & 15; FW[idx] = fox_w_in[((size_t)j * DM + k) * FOX_IN + 4096 + c]; }
            for (int idx = gt; idx < SEQ * 128; idx += NGT) { const int pos = idx / 128, m = idx % 128;
                float c_, s_; rope_cs(pos, m, c_, s_); ctab[idx] = c_; stab[idx] = s_; }
            for (int idx = gt; idx < DM / 2; idx += NGT) ((unsigned*)(HN + (size_t)T * DM))[idx] = 0u;
        } else if (ph == 1) {
            if (wave < 4) { RowArgs A{}; A.src = x; A.h = H; A.hn = HN; A.rstd = RSTD; A.gnorm = norm_mix; A.tab = FW; A.bias0 = fox_b_f; A.flog = FLOG;
                for (int g = wave * G + vcu; g < T / 16; g += 4 * G) row_pass<false, true, 1>(A, g, lane, nullptr, nullptr); }
        } else {
            const int L = (ph - 2) >> 3, sub = (ph - 2) & 7, j = L >> 1; const bool fox = (L & 1) == 0;
            if (sub == 0) {
                if (fox) {
                    if (vcu < BATCH * FOX_H) {
                        const int bh = vcu, b = bh / FOX_H, hh = bh % FOX_H; float v[4]; float run = 0.f;
#pragma unroll
                        for (int i = 0; i < 4; ++i) { const float f = FLOG[((size_t)b * SEQ + 4 * tid + i) * 16 + hh]; run += fminf(f, 0.f) - log1pf(__expf(-fabsf(f))); v[i] = run; }
                        float incl = run;
#pragma unroll
                        for (int o = 1; o < 64; o <<= 1) { const float u = shfl_idx(incl, lane >= o ? lane - o : lane); if (lane >= o) incl += u; }
                        LAS float* wt = (LAS float*)lds;
                        if (lane == 63) wt[wave] = incl;
                        __syncthreads();
                        float base = incl - run;
                        for (int w = 0; w < wave; ++w) base += wt[w];
                        f32x4 o4 = {v[0] + base, v[1] + base, v[2] + base, v[3] + base};
                        *(f32x4*)(CUM + (size_t)bh * SEQ + 4 * tid) = o4;
                        __syncthreads();
                    }
                    pg8::StaticOrder S; S.init(HN, WfoxT + (size_t)j * 4096 * 1024, T, 4096, DM, G, bx);
                    pg8::EpiH16 E{QKVG, 1024, 1024, (size_t)T * 1024, RSTD, attn_body::C2, 1.f, 0, nullptr, nullptr};
                    pg8::gemm_phase<pg8::EpiH16, pg8::StaticOrder, true>(lds, DM, S, E, tid);
                } else {
                    pg8::StaticOrder S; S.init(HN, WretT + (size_t)j * 6144 * 1024, T, 6144, DM, G, bx);
                    pg8::EpiH16 E{QKVG, 1024, 1024, (size_t)T * 1024, RSTD, 1.f, 0.0625f, 1, ctab, stab};
                    pg8::gemm_phase<pg8::EpiH16, pg8::StaticOrder, true>(lds, DM, S, E, tid);
                }
            } else if (sub == 1) {
                if (fox) {
                    const h16* Q = QKVG; const h16* K = QKVG + (size_t)T * 1024; const h16* V = QKVG + (size_t)2 * T * 1024; const h16* Gt = QKVG + (size_t)3 * T * 1024;
                    for (int bh = vcu >> 1; bh < BATCH * FOX_H; bh += (G >> 1)) {
                        const int s = vcu & 1;
#pragma unroll 1
                        for (int i = 0; i < 4; ++i) { const int qb = (i == 0) ? s : (i == 1) ? 7 - s : (i == 2) ? 3 - s : 4 + s;
                            int tu = tid; asm volatile("" : "+v"(tu));
                            attn_body::attn_unit<8>(bh / FOX_H, bh % FOX_H, qb, Q, K, V, Gt, CUM, OG, (char*)lds_raw, tu); }
                    }
                } else {
                    for (int item = vcu; item < BATCH * RET_H * 8; item += G) { const int bh = item >> 3, sl = item & 7, b = bh >> 2, hh = bh & 3;
                        const h16* Vb = QKVG + (size_t)(2 + (hh >> 1)) * T * 1024 + (hh & 1) * 512 + sl * 64;
                        ret_body::ret_item(b, hh, sl, QKVG, QKVG + (size_t)T * 1024, Vb, RO, lds, tid); }
                }
            } else if (sub == 2) {
                if (fox) did = false;
                else { for (int w = gw; w < T * RET_H; w += NGW) ret_gn_item(RO, QKVG + (size_t)4 * T * 1024, ret_gn + (size_t)j * 2048, OG, w, lane); }
            } else if (sub == 3) {
                const int Kd = fox ? 1024 : 2048;
                pg8::StaticOrder S; S.init(OG, fox ? (const void*)(WfoT + (size_t)j * 1024 * 1024) : (const void*)(WroT + (size_t)j * 1024 * 2048), T, DM, Kd, G, bx);
                pg8::EpiResid E{H, DM};
                pg8::gemm_phase<pg8::EpiResid, pg8::StaticOrder, false>(lds, Kd, S, E, tid);
            } else if (sub == 4) {
                if (wave < 4) { RowArgs A{}; A.src = H; A.h = H; A.hn = HN; A.rstd = RSTD; A.gnorm = norm_ffn + (size_t)L * DM; A.tab = RW + (size_t)L * 32 * 64 * 24; A.bias0 = rg_b + L * NG; A.bias1 = re_b + L * NE;
                    A.eid = EID; A.rank = RANK; A.gate = GATE; A.counts = COUNTS + L * NE; A.list = LIST;
                    LAS float* scr = (LAS float*)(lds + wave * 4096);
                    for (int g = wave * G + vcu; g < T / 16; g += 4 * G) row_pass<false, false, 3>(A, g, lane, scr, nullptr); }
            } else if (sub == 5) {
                moe_setup(MISC, COUNTS + L * NE, tid);
                MoeOrder S{MISC + 16, MISC + 48, G, vcu, DM, (const char*)HN, (const char*)(WguT + (size_t)L * NE * 1024 * 1024), SZ_WGU, LIST, 1};
                pg8::EpiSwiGLU E{ACT, RSTD, LIST, (const int*)(COUNTS + L * NE)};
                pg8::gemm_phase<pg8::EpiSwiGLU, MoeOrder, true>(lds, DM, S, E, tid);
            } else if (sub == 6) {
                moe_setup(MISC, COUNTS + L * NE, tid);
                MoeOrder S{MISC + 16, MISC + 48, G, vcu, EFF, (const char*)ACT, (const char*)(WdT + (size_t)L * NE * 1024 * 512), SZ_WD, LIST, 0};
                pg8::EpiStoreF32 E{Y, DM};
                pg8::gemm_phase<pg8::EpiStoreF32, MoeOrder, true>(lds, EFF, S, E, tid);
            } else {
                moe_setup(MISC, COUNTS + L * NE, tid);
                if (L == DEPTH - 1) {
                    for (int t = gw; t < T; t += NGW) final_row(H, Y, EID, RANK, GATE, MISC + 96, norm_final, args.out, t, lane);
                } else if (wave < 4) {
                    const bool nfox = ((L + 1) & 1) == 0;
                    RowArgs A{}; A.src = H; A.h = H; A.hn = HN; A.rstd = RSTD; A.gnorm = norm_mix + (size_t)(L + 1) * DM; A.y = Y; A.eidp = EID; A.rankp = RANK; A.gatep = GATE;
                    if (nfox) { A.tab = FW + (size_t)((L + 1) >> 1) * 32 * 64 * 8; A.bias0 = fox_b_f + ((L + 1) >> 1) * FOX_H; A.flog = FLOG;
                        for (int g = wave * G + vcu; g < T / 16; g += 4 * G) row_pass<true, true, 1>(A, g, lane, nullptr, MISC + 96); }
                    else { for (int g = wave * G + vcu; g < T / 16; g += 4 * G) row_pass<true, true, 0>(A, g, lane, nullptr, MISC + 96); }
                }
            }
        }
        if (did && ph + 1 < args.ph_hi) xcd_barrier(bar);
    }
}

extern "C" void kernel_launch(void* const* d_in, const int* in_sizes, int n_in, void* d_out, int out_size, void* d_ws, size_t ws_size, hipStream_t stream) {
    static int grid = 0;
    if (grid == 0) {
        if (n_in != 16 || out_size != T * DM || ws_size < WS_END) { fprintf(stderr, "kernel_launch: unexpected problem (n_in %d out %d ws %zu need %zu)\n", n_in, out_size, ws_size, (size_t)WS_END); grid = -1; return; }
        int dev = 0, cus = 0;
        if (hipGetDevice(&dev) != hipSuccess || hipDeviceGetAttribute(&cus, hipDeviceAttributeMultiprocessorCount, dev) != hipSuccess) { grid = -1; return; }
        if (hipFuncSetAttribute((const void*)mk_fwd, hipFuncAttributeMaxDynamicSharedMemorySize, LDS_BYTES) != hipSuccess) { fprintf(stderr, "kernel_launch: hipFuncSetAttribute failed\n"); grid = -1; return; }
        (void)hipGetLastError();
        grid = cus;
    }
    if (grid < 0) return;
    if (hipMemsetAsync((char*)d_ws + WS_CTL, 0, CTL_ZERO_BYTES, stream) != hipSuccess) return;
    Args a{};
    for (int i = 0; i < 16; ++i) a.in[i] = (const float*)d_in[i];
    a.out = (float*)d_out; a.ws = (unsigned char*)d_ws;
#if MK_N_LAUNCHES == 1
    a.ph_lo = 0; a.ph_hi = NPHASE; a.li = 0;
    hipLaunchKernelGGL(mk_fwd, dim3(grid), dim3(NWAVES * 64), LDS_BYTES, stream, a);
#else
    for (int p = 0; p < NPHASE; ++p) {
        if (p >= 2 && ((p - 2) & 7) == 2 && (((p - 2) >> 3) & 1) == 0) continue;
        a.ph_lo = p; a.ph_hi = p + 1; a.li = 0;
        hipLaunchKernelGGL(mk_fwd, dim3(grid), dim3(NWAVES * 64), LDS_BYTES, stream, a);
    }
#endif
}
```

```cpp
#include <hip/hip_runtime.h>
#include <cstdio>
#include <cstdint>
#include <cmath>
#define LAS __attribute__((address_space(3)))
#define GAS __attribute__((address_space(1)))
typedef _Float16 h16;
typedef _Float16 f16x8 __attribute__((ext_vector_type(8)));
typedef _Float16 f16x4 __attribute__((ext_vector_type(4)));
typedef _Float16 f16x2 __attribute__((ext_vector_type(2)));
typedef float f32x2 __attribute__((ext_vector_type(2)));
typedef float f32x4 __attribute__((ext_vector_type(4)));
typedef float f32x16 __attribute__((ext_vector_type(16)));
typedef unsigned u32x2 __attribute__((ext_vector_type(2)));
typedef unsigned u32x4 __attribute__((ext_vector_type(4)));
typedef short s16x4 __attribute__((ext_vector_type(4)));
__device__ __forceinline__ unsigned pk2h(float lo, float hi) { f32x2 v = {lo, hi}; f16x2 b = __builtin_convertvector(v, f16x2); return __builtin_bit_cast(unsigned, b); }

constexpr int DM = 1024, BATCH = 8, SEQ = 2048, DEPTH = 4, T = BATCH * SEQ;
constexpr int FOX_H = 16, FOX_D = 64, FOX_IN = 4 * DM + FOX_H;
constexpr int RET_H = 4, RET_DK = 256, RET_DV = 512, RET_IN = 6144;
constexpr int NG = 4, EPG = 8, NE = 32, EFF = 512;
constexpr int PAIRS = T * 2;
constexpr int LISTCAP = 16384;
constexpr int PROWS = PAIRS + NE * 256;
constexpr float EPS = 1e-6f;
constexpr float LOG2E = 1.4426950408889634f;

namespace pg8 {
constexpr int BM = 256, BK = 64, HALF = 128, HTB = HALF * BK * 2, STAGE_BYTES = 8 * HTB, NXCD = 8, WGM = 8;
__host__ __device__ __forceinline__ int lds_byte(int r, int c) { const int st = (r >> 4) * 2 + (c >> 5), rr = r & 15, cc = c & 31, ob = rr * 64 + cc * 2; return st * 1024 + (ob ^ (((ob >> 9) & 1) << 5)); }
__host__ __device__ __forceinline__ void stage_rc(int b, int& R, int& C) { const int st = b / 1024, sb = b % 1024, swz = sb ^ (((sb >> 9) & 1) << 5); R = (st >> 1) * 16 + swz / 64; C = (st & 1) * 32 + (swz % 64) / 2; }
__host__ __device__ __forceinline__ int perm32(int rho) { const int n = rho >> 4, i = rho & 15; return 8 * (i >> 2) + 4 * n + (i & 3); }

struct Unit { int pm, pn, e, mt; };

struct StaticOrder {
    int nM, nN, nwg, G, c, K; const char* A; const char* Bt;
    __device__ void init(const void* A_, const void* Bt_, int M, int N, int K_, int G_, int c_) { A = (const char*)A_; Bt = (const char*)Bt_; K = K_; nM = M / BM; nN = N / BM; nwg = nM * nN; G = G_; c = c_; }
    __device__ bool next(int i, Unit& u) const {
        const long L = (long)i * G + c; if (L >= nwg) return false;
        int wgid = (int)L; { const int q = nwg / NXCD, r = nwg % NXCD, xcd = wgid % NXCD, off = wgid / NXCD; wgid = (xcd < r ? xcd * (q + 1) : r * (q + 1) + (xcd - r) * q) + off; }
        const int nig = WGM * nN, gid = wgid / nig, fm = gid * WGM, gsz = (nM - fm) < WGM ? (nM - fm) : WGM;
        u.pm = fm + ((wgid % nig) % gsz); u.pn = (wgid % nig) / gsz; u.e = 0; u.mt = 0; return true;
    }
    __device__ __forceinline__ const char* abase() const { return A; }
    __device__ __forceinline__ void aoff(const Unit& u, const int (&R)[2], const int (&C)[2], unsigned (&ao)[2][2]) const {
#pragma unroll
        for (int h = 0; h < 2; ++h)
#pragma unroll
            for (int i = 0; i < 2; ++i) ao[h][i] = (unsigned)(((size_t)(u.pm * BM + h * HALF + R[i]) * K + C[i]) * 2);
    }
    __device__ __forceinline__ const char* bbase(const Unit& u) const { return Bt + (size_t)u.pn * BM * K * 2; }
};

#define PG8_WAIT_V(n) asm volatile("s_waitcnt vmcnt(" #n ")" ::: "memory")
#define PG8_WAIT_L(n) asm volatile("s_waitcnt lgkmcnt(" #n ")" ::: "memory")
#define PG8_BAR __builtin_amdgcn_s_barrier()
#define PG8_SCHED __builtin_amdgcn_sched_barrier(0)

template <class Epi, class Sched, bool ALIGN_EPI>
__device__ __forceinline__ void gemm_phase(LAS unsigned char* lds, const int K, const Sched& S, const Epi& E, const int tid) {
    const int wid = __builtin_amdgcn_readfirstlane(tid >> 6), lane = tid & 63, wr = wid >> 2, wc = wid & 3, fr = lane & 15, fq = lane >> 4;
    const int nt = K / BK;
    int Rr[2], Cc[2]; unsigned voffB[2];
#pragma unroll
    for (int i = 0; i < 2; ++i) { int R, C; stage_rc(tid * 16 + i * 8192, R, C); Rr[i] = R; Cc[i] = C; const int Rb = Epi::PERM ? ((R & ~31) + perm32(R & 31)) : R; voffB[i] = (unsigned)(Rb * K + C) * 2u; }
    const size_t kstep = (size_t)(BK * 2);
    const size_t hstep = (size_t)HALF * K * 2;
    const unsigned ldsw = (unsigned)wid * 1024u;
    const int aoff_l = lds_byte(wr * 64 + fr, fq * 8), boff_l = lds_byte(wc * 32 + fr, fq * 8);
    const char* const gA = S.abase();
#define PG8_SA(b, h) (((b) * 2 + (h)) * HTB)
#define PG8_SB(b, h) ((4 + (b) * 2 + (h)) * HTB)
#define PG8_STAGE(bufoff, gbase, voff) do { _Pragma("unroll") for (int _i = 0; _i < 2; ++_i) \
        __builtin_amdgcn_global_load_lds((const unsigned*)((const char*)(gbase) + (voff)[_i]), (LAS unsigned*)(lds + (bufoff) + ldsw + _i * 8192), 16, 0, 0); } while (0)
#define PG8_STAGEA(bufoff, o0, o1, kb) do { \
        __builtin_amdgcn_global_load_lds((const unsigned*)((gA + (kb)) + (o0)), (LAS unsigned*)(lds + (bufoff) + ldsw), 16, 0, 0); \
        __builtin_amdgcn_global_load_lds((const unsigned*)((gA + (kb)) + (o1)), (LAS unsigned*)(lds + (bufoff) + ldsw + 8192), 16, 0, 0); } while (0)
#define PG8_LDA(dst, b, h) do { _Pragma("unroll") for (int m = 0; m < 4; ++m) _Pragma("unroll") for (int k = 0; k < 2; ++k) dst[m][k] = *(const LAS f16x8*)(lds + PG8_SA(b, h) + aoff_l + m * 2048 + k * 1024); } while (0)
#define PG8_LDB(dst, b, h) do { _Pragma("unroll") for (int n = 0; n < 2; ++n) _Pragma("unroll") for (int k = 0; k < 2; ++k) dst[n][k] = *(const LAS f16x8*)(lds + PG8_SB(b, h) + boff_l + n * 2048 + k * 1024); } while (0)
#define PG8_MMA(ai, bj, At, Bt) do { __builtin_amdgcn_s_setprio(1); _Pragma("unroll") for (int m = 0; m < 4; ++m) _Pragma("unroll") for (int n = 0; n < 2; ++n) _Pragma("unroll") for (int k = 0; k < 2; ++k) \
        acc[ai][bj][m][n] = __builtin_amdgcn_mfma_f32_16x16x32_f16(Bt[n][k], At[m][k], acc[ai][bj][m][n], 0, 0, 0); __builtin_amdgcn_s_setprio(0); } while (0)
    Unit cur, nxt; int ui = 0;
    if (!S.next(0, cur)) return;
    f32x4 acc[2][2][4][2];
#pragma unroll
    for (int a = 0; a < 2; ++a)
#pragma unroll
        for (int b = 0; b < 2; ++b)
#pragma unroll
            for (int m = 0; m < 4; ++m)
#pragma unroll
                for (int n = 0; n < 2; ++n) acc[a][b][m][n] = (f32x4){0.f, 0.f, 0.f, 0.f};
    f16x8 At[4][2], B0[2][2], B1[2][2];
    unsigned aoC[2][2], aoN[2][2];
    S.aoff(cur, Rr, Cc, aoC);
    const char* cB = S.bbase(cur);
    PG8_STAGE(PG8_SB(0, 0), cB, voffB); PG8_STAGE(PG8_SB(0, 1), cB + hstep, voffB); PG8_STAGEA(PG8_SA(0, 0), aoC[0][0], aoC[0][1], 0); PG8_STAGEA(PG8_SA(0, 1), aoC[1][0], aoC[1][1], 0);
    if (wr == 1) PG8_BAR;
    PG8_WAIT_V(2); PG8_BAR;
    PG8_STAGE(PG8_SB(1, 0), cB + kstep, voffB); PG8_STAGEA(PG8_SA(1, 0), aoC[0][0], aoC[0][1], kstep); PG8_STAGE(PG8_SB(1, 1), cB + hstep + kstep, voffB);
    PG8_WAIT_V(6); PG8_BAR;
    for (;;) {
        const bool has_next = S.next(ui + 1, nxt);
        const char* nB = cB;
#pragma unroll
        for (int h = 0; h < 2; ++h)
#pragma unroll
            for (int i = 0; i < 2; ++i) aoN[h][i] = aoC[h][i];
        if (has_next) { S.aoff(nxt, Rr, Cc, aoN); nB = S.bbase(nxt); }
        for (int t = 0; t < nt; t += 2) {
            const bool last = (t == nt - 2);
            const size_t k1 = (size_t)(t + 1) * kstep;
            const size_t k2 = last ? 0 : (size_t)(t + 2) * kstep, k3 = k2 + kstep;
            const unsigned a2_00 = last ? aoN[0][0] : aoC[0][0], a2_01 = last ? aoN[0][1] : aoC[0][1], a2_10 = last ? aoN[1][0] : aoC[1][0], a2_11 = last ? aoN[1][1] : aoC[1][1];
            const char* b2 = (last ? nB : cB) + k2; const char* b3 = b2 + kstep;
            PG8_LDB(B0, 0, 0); PG8_LDB(B1, 0, 1); PG8_SCHED; PG8_LDA(At, 0, 0); PG8_STAGEA(PG8_SA(1, 1), aoC[1][0], aoC[1][1], k1);
            PG8_WAIT_V(8); PG8_WAIT_L(0); PG8_BAR; PG8_MMA(0, 0, At, B0); PG8_MMA(0, 1, At, B1); PG8_BAR; PG8_SCHED;
            PG8_LDA(At, 0, 1); PG8_STAGE(PG8_SB(0, 0), b2, voffB); PG8_STAGE(PG8_SB(0, 1), b2 + hstep, voffB); PG8_STAGEA(PG8_SA(0, 0), a2_00, a2_01, k2);
            PG8_WAIT_V(8); PG8_WAIT_L(0); PG8_BAR; PG8_MMA(1, 0, At, B0); PG8_MMA(1, 1, At, B1); PG8_BAR; PG8_SCHED;
            PG8_LDB(B0, 1, 0); PG8_LDB(B1, 1, 1); PG8_SCHED; PG8_LDA(At, 1, 0); PG8_STAGEA(PG8_SA(0, 1), a2_10, a2_11, k2);
            PG8_WAIT_V(8); PG8_WAIT_L(0); PG8_BAR; PG8_MMA(0, 0, At, B0); PG8_MMA(0, 1, At, B1); PG8_BAR; PG8_SCHED;
            PG8_LDA(At, 1, 1); PG8_STAGE(PG8_SB(1, 0), b3, voffB); PG8_STAGE(PG8_SB(1, 1), b3 + hstep, voffB); PG8_STAGEA(PG8_SA(1, 0), a2_00, a2_01, k3);
            PG8_WAIT_V(8); PG8_WAIT_L(0); PG8_BAR; PG8_MMA(1, 0, At, B0); PG8_MMA(1, 1, At, B1); PG8_BAR; PG8_SCHED;
        }
        if constexpr (ALIGN_EPI) { if (wr == 0) PG8_BAR; }
        E(acc, cur, wr, wc, fr, fq);
        if (!has_next) break;
#pragma unroll
        for (int a = 0; a < 2; ++a)
#pragma unroll
            for (int b = 0; b < 2; ++b)
#pragma unroll
                for (int m = 0; m < 4; ++m)
#pragma unroll
                    for (int n = 0; n < 2; ++n) acc[a][b][m][n] = (f32x4){0.f, 0.f, 0.f, 0.f};
        cur = nxt; cB = nB; ++ui;
#pragma unroll
        for (int h = 0; h < 2; ++h)
#pragma unroll
            for (int i = 0; i < 2; ++i) aoC[h][i] = aoN[h][i];
        if constexpr (ALIGN_EPI) { if (wr == 1) PG8_BAR; }
    }
    PG8_WAIT_V(0);
    if constexpr (!ALIGN_EPI) { if (wr == 0) PG8_BAR; }
    PG8_BAR;
#undef PG8_SA
#undef PG8_SB
#undef PG8_STAGE
#undef PG8_STAGEA
#undef PG8_LDA
#undef PG8_LDB
#undef PG8_MMA
}

struct EpiH16 {
    static constexpr bool PERM = true;
    h16* O; int ldc; int split_cols; size_t split_stride; const float* rstd; float scale0, scale1; int rot; const float* ct; const float* st;
    __device__ __forceinline__ void operator()(const f32x4 (&acc)[2][2][4][2], const Unit& u, int wr, int wc, int fr, int fq) const {
        const int row0 = u.pm * BM + wr * 64 + fr; int colt = u.pn * BM; h16* base = O;
        const int t = colt / split_cols; base += (size_t)t * split_stride; colt -= t * split_cols;
        const float sc = (t == 0) ? scale0 : ((t == 1) ? scale1 : 1.f);
        const int col0 = colt + wc * 32 + 8 * fq;
        const bool dorot = rot && (t < 2);
#pragma unroll
        for (int ai = 0; ai < 2; ++ai)
#pragma unroll
            for (int m = 0; m < 4; ++m) {
                const int row = row0 + ai * HALF + m * 16; const float rs = rstd[row] * sc;
                h16* rowp = base + (size_t)row * ldc + col0;
                if (dorot) {
                    const int pos = row & (SEQ - 1); const int d0 = wc * 32 + 8 * fq;
                    const f32x4 c0 = *(const f32x4*)(ct + pos * 128 + d0), c1 = *(const f32x4*)(ct + pos * 128 + d0 + 4);
                    const f32x4 s0 = *(const f32x4*)(st + pos * 128 + d0), s1 = *(const f32x4*)(st + pos * 128 + d0 + 4);
                    const f32x4 a0 = acc[ai][0][m][0] * rs, a1 = acc[ai][0][m][1] * rs, b0 = acc[ai][1][m][0] * rs, b1 = acc[ai][1][m][1] * rs;
                    const f32x4 o10 = a0 * c0 - b0 * s0, o11 = a1 * c1 - b1 * s1, o20 = a0 * s0 + b0 * c0, o21 = a1 * s1 + b1 * c1;
                    u32x4 w; w.x = pk2h(o10[0], o10[1]); w.y = pk2h(o10[2], o10[3]); w.z = pk2h(o11[0], o11[1]); w.w = pk2h(o11[2], o11[3]);
                    *(u32x4*)(rowp) = w;
                    w.x = pk2h(o20[0], o20[1]); w.y = pk2h(o20[2], o20[3]); w.z = pk2h(o21[0], o21[1]); w.w = pk2h(o21[2], o21[3]);
                    *(u32x4*)(rowp + HALF) = w;
                } else {
#pragma unroll
                    for (int bj = 0; bj < 2; ++bj) { const f32x4 v0 = acc[ai][bj][m][0] * rs, v1 = acc[ai][bj][m][1] * rs;
                        u32x4 w; w.x = pk2h(v0[0], v0[1]); w.y = pk2h(v0[2], v0[3]); w.z = pk2h(v1[0], v1[1]); w.w = pk2h(v1[2], v1[3]);
                        *(u32x4*)(rowp + bj * HALF) = w; }
                }
            }
    }
};
struct EpiResid {
    static constexpr bool PERM = false;
    float* H; int ldc;
    __device__ __forceinline__ void operator()(const f32x4 (&acc)[2][2][4][2], const Unit& u, int wr, int wc, int fr, int fq) const {
        const int col0 = u.pn * BM + wc * 32 + 4 * fq, row0 = u.pm * BM + wr * 64 + fr;
#pragma unroll
        for (int ai = 0; ai < 2; ++ai)
#pragma unroll
            for (int m = 0; m < 4; ++m) { float* rp = H + (size_t)(row0 + ai * HALF + m * 16) * ldc + col0;
#pragma unroll
                for (int bj = 0; bj < 2; ++bj)
#pragma unroll
                    for (int n = 0; n < 2; ++n) { f32x4* p = (f32x4*)(rp + bj * HALF + n * 16); *p = *p + acc[ai][bj][m][n]; } }
    }
};
struct EpiStoreF32 {
    static constexpr bool PERM = false;
    float* Y; int ldc;
    __device__ __forceinline__ void operator()(const f32x4 (&acc)[2][2][4][2], const Unit& u, int wr, int wc, int fr, int fq) const {
        const int col0 = u.pn * BM + wc * 32 + 4 * fq, row0 = u.pm * BM + wr * 64 + fr;
#pragma unroll
        for (int ai = 0; ai < 2; ++ai)
#pragma unroll
            for (int m = 0; m < 4; ++m) { float* rp = Y + (size_t)(row0 + ai * HALF + m * 16) * ldc + col0;
#pragma unroll
                for (int bj = 0; bj < 2; ++bj)
#pragma unroll
                    for (int n = 0; n < 2; ++n) *(f32x4*)(rp + bj * HALF + n * 16) = acc[ai][bj][m][n]; }
    }
};
struct EpiStoreH16 {
    static constexpr bool PERM = true;
    h16* Y; int ldc;
    __device__ __forceinline__ void operator()(const f32x4 (&acc)[2][2][4][2], const Unit& u, int wr, int wc, int fr, int fq) const {
        const int col0 = u.pn * BM + wc * 32 + 8 * fq, row0 = u.pm * BM + wr * 64 + fr;
#pragma unroll
        for (int ai = 0; ai < 2; ++ai)
#pragma unroll
            for (int m = 0; m < 4; ++m) { h16* rp = Y + (size_t)(row0 + ai * HALF + m * 16) * ldc + col0;
#pragma unroll
                for (int bj = 0; bj < 2; ++bj) { const f32x4 v0 = acc[ai][bj][m][0], v1 = acc[ai][bj][m][1];
                    u32x4 w; w.x = pk2h(v0[0], v0[1]); w.y = pk2h(v0[2], v0[3]); w.z = pk2h(v1[0], v1[1]); w.w = pk2h(v1[2], v1[3]);
                    *(u32x4*)(rp + bj * HALF) = w; } }
    }
};
struct EpiSwiGLU {
    static constexpr bool PERM = true;
    h16* ACT; const float* rstd; const int* list; const int* cnt;
    __device__ __forceinline__ void operator()(const f32x4 (&acc)[2][2][4][2], const Unit& u, int wr, int wc, int fr, int fq) const {
        const int row0 = u.pm * BM + wr * 64 + fr, rank0 = u.mt * BM + wr * 64 + fr; const int c = cnt[u.e];
        const int col0 = u.pn * 128 + wc * 16 + 4 * fq;
#pragma unroll
        for (int ai = 0; ai < 2; ++ai)
#pragma unroll
            for (int m = 0; m < 4; ++m) {
                const int rank = rank0 + ai * HALF + m * 16; float rs = 0.f;
                if (rank < c) rs = rstd[list[u.e * LISTCAP + rank] >> 1];
                h16* rowp = ACT + (size_t)(row0 + ai * HALF + m * 16) * EFF + col0;
#pragma unroll
                for (int bj = 0; bj < 2; ++bj) { const f32x4 a = acc[ai][bj][m][0] * rs, b = acc[ai][bj][m][1] * rs; f32x4 o;
#pragma unroll
                    for (int q = 0; q < 4; ++q) o[q] = a[q] * __builtin_amdgcn_rcpf(1.0f + __builtin_amdgcn_exp2f(-a[q] * LOG2E)) * b[q];
                    u32x2 w; w.x = pk2h(o[0], o[1]); w.y = pk2h(o[2], o[3]); *(u32x2*)(rowp + bj * 64) = w; }
            }
    }
};
}
namespace attn_body {
constexpr int D = 64, DMP = 1024;
constexpr int NW = 8, QBLK = 32, QB = QBLK * NW, KVBLK = 64, NQB = SEQ / QB;
__device__ __forceinline__ int crow(int r, int hi) { return (r & 3) + 8 * (r >> 2) + 4 * hi; }
#define SBAR() __builtin_amdgcn_sched_barrier(0)
__device__ __forceinline__ void cmask(f32x16& p0, f32x16& p1, int jb, int qrel, int hi) {
    const float NEG = -INFINITY; int kb = 64 * jb + 4 * hi;
#pragma unroll
    for (int r = 0; r < 16; ++r) { int kv = kb + (r & 3) + 8 * (r >> 2); if (kv > qrel) p0[r] = NEG; if (kv + 32 > qrel) p1[r] = NEG; }
}
constexpr int NSLOT = 3, SLOTB = 8192;
constexpr int LDS_K = 0, LDS_V = NSLOT * SLOTB, LDS_WS = 2 * NSLOT * SLOTB, LDS_OST = LDS_WS + NW * 64 * 4, LDS_BIAS = LDS_OST + NW * 4096, LDS_BYTES = LDS_BIAS + SEQ * 4;
constexpr float C2 = 0.125f * LOG2E;
__device__ __forceinline__ void glds16(const void* gsrc, unsigned lds_dst) { unsigned keep;
    asm volatile("s_mov_b32 %0, m0\n\ts_mov_b32 m0, %2\n\ts_nop 0\n\tglobal_load_lds_dwordx4 %1, off\n\ts_mov_b32 m0, %0" : "=&s"(keep) : "v"(gsrc), "s"(lds_dst) : "memory"); }
__device__ __forceinline__ float max3f(float a, float b, float c) { float r; asm("v_max3_f32 %0, %1, %2, %3" : "=v"(r) : "v"(a), "v"(b), "v"(c)); return r; }
__device__ __forceinline__ float max2f(float a, float b) { float r; asm("v_max_f32_e32 %0, %1, %2" : "=v"(r) : "v"(a), "v"(b)); return r; }
__device__ __forceinline__ float fadd_s(float a, float b) { float r; asm("v_add_f32_e32 %0, %1, %2" : "=v"(r) : "v"(a), "v"(b)); return r; }
__device__ __forceinline__ float fsub_s(float a, float b) { float r; asm("v_sub_f32_e32 %0, %1, %2" : "=v"(r) : "v"(a), "v"(b)); return r; }
__device__ __forceinline__ unsigned split_hl(float v) { const h16 hi = (h16)v; const h16 lo = (h16)(v - (float)hi); return (unsigned)__builtin_bit_cast(unsigned short, hi) | ((unsigned)__builtin_bit_cast(unsigned short, lo) << 16); }
#define WAIT_BAR(N) asm volatile("s_waitcnt vmcnt(" #N ") lgkmcnt(0)\n\ts_barrier" ::: "memory")
#define MF16(a, b, c) __builtin_amdgcn_mfma_f32_32x32x16_f16(a, b, c, 0, 0, 0)
typedef LAS const char* lds_cptr;
typedef short v4i16_t __attribute__((ext_vector_type(4)));
__device__ __forceinline__ void kload8(f16x8* kf, lds_cptr kp) {
    kf[0] = *(const LAS f16x8*)(kp);        kf[1] = *(const LAS f16x8*)(kp + 512);
    kf[2] = *(const LAS f16x8*)(kp + 2048); kf[3] = *(const LAS f16x8*)(kp + 2560);
    kf[4] = *(const LAS f16x8*)(kp + 4096); kf[5] = *(const LAS f16x8*)(kp + 4608);
    kf[6] = *(const LAS f16x8*)(kp + 6144); kf[7] = *(const LAS f16x8*)(kp + 6656);
}
__device__ __forceinline__ void kload2(f16x8* kf, lds_cptr kp, int j) { kf[2 * j] = *(const LAS f16x8*)(kp + j * 2048); kf[2 * j + 1] = *(const LAS f16x8*)(kp + j * 2048 + 512); }
__device__ __forceinline__ s16x4 vtr(lds_cptr p) { return __builtin_bit_cast(s16x4, __builtin_amdgcn_ds_read_tr16_b64_v4i16((LAS v4i16_t*)p)); }
__device__ __forceinline__ f16x8 mk8(s16x4 lo, s16x4 hi) { typedef short s16x8 __attribute__((ext_vector_type(8))); s16x8 t = {lo[0], lo[1], lo[2], lo[3], hi[0], hi[1], hi[2], hi[3]}; return __builtin_bit_cast(f16x8, t); }
__device__ __forceinline__ f16x4 ext_frag(unsigned w0, unsigned w1) { u32x2 t = {w0, w1}; return __builtin_bit_cast(f16x4, t); }
#define MF8(a, b, c) __builtin_amdgcn_mfma_f32_32x32x8f16(a, b, c, 0, 0, 0)
__device__ __forceinline__ float rowmax(const f32x16& p0, const f32x16& p1) {
    float a = max3f(p0[0], p0[1], p1[0]), b = max3f(p0[2], p0[3], p1[1]); a = max3f(a, p1[2], p1[3]);
#pragma unroll
    for (int r = 4; r < 16; r += 4) { a = max3f(a, p0[r], p0[r + 1]); b = max3f(b, p0[r + 2], p0[r + 3]); a = max3f(a, p1[r], p1[r + 1]); b = max3f(b, p1[r + 2], p1[r + 3]); }
    const float m = max2f(a, b);
    auto rr = __builtin_amdgcn_permlane32_swap(__float_as_uint(m), __float_as_uint(m), false, false);
    return max2f(__uint_as_float(rr[0]), __uint_as_float(rr[1]));
}
__device__ __forceinline__ void qkt(f32x16& p0, f32x16& p1, const char* Kslot, const f16x8* qr, f16x4 kb0, f16x4 kb1, f16x4 qe, int r32, int hi) {
    const char* kb = Kslot + hi * 1024 + r32 * 16;
    const f32x16 z = {};
    p0 = MF8(kb0, qe, z); p1 = MF8(kb1, qe, z);
#pragma unroll
    for (int d0 = 0; d0 < 4; ++d0) {
        const f16x8 b0 = *reinterpret_cast<const f16x8*>(kb + d0 * 2048);
        const f16x8 b1 = *reinterpret_cast<const f16x8*>(kb + d0 * 2048 + 512);
        p0 = MF16(b0, qr[d0], p0); p1 = MF16(b1, qr[d0], p1); }
}
__device__ __forceinline__ void pv(f32x16* o, int vb, f16x8 pa0, f16x8 pa1, f16x8 pa2, f16x8 pa3) {
#pragma unroll
    for (int d0 = 0; d0 < 2; ++d0) { s16x4 lo[4], hi[4];
#pragma unroll
        for (int ks = 0; ks < 4; ++ks) {
            asm volatile("ds_read_b64_tr_b16 %0,%1 offset:%c2" : "=&v"(lo[ks]) : "v"(vb), "i"(d0 * 4096 + ks * 1024) : "memory");
            asm volatile("ds_read_b64_tr_b16 %0,%1 offset:%c2" : "=&v"(hi[ks]) : "v"(vb), "i"(d0 * 4096 + ks * 1024 + 512) : "memory"); }
        asm volatile("s_waitcnt lgkmcnt(0)" ::: "memory"); SBAR();
        o[d0] = MF16(pa0, mk8(lo[0], hi[0]), o[d0]);
        o[d0] = MF16(pa1, mk8(lo[1], hi[1]), o[d0]);
        o[d0] = MF16(pa2, mk8(lo[2], hi[2]), o[d0]);
        o[d0] = MF16(pa3, mk8(lo[3], hi[3]), o[d0]);
    }
}
#define ATTN_ONES 0x3C003C00u
template <int THRL> __device__ __forceinline__ void attn_unit(int b, int h, int qb, const h16* Q, const h16* __restrict__ K, const h16* __restrict__ V, const h16* __restrict__ G, const float* __restrict__ cum, h16* O, char* shm, const int tid) {
    const int lane = tid & 63, r32 = lane & 31, hi = lane >> 5; const int wid = __builtin_amdgcn_readfirstlane(tid >> 6);
    const long rowbase = (long)b * SEQ; const int q0 = qb * QB;
    const h16* Qw = Q + (rowbase + q0 + wid * QBLK) * DMP + h * D;
    const h16* Kh = K + rowbase * DMP + h * D, *Vh = V + rowbase * DMP + h * D;
    const unsigned lds0 = (unsigned)(uintptr_t)shm;
    float* wsf = (float*)(shm + LDS_WS) + wid * 64;
    const h16* ksrc = Kh + (long)lane * DMP + wid * 8;
    const h16* vsrc = Vh + (long)(16 * (wid & 3) + (lane >> 2)) * DMP + (wid >> 2) * 32 + (lane & 3) * 8;
    const unsigned kdst = lds0 + LDS_K + wid * 1024, vdst = lds0 + LDS_V + wid * 1024;
#define DMA_K(t, slot) glds16(ksrc + (long)(t) * KVBLK * DMP, (unsigned)__builtin_amdgcn_readfirstlane(kdst + (slot)))
#define DMA_V(t, slot) glds16(vsrc + (long)(t) * KVBLK * DMP, (unsigned)__builtin_amdgcn_readfirstlane(vdst + (slot)))
    const int vb0 = (int)(lds0 + LDS_V) + ((lane >> 4) & 1) * 32 + (lane & 3) * 8 + (4 * hi + ((lane & 15) >> 2)) * 64;
    const char* Kbase = shm + LDS_K; f16x8 kf[8];
    const lds_cptr shm3 = (lds_cptr)shm; const lds_cptr kp0 = shm3 + LDS_K + hi * 1024 + r32 * 16; const lds_cptr vp0 = shm3 + LDS_V + ((lane >> 4) & 1) * 32 + (lane & 3) * 8 + (4 * hi + ((lane & 15) >> 2)) * 64;
    const LAS unsigned* biasw = (const LAS unsigned*)(shm3 + LDS_BIAS);
    const int NT = (q0 + QB) / KVBLK;
    DMA_K(0, 0); DMA_V(0, 0); DMA_K(1, SLOTB);
    { const float* cb = cum + (long)(b * FOX_H + h) * SEQ; const float cref = cb[q0];
      LAS unsigned* bw = (LAS unsigned*)(shm3 + LDS_BIAS);
      for (int j = tid; j < q0 + QB; j += NW * 64) bw[j] = split_hl(fmaxf((cref - cb[j]) * LOG2E, -30000.f)); }
    f16x8 qr[4];
#pragma unroll
    for (int d0 = 0; d0 < 4; ++d0) qr[d0] = *reinterpret_cast<const f16x8*>(&Qw[(long)r32 * DMP + d0 * 16 + hi * 8]);
    float mhat = 0.f, l_reg = 0.f; f32x16 o[2]; o[0] = f32x16{}; o[1] = f32x16{};
    unsigned qew1 = 0u;
    const unsigned qew0 = hi ? 0u : ATTN_ONES, kew1 = hi ? 0u : ATTN_ONES;
#define QE() ext_frag(qew0, qew1)
#define KE(w) ext_frag(hi ? 0u : (w), kew1)
#define SETM() do { qew1 = hi ? 0u : split_hl(-mhat); } while (0)
    const int qrel = wid * QBLK + r32;
#define CMASK(P0, P1, t) do { int jb_ = (t) - (NT - 4); if (jb_ >= 0) cmask(P0, P1, jb_, qrel, hi); } while (0)
    bool resc = false;
#define START(P0, P1) do { const float rm = rowmax(P0, P1); resc = false; \
    { const float dl = rm; mhat = fadd_s(mhat, dl); \
      _Pragma("unroll") for (int r = 0; r < 16; ++r) { P0[r] = fsub_s(P0[r], dl); P1[r] = fsub_s(P1[r], dl); } \
      SETM(); } \
    _Pragma("unroll") for (int r = 0; r < 16; ++r) P0[r] = __builtin_amdgcn_exp2f(P0[r]); } while (0)
#define RESC() do { if (resc) { asm volatile("s_waitcnt lgkmcnt(0)" ::: "memory"); \
      _Pragma("unroll") for (int d_ = 0; d_ < 2; ++d_) _Pragma("unroll") for (int r = 0; r < 16; ++r) o[d_][r] *= wsf[crow(r, hi)]; } } while (0)
    f32x16 pA0, pA1, pB0, pB1;
    int sl_prev = 0, sl_cur = 0, sl_next = SLOTB;
#define ROT() do { sl_prev = sl_cur; sl_cur = sl_next; sl_next = (sl_next == (NSLOT - 1) * SLOTB) ? 0 : sl_next + SLOTB; } while (0)
    DMA_K(2, 2 * SLOTB);
    WAIT_BAR(3);
    unsigned bw0 = biasw[r32], bw1 = biasw[32 + r32];
    qkt(pA0, pA1, Kbase, qr, KE(bw0), KE(bw1), QE(), r32, hi); asm volatile("s_nop 15\n\ts_nop 7" : "+v"(pA0), "+v"(pA1)); CMASK(pA0, pA1, 0);
    START(pA0, pA1);
    _Pragma("unroll") for (int r = 0; r < 16; ++r) pA1[r] = __builtin_amdgcn_exp2f(pA1[r]);
    WAIT_BAR(0);
    DMA_K(3, 0); DMA_V(1, SLOTB);
    ROT();
    kload8(kf, kp0 + sl_cur);
    bw0 = biasw[64 + r32]; bw1 = biasw[96 + r32];
    WAIT_BAR(2);
    s16x4 vlo[8], vhi[8]; u32x4 pw0, pw1, pw2, pw3;
#define PKW(P, B) pk2h(P[B], P[B + 1])
#define PAF(k) __builtin_bit_cast(f16x8, pw##k)
#define VFR(i) mk8(vlo[i], vhi[i])
#define PIN(x) asm volatile("" : "+v"(x))
#define MX3(a, b, c) __builtin_fmaxf(__builtin_fmaxf((a), (b)), (c))
#define GAPA(MF, A0, A1, A2, A3, W0, W1, PW) do { MF; sacc += A0; sacc += A1; sacc += A2; sacc += A3; PIN(sacc); W0; W1; PIN(PW); SBAR(); } while (0)
#define EX(v) __builtin_amdgcn_exp2f(v)
#define GAPB(MF, X, B) do { MF; X[B] = EX(X[B]); X[B + 1] = EX(X[B + 1]); X[B + 2] = EX(X[B + 2]); X[B + 3] = EX(X[B + 3]); PIN(X); SBAR(); } while (0)
#define VRD(i) do { vlo[i] = vtr(vp_ + (((i) >> 2) * 4096 + ((i) & 3) * 1024)); vhi[i] = vtr(vp_ + (((i) >> 2) * 4096 + ((i) & 3) * 1024 + 512)); } while (0)
#define KRD(G_, j) do { if (G_) { kload2(kf, kp0 + sl_next, j); SBAR(); } } while (0)
#define STEP(C0, C1, P0, P1, t, GK, GV, GL) do { SBAR(); \
    const lds_cptr vp_ = vp0 + sl_prev; const f32x16 z_ = {}; \
    C0 = MF8(KE(bw0), QE(), z_); C1 = MF8(KE(bw1), QE(), z_); SBAR(); \
    VRD(0); SBAR(); float sacc = (P0[0] + P0[1]); \
    GAPA(C0 = MF16(kf[0], qr[0], C0), P0[2], P0[3], P0[4], P0[5],     pw0[0] = PKW(P0, 0), pw0[1] = PKW(P0, 2), pw0); \
    VRD(4); SBAR(); GAPA(C1 = MF16(kf[1], qr[0], C1), P0[6], P0[7], P0[8], P0[9],     pw0[2] = PKW(P0, 4), pw0[3] = PKW(P0, 6), pw0); \
    VRD(1); SBAR(); GAPA(C0 = MF16(kf[2], qr[1], C0),   P0[10], P0[11], P0[12], P0[13], pw1[0] = PKW(P0, 8), pw1[1] = PKW(P0, 10), pw1); \
    VRD(5); SBAR(); GAPA(C1 = MF16(kf[3], qr[1], C1),   P0[14], P0[15], P1[0], P1[1],   pw1[2] = PKW(P0, 12), pw1[3] = PKW(P0, 14), pw1); \
    VRD(2); SBAR(); GAPA(C0 = MF16(kf[4], qr[2], C0),   P1[2], P1[3], P1[4], P1[5],     pw2[0] = PKW(P1, 0), pw2[1] = PKW(P1, 2), pw2); \
    VRD(6); SBAR(); GAPA(C1 = MF16(kf[5], qr[2], C1),   P1[6], P1[7], P1[8], P1[9],     pw2[2] = PKW(P1, 4), pw2[3] = PKW(P1, 6), pw2); \
    VRD(3); SBAR(); GAPA(C0 = MF16(kf[6], qr[3], C0),   P1[10], P1[11], P1[12], P1[13], pw3[0] = PKW(P1, 8), pw3[1] = PKW(P1, 10), pw3); \
    VRD(7); SBAR(); GAPA(C1 = MF16(kf[7], qr[3], C1),   P1[14], P1[15], 0.f, 0.f,       pw3[2] = PKW(P1, 12), pw3[3] = PKW(P1, 14), pw3); \
    l_reg += sacc; \
    if (GK) { DMA_K((t) + 3, sl_cur); } if (GV) { DMA_V((t) + 1, sl_next); } \
    CMASK(C0, C1, t); \
    { float a = MX3(C0[0], C0[1], C1[0]), b_ = MX3(C0[2], C0[3], C1[1]); a = MX3(a, C1[2], C1[3]); \
      _Pragma("unroll") for (int r = 4; r < 16; r += 4) { a = MX3(a, C0[r], C0[r + 1]); b_ = MX3(b_, C0[r + 2], C0[r + 3]); a = MX3(a, C1[r], C1[r + 1]); b_ = MX3(b_, C1[r + 2], C1[r + 3]); } \
      float rm = __builtin_fmaxf(a, b_); { auto rr = __builtin_amdgcn_permlane32_swap(__float_as_uint(rm), __float_as_uint(rm), false, false); rm = __builtin_fmaxf(__uint_as_float(rr[0]), __uint_as_float(rr[1])); } \
      resc = false; \
      if (__builtin_expect(__any(rm > (float)THRL), 0)) { const float dl = __builtin_fmaxf(rm, 0.f); mhat += dl; \
        _Pragma("unroll") for (int r = 0; r < 16; ++r) { C0[r] -= dl; C1[r] -= dl; } \
        SETM(); \
        const float f = __builtin_amdgcn_exp2f(-dl); l_reg *= f; if (hi == 0) wsf[r32] = f; resc = true; } } \
    SBAR(); \
    if (GL) { bw0 = biasw[((t) + 1) * 64 + r32]; bw1 = biasw[((t) + 1) * 64 + 32 + r32]; } \
    GAPB(o[0] = MF16(PAF(0), VFR(0), o[0]), C0, 0); \
    GAPB(o[1] = MF16(PAF(0), VFR(4), o[1]), C0, 4); \
    KRD(GL, 0); GAPB(o[0] = MF16(PAF(1), VFR(1), o[0]), C0, 8); \
    KRD(GL, 1); GAPB(o[1] = MF16(PAF(1), VFR(5), o[1]), C0, 12); \
    KRD(GL, 2); GAPB(o[0] = MF16(PAF(2), VFR(2), o[0]), C1, 0); \
    KRD(GL, 3); GAPB(o[1] = MF16(PAF(2), VFR(6), o[1]), C1, 4); \
    GAPB(o[0] = MF16(PAF(3), VFR(3), o[0]), C1, 8); \
    GAPB(o[1] = MF16(PAF(3), VFR(7), o[1]), C1, 12); \
    } while (0)
    int t = 1;
#undef CMASK
#define CMASK(P0, P1, t) do {} while (0)
    for (; t + 5 < NT; t += 2) {
        STEP(pB0, pB1, pA0, pA1, t, true, true, true);     WAIT_BAR(2); RESC(); ROT();
        STEP(pA0, pA1, pB0, pB1, t + 1, true, true, true); WAIT_BAR(2); RESC(); ROT();
    }
#undef CMASK
#define CMASK(P0, P1, t) do { int jb_ = (t) - (NT - 4); if (jb_ >= 0) cmask(P0, P1, jb_, qrel, hi); } while (0)
#define ENDW(tt) do { if ((tt) + 3 < NT) { WAIT_BAR(2); } else if ((tt) + 2 < NT) { WAIT_BAR(1); } else { WAIT_BAR(0); } } while (0)
    for (; t + 1 < NT; t += 2) {
        STEP(pB0, pB1, pA0, pA1, t, (t + 3 < NT), (t + 1 < NT), (t + 1 < NT));         ENDW(t);     RESC(); ROT();
        STEP(pA0, pA1, pB0, pB1, t + 1, (t + 4 < NT), (t + 2 < NT), (t + 2 < NT));     ENDW(t + 1); RESC(); ROT();
    }
    STEP(pB0, pB1, pA0, pA1, NT - 1, false, false, false); RESC();
    { float sacc = pB0[0] + pB0[1]; _Pragma("unroll") for (int r = 2; r < 16; ++r) sacc += pB0[r]; _Pragma("unroll") for (int r = 0; r < 16; ++r) sacc += pB1[r]; l_reg += sacc;
      pw0 = (u32x4){PKW(pB0, 0), PKW(pB0, 2), PKW(pB0, 4), PKW(pB0, 6)}; pw1 = (u32x4){PKW(pB0, 8), PKW(pB0, 10), PKW(pB0, 12), PKW(pB0, 14)}; pw2 = (u32x4){PKW(pB1, 0), PKW(pB1, 2), PKW(pB1, 4), PKW(pB1, 6)}; pw3 = (u32x4){PKW(pB1, 8), PKW(pB1, 10), PKW(pB1, 12), PKW(pB1, 14)};
      SBAR(); pv(o, vb0 + sl_cur, PAF(0), PAF(1), PAF(2), PAF(3)); }
#undef PKW
#undef PAF
#undef VFR
#undef PIN
#undef MX3
#undef GAPA
#undef GAPB
#undef EX
#undef VRD
#undef KRD
#undef STEP
#undef ENDW
    { auto rr = __builtin_amdgcn_permlane32_swap(__float_as_uint(l_reg), __float_as_uint(l_reg), false, false); l_reg = __uint_as_float(rr[0]) + __uint_as_float(rr[1]); }
    if (hi == 0) wsf[32 + r32] = l_reg; asm volatile("s_waitcnt lgkmcnt(0)" ::: "memory");
    float rli[16];
#pragma unroll
    for (int r = 0; r < 16; ++r) rli[r] = __builtin_amdgcn_rcpf(wsf[32 + crow(r, hi)]);
    h16* Ow = O + (rowbase + q0 + wid * QBLK) * DMP + h * D;
    const h16* Gw = G + (rowbase + q0 + wid * QBLK) * DMP + h * D;
    { h16* stg = (h16*)(shm + LDS_OST) + wid * 2048;
#pragma unroll
      for (int r = 0; r < 16; ++r) { const int orow = crow(r, hi);
#pragma unroll
        for (int d0 = 0; d0 < 2; ++d0) stg[orow * 64 + d0 * 32 + r32] = (h16)(o[d0][r] * rli[r]); }
      asm volatile("s_waitcnt lgkmcnt(0)" ::: "memory");
#pragma unroll
      for (int i = 0; i < 4; ++i) { const int row = i * 8 + (lane >> 3), ch = lane & 7; const f16x8 v = *(const f16x8*)(stg + row * 64 + ch * 8); const f16x8 g = *(const f16x8*)(Gw + (long)row * DMP + ch * 8);
        float r8[8];
#pragma unroll
        for (int e = 0; e < 8; ++e) { const float gg = (float)g[e]; r8[e] = (float)v[e] * __builtin_amdgcn_rcpf(1.0f + __builtin_amdgcn_exp2f(-gg * LOG2E)); }
        u32x4 w; w.x = pk2h(r8[0], r8[1]); w.y = pk2h(r8[2], r8[3]); w.z = pk2h(r8[4], r8[5]); w.w = pk2h(r8[6], r8[7]);
        *(u32x4*)(Ow + (long)row * DMP + ch * 8) = w; } }
    asm volatile("s_waitcnt lgkmcnt(0)\n\ts_barrier" ::: "memory");
#undef DMA_K
#undef DMA_V
#undef CMASK
#undef START
#undef RESC
#undef ROT
#undef QE
#undef KE
#undef SETM
}
#undef SBAR
#undef WAIT_BAR
#undef MF16
#undef MF8
}
constexpr int NWAVES = 8;
#ifndef MK_N_LAUNCHES
#define MK_N_LAUNCHES 1
#endif
constexpr int NPHASE = 2 + 8 * DEPTH;
constexpr size_t MiB = 1u << 20;
constexpr size_t WS_CTL = 0, CTL_ZERO_BYTES = 1 * MiB;
constexpr size_t SZ_WFOX = (size_t)4096 * 1024 * 2, SZ_WFO = (size_t)1024 * 1024 * 2, SZ_WRET = (size_t)6144 * 1024 * 2, SZ_WRO = (size_t)1024 * 2048 * 2;
constexpr size_t SZ_WGU = (size_t)1024 * 1024 * 2, SZ_WD = (size_t)1024 * 512 * 2;
constexpr size_t WS_WFOX = 1 * MiB, WS_WFO = WS_WFOX + 2 * SZ_WFOX, WS_WRET = WS_WFO + 2 * SZ_WFO, WS_WRO = WS_WRET + 2 * SZ_WRET;
constexpr size_t WS_WGU = WS_WRO + 2 * SZ_WRO, WS_WD = WS_WGU + (size_t)DEPTH * NE * SZ_WGU, WS_WEND = WS_WD + (size_t)DEPTH * NE * SZ_WD;
constexpr size_t SZ_RW = (size_t)32 * 64 * 24 * 4, SZ_FW = (size_t)32 * 64 * 8 * 4;
constexpr size_t WS_RW = WS_WEND, WS_FW = WS_RW + DEPTH * SZ_RW, WS_ROPE = WS_FW + 2 * SZ_FW;
constexpr size_t WS_H = WS_ROPE + 2 * (size_t)SEQ * 128 * 4;
constexpr size_t WS_HN = WS_H + (size_t)T * DM * 4;
constexpr size_t WS_RSTD = WS_HN + (size_t)(T + 8) * DM * 2;
constexpr size_t WS_FLOG = WS_RSTD + (size_t)T * 4, WS_CUM = WS_FLOG + (size_t)T * 16 * 4;
constexpr size_t WS_EID = WS_CUM + (size_t)BATCH * FOX_H * SEQ * 4, WS_RANK = WS_EID + PAIRS * 4, WS_GATE = WS_RANK + PAIRS * 4, WS_LIST = WS_GATE + PAIRS * 4;
constexpr size_t WS_QKVG = (WS_LIST + (size_t)NE * LISTCAP * 4 + 255) & ~(size_t)255;
constexpr size_t SZ_T1K = (size_t)T * 1024 * 2;
constexpr size_t WS_OG = WS_QKVG + 6 * SZ_T1K;
constexpr size_t WS_RO = WS_OG + 2 * SZ_T1K;
constexpr size_t WS_END0 = WS_RO + 2 * SZ_T1K;
constexpr size_t WS_DUMMY = WS_END0;
constexpr size_t WS_END = WS_DUMMY + 160 * MiB;
constexpr size_t WS_Y = WS_QKVG;
constexpr size_t WS_ACT = WS_RO;
static_assert((size_t)PROWS * 1024 * 2 <= 6 * SZ_T1K && (size_t)PROWS * 512 * 2 <= 2 * SZ_T1K, "overlays");
constexpr int CW_TMO = 0, CW_BAR = 4096, CW_CNT = 16384, CW_CNT2 = 16384 + 1024;
constexpr int RING_BYTES = 147456;
constexpr int LDSCTL_OFF = RING_BYTES, MISC_OFF = LDSCTL_OFF;
constexpr int LDS_BYTES = RING_BYTES + 1024;

typedef GAS unsigned gu32;
#define RLX_AGENT __ATOMIC_RELAXED, __HIP_MEMORY_SCOPE_AGENT
#define LDS_WAIT() asm volatile("s_waitcnt lgkmcnt(0)" ::: "memory")

#define XB_TMO      128
#define XB_XCNT(j)  (256  + 64 * (j))
#define XB_XSUB(j)  (1280 + 64 * (j))
#define XB_XGEN(j)  (2304 + 64 * (j))
#define XB_TOP      3328
#define XB_TOPGEN   3392
#define XCD_BAR_WORDS 3456
#define XB_SPIN_CAP (1u << 18)
__device__ __forceinline__ unsigned xb_ld(unsigned* p)              { return __hip_atomic_load(p, __ATOMIC_RELAXED, __HIP_MEMORY_SCOPE_AGENT); }
__device__ __forceinline__ unsigned xb_add(unsigned* p, unsigned v) { return __hip_atomic_fetch_add(p, v, __ATOMIC_RELAXED, __HIP_MEMORY_SCOPE_AGENT); }
__device__ __forceinline__ unsigned xb_xcc_id() { return (unsigned)__builtin_amdgcn_s_getreg((3 << 11) | 20) & 0xFu; }
#define XB_SPIN(cond, bar) do { unsigned _sp = 0; while (cond) { __builtin_amdgcn_s_sleep(1); \
    if ((++_sp & 255u) == 0u) { if (xb_ld(&(bar)[XB_TMO])) break; if (_sp > XB_SPIN_CAP) { atomicAdd(&(bar)[XB_TMO], 1u); break; } } } } while (0)
struct XcdBarrier { unsigned* bar; unsigned x; volatile LAS unsigned* st; };
__device__ __forceinline__ XcdBarrier xcd_barrier_post(unsigned* bar, volatile LAS unsigned* st) {
    XcdBarrier b; b.bar = bar; b.x = xb_xcc_id(); b.st = st;
    if (threadIdx.x == 0) (void)xb_add(&bar[XB_XCNT(b.x)], 1u);
    return b;
}
__device__ __forceinline__ void xcd_barrier_complete(unsigned* bar, unsigned x, unsigned& nloc, unsigned& nx) {
    const unsigned G = gridDim.x * gridDim.y * gridDim.z;
    unsigned sum, cnt, mine, sp = 0u;
    for (;;) {
        sum = 0u; cnt = 0u; mine = 0u;
#pragma unroll
        for (unsigned j = 0; j < 16; ++j) { const unsigned c = xb_ld(&bar[XB_XCNT(j)]); sum += c; cnt += (c > 0u) ? 1u : 0u; mine = (j == x) ? c : mine; }
        if (sum == G) break;
        __builtin_amdgcn_s_sleep(1);
        if ((++sp & 255u) == 0u) { if (xb_ld(&bar[XB_TMO])) break; if (sp > XB_SPIN_CAP) { atomicAdd(&bar[XB_TMO], 1u); break; } }
    }
    nloc = mine > 0u ? mine : 1u; nx = cnt > 0u ? cnt : 1u;
}
__device__ __forceinline__ void xcd_barrier(const XcdBarrier& b) {
    asm volatile("s_waitcnt vmcnt(0)" ::: "memory");
    __syncthreads();
    if (threadIdx.x == 0) {
        unsigned* bar = b.bar;
        __builtin_amdgcn_s_waitcnt(0);
        unsigned nloc = b.st[0], nx = b.st[1];
        if (nloc == 0u) { xcd_barrier_complete(bar, b.x, nloc, nx); b.st[0] = nloc; b.st[1] = nx; }
        const unsigned old = xb_add(&bar[XB_XSUB(b.x)], 1u);
        const unsigned gen = old / nloc;
        if (old + 1u == (gen + 1u) * nloc) {
            __builtin_amdgcn_fence(__ATOMIC_RELEASE, "agent");
            asm volatile("s_waitcnt vmcnt(0)" ::: "memory");
            const unsigned og = xb_add(&bar[XB_TOP], 1u);
            const unsigned tg = og / nx;
            if (og + 1u == (tg + 1u) * nx) xb_add(&bar[XB_TOPGEN], 1u);
            else XB_SPIN(xb_ld(&bar[XB_TOPGEN]) == tg, bar);
            __builtin_amdgcn_fence(__ATOMIC_ACQUIRE, "agent");
            xb_add(&bar[XB_XGEN(b.x)], 1u);
            asm volatile("s_waitcnt vmcnt(0)" ::: "memory");
        } else {
            XB_SPIN(xb_ld(&bar[XB_XGEN(b.x)]) == gen, bar);
            __builtin_amdgcn_fence(__ATOMIC_ACQUIRE, "agent");
            asm volatile("s_waitcnt vmcnt(0)" ::: "memory");
        }
    }
    __syncthreads();
}

struct Args { const float* in[16]; float* out; unsigned char* ws; int ph_lo, ph_hi, li, pad; };

template <bool GU>
__device__ __forceinline__ void transpose_item(const float* W, int K, int ld, h16* WT, LAS float* scr, int kb, int nb, int lane) {
    const int k0 = 64 * kb, n0 = 64 * nb;
    const int lc = (lane & 15) * 4;
    const int srccol = GU ? ((lc < 32) ? (n0 / 2 + lc) : (512 + n0 / 2 + (lc - 32))) : (n0 + lc);
#pragma unroll 4
    for (int it = 0; it < 16; ++it) { const int kk = 4 * it + (lane >> 4);
        const f32x4 v = *(const f32x4*)(W + (size_t)(k0 + kk) * ld + srccol);
        scr[kk * 65 + lc + 0] = v[0]; scr[kk * 65 + lc + 1] = v[1]; scr[kk * 65 + lc + 2] = v[2]; scr[kk * 65 + lc + 3] = v[3]; }
    LDS_WAIT(); asm volatile("" ::: "memory");
    const int c = lane & 7;
#pragma unroll
    for (int j = 0; j < 8; ++j) { const int nn = 8 * j + (lane >> 3);
        const int cc = GU ? (((nn & 7) < 4) ? (4 * (nn >> 3) + (nn & 7)) : (32 + 4 * (nn >> 3) + ((nn & 7) - 4))) : nn;
        const LAS float* s = scr + (8 * c) * 65 + cc;
        u32x4 o; o.x = pk2h(s[0 * 65], s[1 * 65]); o.y = pk2h(s[2 * 65], s[3 * 65]); o.z = pk2h(s[4 * 65], s[5 * 65]); o.w = pk2h(s[6 * 65], s[7 * 65]);
        *(GAS u32x4*)(WT + (size_t)(n0 + nn) * K + k0 + 8 * c) = o; }
    LDS_WAIT(); asm volatile("" ::: "memory");
}

__device__ __forceinline__ float shfl_idx(float v, int src) { return __int_as_float(__builtin_amdgcn_ds_bpermute(src << 2, __float_as_int(v))); }
__device__ __forceinline__ float wave_sum(float v, int lane) {
#pragma unroll
    for (int o = 1; o < 64; o <<= 1) v += shfl_idx(v, lane ^ o);
    return v;
}
__device__ __forceinline__ void rope_cs(int pos, int m, float& c, float& s) {
    const float e = -(float)m * (13.287712379549449f / 127.0f);
    const float inv = exp2f(e);
    const float ang = (float)pos * inv;
    const float k = rintf(ang * 0.6366197723675814f);
    float r = fmaf(-k, 1.5703125f, ang); r = fmaf(-k, 4.837512969970703125e-4f, r); r = fmaf(-k, 7.54978995489188216e-8f, r);
    const float z = r * r;
    const float sp = fmaf(r * z, fmaf(z, fmaf(z, -1.9515295891e-4f, 8.3321608736e-3f), -1.6666654611e-1f), r);
    const float cp = fmaf(z * z, fmaf(z, fmaf(z, 2.443315711809948e-5f, -1.388731625493765e-3f), 4.166664568298827e-2f), fmaf(z, -0.5f, 1.0f));
    const int q = ((int)k) & 3;
    c = (q == 0) ? cp : (q == 1) ? -sp : (q == 2) ? -cp : sp;
    s = (q == 0) ? sp : (q == 1) ? cp : (q == 2) ? -sp : -cp;
}
struct RowArgs {
    const float* src; float* h; h16* hn; float* rstd; const float* gnorm;
    const h16* y; const int* eidp; const int* rankp; const float* gatep;
    const float* tab; const float* bias0; const float* bias1; float* flog;
    int* eid; int* rank; float* gate; unsigned* counts; int* list;
};
template <bool COMBINE, bool STORE_H, int NT_>
__device__ __forceinline__ void row_pass(const RowArgs& A, int g, bool valid, int lane, int ch, LAS float* xch, LAS float* scr, const volatile LAS unsigned* padstart) {
    const int r = lane & 15, kq = lane >> 4; const int t = 16 * g + r;
    constexpr int NA = NT_ > 0 ? NT_ : 1;
    f32x4 acc[NA];
#pragma unroll
    for (int i = 0; i < NA; ++i) acc[i] = (f32x4){0.f, 0.f, 0.f, 0.f};
    float ss = 0.f;
    if (valid) {
        const float* srow = A.src + (size_t)t * DM + 8 * kq + 512 * ch; float* hrow = A.h + (size_t)t * DM + 8 * kq + 512 * ch; h16* nrow = A.hn + (size_t)t * DM + 8 * kq + 512 * ch;
        const h16* y0 = nullptr; const h16* y1 = nullptr; float g0 = 0.f, g1 = 0.f;
        if (COMBINE) { const int e0 = A.eidp[2 * t], e1 = A.eidp[2 * t + 1]; const int p0 = (int)padstart[e0] + A.rankp[2 * t], p1 = (int)padstart[e1] + A.rankp[2 * t + 1];
            g0 = A.gatep[2 * t]; g1 = A.gatep[2 * t + 1]; y0 = A.y + (size_t)p0 * DM + 8 * kq + 512 * ch; y1 = A.y + (size_t)p1 * DM + 8 * kq + 512 * ch; }
        const float* gnp = A.gnorm + 8 * kq + 512 * ch;
        const float* tabp = A.tab + ((size_t)(16 * ch) * 64 + lane) * (8 * NA);
#pragma unroll 4
        for (int it = 0; it < 16; ++it) {
            f32x4 v0 = *(const f32x4*)(srow + 32 * it), v1 = *(const f32x4*)(srow + 32 * it + 4);
            if (COMBINE) { const f16x8 a = *(const f16x8*)(y0 + 32 * it), b = *(const f16x8*)(y1 + 32 * it);
#pragma unroll
                for (int q = 0; q < 4; ++q) { v0[q] += (float)a[q] * g0 + (float)b[q] * g1; v1[q] += (float)a[4 + q] * g0 + (float)b[4 + q] * g1; } }
            if (STORE_H) { *(f32x4*)(hrow + 32 * it) = v0; *(f32x4*)(hrow + 32 * it + 4) = v1; }
            ss += (v0[0] * v0[0] + v0[1] * v0[1]) + (v0[2] * v0[2] + v0[3] * v0[3]) + (v1[0] * v1[0] + v1[1] * v1[1]) + (v1[2] * v1[2] + v1[3] * v1[3]);
            const f32x4 gn0 = *(const f32x4*)(gnp + 32 * it), gn1 = *(const f32x4*)(gnp + 32 * it + 4);
            const f32x4 a0 = v0 * gn0, a1 = v1 * gn1;
            u32x4 w; w.x = pk2h(a0[0], a0[1]); w.y = pk2h(a0[2], a0[3]); w.z = pk2h(a1[0], a1[1]); w.w = pk2h(a1[2], a1[3]);
            *(u32x4*)(nrow + 32 * it) = w;
            if (NT_ > 0) {
                const float* tp = tabp + (size_t)it * 64 * 8 * NA;
                f32x4 bf[2 * NA];
#pragma unroll
                for (int q = 0; q < 2 * NT_; ++q) bf[q] = *(const f32x4*)(tp + 4 * q);
#pragma unroll
                for (int tl = 0; tl < NT_; ++tl) {
#pragma unroll
                    for (int i = 0; i < 4; ++i) acc[tl] = __builtin_amdgcn_mfma_f32_16x16x4f32(a0[i], bf[2 * tl][i], acc[tl], 0, 0, 0);
#pragma unroll
                    for (int i = 0; i < 4; ++i) acc[tl] = __builtin_amdgcn_mfma_f32_16x16x4f32(a1[i], bf[2 * tl + 1][i], acc[tl], 0, 0, 0);
                }
            }
        }
        ss += shfl_idx(ss, lane ^ 16); ss += shfl_idx(ss, lane ^ 32);
        if (ch == 1) { xch[lane] = ss;
#pragma unroll
            for (int tl = 0; tl < NT_; ++tl)
#pragma unroll
                for (int q = 0; q < 4; ++q) xch[64 * (1 + 4 * tl + q) + lane] = acc[tl][q]; }
    }
    __syncthreads();
    if (valid && ch == 0) {
        ss += xch[lane];
#pragma unroll
        for (int tl = 0; tl < NT_; ++tl)
#pragma unroll
            for (int q = 0; q < 4; ++q) acc[tl][q] += xch[64 * (1 + 4 * tl + q) + lane];
        const float rs = 1.0f / sqrtf(ss * (1.0f / DM) + EPS);
        if (kq == 0) A.rstd[t] = rs;
        if (NT_ > 0) {
            float rst[4];
#pragma unroll
            for (int q = 0; q < 4; ++q) rst[q] = shfl_idx(rs, 4 * kq + q);
            if (NT_ == 1) {
                const float bb = A.bias0[r];
#pragma unroll
                for (int q = 0; q < 4; ++q) A.flog[(size_t)(16 * g + 4 * kq + q) * 16 + r] = acc[0][q] * rst[q] + bb;
            } else {
#pragma unroll
                for (int tl = 0; tl < NT_; ++tl)
#pragma unroll
                    for (int q = 0; q < 4; ++q) scr[(4 * kq + q) * 48 + 16 * tl + r] = acc[tl][q] * rst[q];
                LDS_WAIT(); asm volatile("" ::: "memory");
                if (lane < 16) {
                    const LAS float* sr = scr + r * 48;
                    float gl[4];
#pragma unroll
                    for (int q = 0; q < 4; ++q) gl[q] = sr[32 + q] + A.bias0[q];
                    int gi = 0; float gmax = gl[0];
#pragma unroll
                    for (int q = 1; q < 4; ++q) if (gl[q] > gmax) { gmax = gl[q]; gi = q; }
                    float gs = 0.f;
#pragma unroll
                    for (int q = 0; q < 4; ++q) gs += __expf(gl[q] - gmax);
                    const float pg = 1.0f / gs;
                    float el[8];
#pragma unroll
                    for (int e = 0; e < 8; ++e) el[e] = sr[gi * 8 + e] + A.bias1[gi * 8 + e];
                    int i0 = 0; float emax = el[0];
#pragma unroll
                    for (int e = 1; e < 8; ++e) if (el[e] > emax) { emax = el[e]; i0 = e; }
                    int i1 = -1; float b1 = -3.0e38f;
#pragma unroll
                    for (int e = 0; e < 8; ++e) if (e != i0 && el[e] > b1) { b1 = el[e]; i1 = e; }
                    const float p1 = __expf(b1 - emax);
                    const float ga = pg / (1.0f + p1), gb = pg * p1 / (1.0f + p1);
                    const int e0 = gi * 8 + i0, e1 = gi * 8 + i1;
                    const int r0 = (int)atomicAdd(A.counts + e0, 1u), r1 = (int)atomicAdd(A.counts + e1, 1u);
                    A.list[e0 * LISTCAP + r0] = 2 * t; A.list[e1 * LISTCAP + r1] = 2 * t + 1;
                    A.eid[2 * t] = e0; A.eid[2 * t + 1] = e1; A.rank[2 * t] = r0; A.rank[2 * t + 1] = r1; A.gate[2 * t] = ga; A.gate[2 * t + 1] = gb;
                }
                LDS_WAIT(); asm volatile("" ::: "memory");
            }
        }
    }
    __syncthreads();
}
template <bool COMBINE, bool STORE_H, int NT_>
__device__ __forceinline__ void row_pass_all(const RowArgs& A, int vcu, int G, int wave, int lane, LAS unsigned char* lds, const volatile LAS unsigned* padstart) {
    const int pr = wave & 3, ch = wave >> 2;
    LAS float* xch = (LAS float*)(lds + pr * 4096); LAS float* scr = (LAS float*)(lds + 16384 + pr * 4096);
    for (int base = 0; base < T / 16; base += 4 * G) { const int g = base + pr * G + vcu; row_pass<COMBINE, STORE_H, NT_>(A, g, g < T / 16, lane, ch, xch, scr, padstart); }
}
__device__ __forceinline__ void final_row(const float* h, const h16* y, const int* eidp, const int* rankp, const float* gatep, const volatile LAS unsigned* padstart, const float* gf, float* out, int t, int lane) {
    const int e0 = eidp[2 * t], e1 = eidp[2 * t + 1]; const int p0 = (int)padstart[e0] + rankp[2 * t], p1 = (int)padstart[e1] + rankp[2 * t + 1];
    const float g0 = gatep[2 * t], g1 = gatep[2 * t + 1];
    const f32x4* hr = (const f32x4*)(h + (size_t)t * DM) + lane; const f16x4* ya = (const f16x4*)(y + (size_t)p0 * DM) + lane; const f16x4* yb = (const f16x4*)(y + (size_t)p1 * DM) + lane;
    f32x4 v[4]; float s = 0.f;
#pragma unroll
    for (int j = 0; j < 4; ++j) { const f16x4 a = ya[64 * j], b = yb[64 * j]; v[j] = hr[64 * j];
#pragma unroll
        for (int q = 0; q < 4; ++q) v[j][q] += (float)a[q] * g0 + (float)b[q] * g1;
        s += (v[j][0] * v[j][0] + v[j][1] * v[j][1]) + (v[j][2] * v[j][2] + v[j][3] * v[j][3]); }
    const float rs = 1.0f / sqrtf(wave_sum(s, lane) * (1.0f / DM) + EPS);
    f32x4* o = (f32x4*)(out + (size_t)t * DM) + lane;
#pragma unroll
    for (int j = 0; j < 4; ++j) o[64 * j] = v[j] * rs * ((const f32x4*)gf)[lane + 64 * j];
}
__device__ __forceinline__ void ret_gn_item(const h16* ro, const h16* gate, const float* gain, h16* og, int w, int lane) {
    const int t = w >> 2, h = w & 3;
    const f16x8 ov = *(const f16x8*)(ro + (size_t)t * 2048 + h * 512 + lane * 8);
    const f16x8 gv = *(const f16x8*)(gate + (size_t)(h >> 1) * T * 1024 + (size_t)t * 1024 + (h & 1) * 512 + lane * 8);
    float v[8]; float s = 0.f;
#pragma unroll
    for (int j = 0; j < 8; ++j) { v[j] = (float)ov[j]; s += v[j]; }
    const float mu = wave_sum(s, lane) * (1.0f / RET_DV); float q = 0.f;
#pragma unroll
    for (int j = 0; j < 8; ++j) { v[j] -= mu; q += v[j] * v[j]; }
    const float rs = 1.0f / sqrtf(wave_sum(q, lane) * (1.0f / RET_DV) + EPS);
    const f32x4 ga = *(const f32x4*)(gain + h * 512 + lane * 8), gb = *(const f32x4*)(gain + h * 512 + lane * 8 + 4);
    float o[8];
#pragma unroll
    for (int j = 0; j < 8; ++j) { const float gg = (float)gv[j]; const float gn = (j < 4) ? ga[j & 3] : gb[j & 3];
        o[j] = v[j] * rs * gn * gg * __builtin_amdgcn_rcpf(1.0f + __builtin_amdgcn_exp2f(-gg * LOG2E)); }
    u32x4 wv; wv.x = pk2h(o[0], o[1]); wv.y = pk2h(o[2], o[3]); wv.z = pk2h(o[4], o[5]); wv.w = pk2h(o[6], o[7]);
    *(u32x4*)(og + (size_t)t * 2048 + h * 512 + lane * 8) = wv;
}

namespace ret_body {
constexpr int KLP = 528, VLP = 144, RLP = 528;
constexpr int OFF_KL = 0, OFF_VL = 128 * KLP, OFF_VD = OFF_VL + 128 * VLP, OFF_RL = OFF_VD + 128 * VLP, END = OFF_RL + 64 * RLP, OFF_OS = 0;
static_assert(END <= RING_BYTES, "retention LDS");
#define MF16(a, b, c) __builtin_amdgcn_mfma_f32_32x32x16_f16(a, b, c, 0, 0, 0)
__device__ __forceinline__ int crow(int r, int hi) { return (r & 3) + 8 * (r >> 2) + 4 * hi; }
typedef short v4i16_t __attribute__((ext_vector_type(4)));
__device__ __forceinline__ s16x4 vtr(LAS const char* p) { return __builtin_bit_cast(s16x4, __builtin_amdgcn_ds_read_tr16_b64_v4i16((LAS v4i16_t*)p)); }
__device__ __forceinline__ f16x8 mk8(s16x4 lo, s16x4 hi) { typedef short s16x8 __attribute__((ext_vector_type(8))); s16x8 t = {lo[0], lo[1], lo[2], lo[3], hi[0], hi[1], hi[2], hi[3]}; return __builtin_bit_cast(f16x8, t); }
__device__ __forceinline__ f16x8 pack8(const f32x16& S, int b) { u32x4 w; w.x = pk2h(S[b], S[b + 1]); w.y = pk2h(S[b + 2], S[b + 3]); w.z = pk2h(S[b + 4], S[b + 5]); w.w = pk2h(S[b + 6], S[b + 7]); return __builtin_bit_cast(f16x8, w); }
__device__ __forceinline__ void ret_item(int b, int h, int sl, const h16* __restrict__ Qr, const h16* __restrict__ Kr, const h16* __restrict__ Vb, h16* __restrict__ O, LAS unsigned char* lds, const int tid_arg) {
    const int tid_in = tid_arg;
    const float lg2 = log2f(1.0f - exp2f(-5.0f - (float)h));
    const float cd = exp2f(128.0f * lg2);
    f32x16 R0 = {}, R1 = {};
    for (int n = 0; n < SEQ / 128; ++n) {
        int tid = tid_in; asm volatile("" : "+v"(tid));
        const int lane = tid & 63, r32 = lane & 31, hi = lane >> 5; const int wid = __builtin_amdgcn_readfirstlane(tid >> 6);
        const int wi = wid & 3, wj = wid >> 2;
        const bool act_s = !(wj == 1 && wi < 2);
        const int trq = (lane & 15) >> 2, trp = lane & 3, trg = (lane >> 4) & 1;
        const size_t t0 = (size_t)b * SEQ + (size_t)n * 128;
#pragma unroll
        for (int i = 0; i < 8; ++i) { const int p = tid + 512 * i, j = p >> 5, c16 = p & 31;
            const u32x4 v = *(const u32x4*)(Kr + (t0 + j) * 1024 + h * 256 + c16 * 8);
            *(LAS u32x4*)(lds + OFF_KL + j * KLP + c16 * 16) = v; }
#pragma unroll
        for (int i = 0; i < 2; ++i) { const int p = tid + 512 * i, j = p >> 3, c16 = p & 7;
            const f16x8 v = *(const f16x8*)(Vb + (t0 + j) * 1024 + c16 * 8);
            *(LAS f16x8*)(lds + OFF_VL + j * VLP + c16 * 16) = v;
            const float kd = exp2f(lg2 * (float)(127 - j));
            u32x4 w; w.x = pk2h((float)v[0] * kd, (float)v[1] * kd); w.y = pk2h((float)v[2] * kd, (float)v[3] * kd); w.z = pk2h((float)v[4] * kd, (float)v[5] * kd); w.w = pk2h((float)v[6] * kd, (float)v[7] * kd);
            *(LAS u32x4*)(lds + OFF_VD + j * VLP + c16 * 16) = w; }
        const h16* qp = Qr + (t0 + 32 * wi + r32) * 1024 + h * 256 + 8 * hi;
        f16x8 qf[8];
#pragma unroll
        for (int s = 0; s < 8; ++s) qf[s] = *(const f16x8*)(qp + 16 * (8 * (1 - wj) + s));
        __syncthreads();
        f16x8 sf[2][2];
        {
            f32x16 S0 = {}, S1 = {};
            const LAS unsigned char* kp = lds + OFF_KL + (64 * wj + r32) * KLP + 16 * hi + 256 * (1 - wj);
            if (act_s) {
#pragma unroll
                for (int s = 0; s < 8; ++s) { const f16x8 a0 = *(const LAS f16x8*)(kp + 32 * s), a1 = *(const LAS f16x8*)(kp + 32 * KLP + 32 * s);
                    S0 = MF16(a0, qf[s], S0); S1 = MF16(a1, qf[s], S1); if ((s & 3) == 3) __builtin_amdgcn_sched_barrier(0); }
            }
#pragma unroll
            for (int s = 0; s < 8; ++s) qf[s] = *(const f16x8*)(qp + 16 * (8 * wj + s));
            if (act_s) {
                const LAS unsigned char* kp2 = lds + OFF_KL + (64 * wj + r32) * KLP + 16 * hi + 256 * wj;
#pragma unroll
                for (int s = 0; s < 8; ++s) { const f16x8 a0 = *(const LAS f16x8*)(kp2 + 32 * s), a1 = *(const LAS f16x8*)(kp2 + 32 * KLP + 32 * s);
                    S0 = MF16(a0, qf[s], S0); S1 = MF16(a1, qf[s], S1); if ((s & 3) == 3) __builtin_amdgcn_sched_barrier(0); }
                const int ig = 32 * wi + r32;
#pragma unroll
                for (int r = 0; r < 16; ++r) { const int j0 = 64 * wj + crow(r, hi), j1 = j0 + 32;
                    S0[r] = (ig >= j0) ? S0[r] * exp2f(lg2 * (float)(ig - j0)) : 0.f;
                    S1[r] = (ig >= j1) ? S1[r] * exp2f(lg2 * (float)(ig - j1)) : 0.f; }
            }
            sf[0][0] = pack8(S0, 0); sf[0][1] = pack8(S0, 8); sf[1][0] = pack8(S1, 0); sf[1][1] = pack8(S1, 8);
        }
        __builtin_amdgcn_sched_barrier(0);
        f32x16 OT0 = {}, OT1 = {};
        if (n > 0) {
            const LAS unsigned char* rp = lds + OFF_RL + r32 * RLP + 16 * hi + 256 * wj;
#pragma unroll
            for (int s = 0; s < 8; ++s) {
                const f16x8 a0 = *(const LAS f16x8*)(rp + 32 * s), a1 = *(const LAS f16x8*)(rp + 32 * RLP + 32 * s);
                OT0 = MF16(a0, qf[s], OT0); OT1 = MF16(a1, qf[s], OT1); if ((s & 3) == 3) __builtin_amdgcn_sched_barrier(0); }
            const float qd = exp2f(lg2 * (float)(32 * wi + r32 + 1));
#pragma unroll
            for (int r = 0; r < 16; ++r) { OT0[r] *= qd; OT1[r] *= qd; }
        }
        __builtin_amdgcn_sched_barrier(0);
        if (act_s) {
#pragma unroll
            for (int jt = 0; jt < 2; ++jt)
#pragma unroll
                for (int s2 = 0; s2 < 2; ++s2) {
                    const int jb = 64 * wj + 32 * jt + 16 * s2 + 4 * hi + trq;
                    const LAS char* vp = (const LAS char*)(lds + OFF_VL + jb * VLP + (16 * trg + 4 * trp) * 2);
                    const f16x8 v0 = mk8(vtr(vp), vtr(vp + 8 * VLP)), v1 = mk8(vtr(vp + 64), vtr(vp + 64 + 8 * VLP));
                    OT0 = MF16(v0, sf[jt][s2], OT0); OT1 = MF16(v1, sf[jt][s2], OT1); }
        }
        __builtin_amdgcn_sched_barrier(0);
#pragma unroll
        for (int r = 0; r < 16; ++r) { R0[r] *= cd; R1[r] *= cd; }
#pragma unroll
        for (int s = 0; s < 8; ++s) {
            const int jb = 16 * s + 8 * hi + trq;
            const LAS char* kp = (const LAS char*)(lds + OFF_KL + jb * KLP + (32 * wid + 16 * trg + 4 * trp) * 2);
            const LAS char* vp = (const LAS char*)(lds + OFF_VD + jb * VLP + (16 * trg + 4 * trp) * 2);
            const f16x8 ka = mk8(vtr(kp), vtr(kp + 4 * KLP));
            const f16x8 v0 = mk8(vtr(vp), vtr(vp + 4 * VLP)), v1 = mk8(vtr(vp + 64), vtr(vp + 64 + 4 * VLP));
            R0 = MF16(ka, v0, R0); R1 = MF16(ka, v1, R1); if ((s & 1) == 1) __builtin_amdgcn_sched_barrier(0); }
        __syncthreads();
        {
#pragma unroll
            for (int g4 = 0; g4 < 4; ++g4) {
                u32x2 w; w.x = pk2h(R0[4 * g4], R0[4 * g4 + 1]); w.y = pk2h(R0[4 * g4 + 2], R0[4 * g4 + 3]);
                *(LAS u32x2*)(lds + OFF_RL + r32 * RLP + (32 * wid + 8 * g4 + 4 * hi) * 2) = w;
                w.x = pk2h(R1[4 * g4], R1[4 * g4 + 1]); w.y = pk2h(R1[4 * g4 + 2], R1[4 * g4 + 3]);
                *(LAS u32x2*)(lds + OFF_RL + (32 + r32) * RLP + (32 * wid + 8 * g4 + 4 * hi) * 2) = w; }
            LAS float* os = (LAS float*)(lds + OFF_OS) + wid * 1024 + lane;
#pragma unroll
            for (int r = 0; r < 16; ++r) os[64 * r] = wj ? OT0[r] : OT1[r];
        }
        __syncthreads();
        {
            const LAS float* os = (const LAS float*)(lds + OFF_OS) + (wid ^ 4) * 1024 + lane;
            h16* op = O + (t0 + 32 * wi + r32) * 2048 + h * 512 + sl * 64 + 32 * wj + 4 * hi;
#pragma unroll
            for (int g4 = 0; g4 < 4; ++g4) { float f[4];
#pragma unroll
                for (int q = 0; q < 4; ++q) f[q] = (wj ? OT1[4 * g4 + q] : OT0[4 * g4 + q]) + os[64 * (4 * g4 + q)];
                u32x2 w; w.x = pk2h(f[0], f[1]); w.y = pk2h(f[2], f[3]); *(u32x2*)(op + 8 * g4) = w; }
        }
        __syncthreads();
    }
}
#undef MF16
}

struct MoeOrder {
    const volatile LAS unsigned* cnt; const volatile LAS unsigned* tstart; int G, c, K; const char* A; const char* Bt; size_t bstride; const int* list; int gather;
    __device__ bool next(int i, pg8::Unit& u) const {
        const int NTt = __builtin_amdgcn_readfirstlane((int)tstart[NE]); const long L = (long)i * G + c; if (L >= (long)NTt * 4) return false;
        const int mtg = (int)(L >> 2); int e = 0;
        while (e < NE - 1 && mtg >= __builtin_amdgcn_readfirstlane((int)tstart[e + 1])) ++e;
        u.pm = mtg; u.pn = (int)(L & 3); u.e = e; u.mt = mtg - __builtin_amdgcn_readfirstlane((int)tstart[e]); return true;
    }
    __device__ __forceinline__ const char* abase() const { return A; }
    __device__ __forceinline__ void aoff(const pg8::Unit& u, const int (&R)[2], const int (&C)[2], unsigned (&ao)[2][2]) const {
        if (gather) { const int cn = (int)cnt[u.e];
#pragma unroll
            for (int h = 0; h < 2; ++h)
#pragma unroll
                for (int i = 0; i < 2; ++i) { const int rank = u.mt * 256 + h * 128 + R[i]; int row = T; if (rank < cn) row = list[u.e * LISTCAP + rank] >> 1;
                    ao[h][i] = (unsigned)(((size_t)row * K + C[i]) * 2); }
        } else {
#pragma unroll
            for (int h = 0; h < 2; ++h)
#pragma unroll
                for (int i = 0; i < 2; ++i) ao[h][i] = (unsigned)(((size_t)(u.pm * 256 + h * 128 + R[i]) * K + C[i]) * 2);
        }
    }
    __device__ __forceinline__ const char* bbase(const pg8::Unit& u) const { return Bt + (size_t)u.e * bstride + (size_t)u.pn * 256 * K * 2; }
};
__device__ __forceinline__ void moe_setup(volatile LAS unsigned* MISC, const unsigned* counts, const int tid) {
    __syncthreads();
    if (tid < NE) MISC[16 + tid] = __hip_atomic_load(counts + tid, RLX_AGENT);
    __syncthreads();
    if (tid == 0) { unsigned a = 0; for (int e = 0; e < NE; ++e) { MISC[48 + e] = a; MISC[96 + e] = a * 256u; a += (MISC[16 + e] + 255u) >> 8; } MISC[48 + NE] = a; }
    __syncthreads();
}

__global__ void __launch_bounds__(NWAVES * 64, 2) mk_fwd(Args args) {
    extern __shared__ __attribute__((aligned(16))) unsigned char lds_raw[];
    LAS unsigned char* lds = (LAS unsigned char*)lds_raw;
    volatile LAS unsigned* MISC = (volatile LAS unsigned*)(lds + MISC_OFF);
    const int G = gridDim.x; const int bx = blockIdx.x; const int vcu = (G % 8 == 0) ? (bx % 8) * (G / 8) + bx / 8 : bx;
    { gu32* ctl0 = (gu32*)(args.ws + WS_CTL);
      for (int u = threadIdx.x; u < (LDS_BYTES - LDSCTL_OFF) / 4; u += NWAVES * 64) ((LAS unsigned*)(lds + LDSCTL_OFF))[u] = 0u;
      __syncthreads();
      (void)ctl0; }
    XcdBarrier bar; bar.bar = (unsigned*)((gu32*)(args.ws + WS_CTL) + CW_BAR) + args.li * XCD_BAR_WORDS; bar.x = 0; bar.st = nullptr;
    const bool use_bar = (args.ph_hi - args.ph_lo) > 1;
    if (use_bar) bar = xcd_barrier_post((unsigned*)((gu32*)(args.ws + WS_CTL) + CW_BAR) + args.li * XCD_BAR_WORDS, MISC + 8);
#ifndef PROBE_DUP
#define PROBE_DUP -1
#endif
    for (int pi = args.ph_lo; pi < args.ph_hi; ++pi) {
        const int ph = (PROBE_DUP >= 0 && pi > PROBE_DUP) ? pi - 1 : pi;
        bool did = true; const bool dummy = (PROBE_DUP >= 0 && pi == PROBE_DUP + 1);
        int tid = threadIdx.x; asm volatile("" : "+v"(tid));
        size_t zoff = 0; asm volatile("" : "+s"(zoff));
        unsigned char* ws = args.ws + zoff;
        const int lane = tid & 63, wave = __builtin_amdgcn_readfirstlane(tid >> 6);
        gu32* ctl = (gu32*)(ws + WS_CTL);
        const float* x = args.in[0]; const float* fox_w_in = args.in[1]; const float* fox_b_f = args.in[2]; const float* fox_w_out = args.in[3];
        const float* ret_w_in = args.in[4]; const float* ret_gn = args.in[5]; const float* ret_w_out = args.in[6];
        const float* norm_mix = args.in[7]; const float* norm_ffn = args.in[8];
        const float* rg_w = args.in[9]; const float* rg_b = args.in[10]; const float* re_w = args.in[11]; const float* re_b = args.in[12];
        const float* w_gu = args.in[13]; const float* w_down = args.in[14]; const float* norm_final = args.in[15];
        h16* WfoxT = (h16*)(ws + WS_WFOX); h16* WfoT = (h16*)(ws + WS_WFO); h16* WretT = (h16*)(ws + WS_WRET); h16* WroT = (h16*)(ws + WS_WRO); h16* WguT = (h16*)(ws + WS_WGU); h16* WdT = (h16*)(ws + WS_WD);
        float* RW = (float*)(ws + WS_RW); float* FW = (float*)(ws + WS_FW); float* ctab = (float*)(ws + WS_ROPE); float* stab = ctab + SEQ * 128;
        float* H = (float*)(ws + WS_H); h16* HN = (h16*)(ws + WS_HN); float* RSTD = (float*)(ws + WS_RSTD); float* FLOG = (float*)(ws + WS_FLOG); float* CUM = (float*)(ws + WS_CUM);
        int* EID = (int*)(ws + WS_EID); int* RANK = (int*)(ws + WS_RANK); float* GATE = (float*)(ws + WS_GATE); int* LIST = (int*)(ws + WS_LIST);
        h16* QKVG = (h16*)(ws + WS_QKVG); h16* OG = (h16*)(ws + WS_OG); h16* RO = (h16*)(ws + WS_RO); h16* Y = (h16*)(ws + WS_Y); h16* ACT = (h16*)(ws + WS_ACT);
        unsigned* COUNTS = (unsigned*)(ctl + CW_CNT);
        const int gw = vcu * NWAVES + wave, NGW = G * NWAVES;

        if (ph == 0) {
            LAS float* scr = (LAS float*)(lds + wave * 16640);
            constexpr int I_FOX = 2 * 16 * 64, I_FO = 2 * 16 * 16, I_RET = 2 * 16 * 96, I_RO = 2 * 32 * 16, I_GU = DEPTH * NE * 16 * 16, I_D = DEPTH * NE * 8 * 16;
            constexpr int NITEMS = I_FOX + I_FO + I_RET + I_RO + I_GU + I_D;
            for (int it = gw; it < NITEMS; it += NGW) {
                int r = it;
                if (r < I_FOX) { const int j = r / (16 * 64), q = r % (16 * 64); transpose_item<false>(fox_w_in + (size_t)j * DM * FOX_IN, DM, FOX_IN, WfoxT + (size_t)j * 4096 * 1024, scr, q / 64, q % 64, lane); continue; } r -= I_FOX;
                if (r < I_FO) { const int j = r / 256, q = r % 256; transpose_item<false>(fox_w_out + (size_t)j * DM * DM, DM, DM, WfoT + (size_t)j * 1024 * 1024, scr, q / 16, q % 16, lane); continue; } r -= I_FO;
                if (r < I_RET) { const int j = r / (16 * 96), q = r % (16 * 96); transpose_item<false>(ret_w_in + (size_t)j * DM * RET_IN, DM, RET_IN, WretT + (size_t)j * 6144 * 1024, scr, q / 96, q % 96, lane); continue; } r -= I_RET;
                if (r < I_RO) { const int j = r / 512, q = r % 512; transpose_item<false>(ret_w_out + (size_t)j * 2048 * DM, 2048, DM, WroT + (size_t)j * 1024 * 2048, scr, q / 16, q % 16, lane); continue; } r -= I_RO;
                if (r < I_GU) { const int m = r / 256, q = r % 256; transpose_item<true>(w_gu + (size_t)m * DM * 1024, DM, 1024, WguT + (size_t)m * 1024 * 1024, scr, q / 16, q % 16, lane); continue; } r -= I_GU;
                { const int m = r / 128, q = r % 128; transpose_item<false>(w_down + (size_t)m * EFF * DM, EFF, DM, WdT + (size_t)m * 1024 * 512, scr, q / 16, q % 16, lane); }
            }
            const int gt = vcu * NWAVES * 64 + tid, NGT = G * NWAVES * 64;
            for (int idx = gt; idx < DEPTH * 32 * 64 * 24; idx += NGT) { const int v = idx % 24, ln = (idx / 24) % 64, it = (idx / (24 * 64)) % 32, L = idx / (24 * 64 * 32);
                const int tl = v >> 3, i = v & 7, k = 32 * it + 8 * (ln >> 4) + i, c = ln & 15;
                float val = 0.f; if (tl < 2) val = re_w[((size_t)L * DM + k) * NE + 16 * tl + c]; else if (c < 4) val = rg_w[((size_t)L * DM + k) * NG + c];
                RW[idx] = val; }
            for (int idx = gt; idx < 2 * 32 * 64 * 8; idx += NGT) { const int i = idx % 8, ln = (idx / 8) % 64, it = (idx / 512) % 32, j = idx / (512 * 32);
                const int k = 32 * it + 8 * (ln >> 4) + i, c = ln & 15; FW[idx] = fox_w_in[((size_t)j * DM + k) * FOX_IN + 4096 + c]; }
            for (int idx = gt; idx < SEQ * 128; idx += NGT) { const int pos = idx / 128, m = idx % 128;
                float c_, s_; rope_cs(pos, m, c_, s_); ctab[idx] = c_; stab[idx] = s_; }
            for (int idx = gt; idx < DM / 2; idx += NGT) ((unsigned*)(HN + (size_t)T * DM))[idx] = 0u;
        } else if (ph == 1) {
            { RowArgs A{}; A.src = x; A.h = H; A.hn = HN; A.rstd = RSTD; A.gnorm = norm_mix; A.tab = FW; A.bias0 = fox_b_f; A.flog = FLOG;
                row_pass_all<false, true, 1>(A, vcu, G, wave, lane, lds, nullptr); }
        } else {
            const int L = (ph - 2) >> 3, sub = (ph - 2) & 7, j = L >> 1; const bool fox = (L & 1) == 0;
            if (sub == 0) {
                if (fox) {
                    if (vcu < BATCH * FOX_H) {
                        const int bh = vcu, b = bh / FOX_H, hh = bh % FOX_H; float v[4]; float run = 0.f;
#pragma unroll
                        for (int i = 0; i < 4; ++i) { const float f = FLOG[((size_t)b * SEQ + 4 * tid + i) * 16 + hh]; run += fminf(f, 0.f) - log1pf(__expf(-fabsf(f))); v[i] = run; }
                        float incl = run;
#pragma unroll
                        for (int o = 1; o < 64; o <<= 1) { const float u = shfl_idx(incl, lane >= o ? lane - o : lane); if (lane >= o) incl += u; }
                        LAS float* wt = (LAS float*)lds;
                        if (lane == 63) wt[wave] = incl;
                        __syncthreads();
                        float base = incl - run;
                        for (int w = 0; w < wave; ++w) base += wt[w];
                        f32x4 o4 = {v[0] + base, v[1] + base, v[2] + base, v[3] + base};
                        *(f32x4*)(CUM + (size_t)bh * SEQ + 4 * tid) = o4;
                        __syncthreads();
                    }
                    pg8::StaticOrder S; S.init(HN, WfoxT + (size_t)j * 4096 * 1024, T, 4096, DM, G, bx);
                    pg8::EpiH16 E{QKVG, 1024, 1024, (size_t)T * 1024, RSTD, attn_body::C2, 1.f, 0, nullptr, nullptr};
                    pg8::gemm_phase<pg8::EpiH16, pg8::StaticOrder, true>(lds, DM, S, E, tid);
                } else {
                    pg8::StaticOrder S; S.init(HN, WretT + (size_t)j * 6144 * 1024, T, 6144, DM, G, bx);
                    pg8::EpiH16 E{QKVG, 1024, 1024, (size_t)T * 1024, RSTD, 1.f, 0.0625f, 1, ctab, stab};
                    pg8::gemm_phase<pg8::EpiH16, pg8::StaticOrder, true>(lds, DM, S, E, tid);
                }
            } else if (sub == 1) {
                if (fox) {
                    const h16* Q = QKVG; const h16* K = QKVG + (size_t)T * 1024; const h16* V = QKVG + (size_t)2 * T * 1024; const h16* Gt = QKVG + (size_t)3 * T * 1024;
                    for (int bh = vcu >> 1; bh < BATCH * FOX_H; bh += (G >> 1)) {
                        const int s = vcu & 1;
#pragma unroll 1
                        for (int i = 0; i < 4; ++i) { const int qb = (i == 0) ? s : (i == 1) ? 7 - s : (i == 2) ? 3 - s : 4 + s;
                            int tu = tid; asm volatile("" : "+v"(tu));
                            attn_body::attn_unit<8>(bh / FOX_H, bh % FOX_H, qb, Q, K, V, Gt, CUM, OG, (char*)lds_raw, tu); }
                    }
                } else {
                    for (int item = vcu; item < BATCH * RET_H * 8; item += G) { const int bh = item >> 3, sl = item & 7, b = bh >> 2, hh = bh & 3;
                        const h16* Vb = QKVG + (size_t)(2 + (hh >> 1)) * T * 1024 + (hh & 1) * 512 + sl * 64;
                        ret_body::ret_item(b, hh, sl, QKVG, QKVG + (size_t)T * 1024, Vb, RO, lds, tid); }
                }
            } else if (sub == 2) {
                if (fox) did = false;
                else { for (int w = gw; w < T * RET_H; w += NGW) ret_gn_item(RO, QKVG + (size_t)4 * T * 1024, ret_gn + (size_t)j * 2048, OG, w, lane); }
            } else if (sub == 3) {
                const int Kd = fox ? 1024 : 2048;
                pg8::StaticOrder S; S.init(OG, fox ? (const void*)(WfoT + (size_t)j * 1024 * 1024) : (const void*)(WroT + (size_t)j * 1024 * 2048), T, DM, Kd, G, bx);
                pg8::EpiResid E{dummy ? (float*)(ws + WS_DUMMY) : H, DM};
                pg8::gemm_phase<pg8::EpiResid, pg8::StaticOrder, false>(lds, Kd, S, E, tid);
            } else if (sub == 4) {
                { RowArgs A{}; A.src = H; A.h = H; A.hn = HN; A.rstd = RSTD; A.gnorm = norm_ffn + (size_t)L * DM; A.tab = RW + (size_t)L * 32 * 64 * 24; A.bias0 = rg_b + L * NG; A.bias1 = re_b + L * NE;
                    A.eid = EID; A.rank = RANK; A.gate = GATE; A.counts = COUNTS + L * NE; A.list = LIST;
                    if (dummy) { unsigned char* dz = ws + WS_DUMMY; A.hn = (h16*)(dz + 64 * MiB); A.rstd = (float*)(dz + 100 * MiB); A.eid = (int*)(dz + 101 * MiB); A.rank = (int*)(dz + 102 * MiB); A.gate = (float*)(dz + 103 * MiB); A.list = (int*)(dz + 104 * MiB); A.counts = (unsigned*)(ctl + CW_CNT2); }
                    row_pass_all<false, false, 3>(A, vcu, G, wave, lane, lds, nullptr); }
            } else if (sub == 5) {
                moe_setup(MISC, COUNTS + L * NE, tid);
                MoeOrder S{MISC + 16, MISC + 48, G, vcu, DM, (const char*)HN, (const char*)(WguT + (size_t)L * NE * 1024 * 1024), SZ_WGU, LIST, 1};
                pg8::EpiSwiGLU E{ACT, RSTD, LIST, (const int*)(COUNTS + L * NE)};
                pg8::gemm_phase<pg8::EpiSwiGLU, MoeOrder, true>(lds, DM, S, E, tid);
            } else if (sub == 6) {
                moe_setup(MISC, COUNTS + L * NE, tid);
                MoeOrder S{MISC + 16, MISC + 48, G, vcu, EFF, (const char*)ACT, (const char*)(WdT + (size_t)L * NE * 1024 * 512), SZ_WD, LIST, 0};
                pg8::EpiStoreH16 E{Y, DM};
                pg8::gemm_phase<pg8::EpiStoreH16, MoeOrder, true>(lds, EFF, S, E, tid);
            } else {
                moe_setup(MISC, COUNTS + L * NE, tid);
                if (L == DEPTH - 1) {
                    for (int t = gw; t < T; t += NGW) final_row(H, Y, EID, RANK, GATE, MISC + 96, norm_final, dummy ? (float*)(ws + WS_DUMMY) : args.out, t, lane);
                } else {
                    const bool nfox = ((L + 1) & 1) == 0;
                    RowArgs A{}; A.src = H; A.h = H; A.hn = HN; A.rstd = RSTD; A.gnorm = norm_mix + (size_t)(L + 1) * DM; A.y = Y; A.eidp = EID; A.rankp = RANK; A.gatep = GATE;
                    if (dummy) { unsigned char* dz = ws + WS_DUMMY; A.h = (float*)dz; A.hn = (h16*)(dz + 64 * MiB); A.rstd = (float*)(dz + 100 * MiB); }
                    if (nfox) { A.tab = FW + (size_t)((L + 1) >> 1) * 32 * 64 * 8; A.bias0 = fox_b_f + ((L + 1) >> 1) * FOX_H; A.flog = dummy ? (float*)(ws + WS_DUMMY + 106 * MiB) : FLOG;
                        row_pass_all<true, true, 1>(A, vcu, G, wave, lane, lds, MISC + 96); }
                    else { row_pass_all<true, true, 0>(A, vcu, G, wave, lane, lds, MISC + 96); }
                }
            }
        }
        if (did && pi + 1 < args.ph_hi) xcd_barrier(bar);
    }
}

extern "C" void kernel_launch(void* const* d_in, const int* in_sizes, int n_in, void* d_out, int out_size, void* d_ws, size_t ws_size, hipStream_t stream) {
    static int grid = 0;
    if (grid == 0) {
        if (n_in != 16 || out_size != T * DM || ws_size < WS_END) { fprintf(stderr, "kernel_launch: unexpected problem (n_in %d out %d ws %zu need %zu)\n", n_in, out_size, ws_size, (size_t)WS_END); grid = -1; return; }
        int dev = 0, cus = 0;
        if (hipGetDevice(&dev) != hipSuccess || hipDeviceGetAttribute(&cus, hipDeviceAttributeMultiprocessorCount, dev) != hipSuccess) { grid = -1; return; }
        if (hipFuncSetAttribute((const void*)mk_fwd, hipFuncAttributeMaxDynamicSharedMemorySize, LDS_BYTES) != hipSuccess) { fprintf(stderr, "kernel_launch: hipFuncSetAttribute failed\n"); grid = -1; return; }
        (void)hipGetLastError();
        grid = cus;
    }
    if (grid < 0) return;
    if (hipMemsetAsync((char*)d_ws + WS_CTL, 0, CTL_ZERO_BYTES, stream) != hipSuccess) return;
    Args a{};
    for (int i = 0; i < 16; ++i) a.in[i] = (const float*)d_in[i];
    a.out = (float*)d_out; a.ws = (unsigned char*)d_ws;
#if MK_N_LAUNCHES == 1
    a.ph_lo = 0; a.ph_hi = NPHASE + (PROBE_DUP >= 0 ? 1 : 0); a.li = 0;
    hipLaunchKernelGGL(mk_fwd, dim3(grid), dim3(NWAVES * 64), LDS_BYTES, stream, a);
#else
    for (int p = 0; p < NPHASE; ++p) {
        if (p >= 2 && ((p - 2) & 7) == 2 && (((p - 2) >> 3) & 1) == 0) continue;
        a.ph_lo = p; a.ph_hi = p + 1; a.li = 0;
        hipLaunchKernelGGL(mk_fwd, dim3(grid), dim3(NWAVES * 64), LDS_BYTES, stream, a);
    }
#endif
}
```

```cpp
#include <hip/hip_runtime.h>
#include <cstdio>
#include <cstdint>
#include <cmath>
#define LAS __attribute__((address_space(3)))
#define GAS __attribute__((address_space(1)))
typedef _Float16 h16;
typedef _Float16 f16x8 __attribute__((ext_vector_type(8)));
typedef _Float16 f16x4 __attribute__((ext_vector_type(4)));
typedef _Float16 f16x2 __attribute__((ext_vector_type(2)));
typedef float f32x2 __attribute__((ext_vector_type(2)));
typedef float f32x4 __attribute__((ext_vector_type(4)));
typedef float f32x16 __attribute__((ext_vector_type(16)));
typedef unsigned u32x2 __attribute__((ext_vector_type(2)));
typedef unsigned u32x4 __attribute__((ext_vector_type(4)));
typedef short s16x4 __attribute__((ext_vector_type(4)));
__device__ __forceinline__ unsigned pk2h(float lo, float hi) { f32x2 v = {lo, hi}; f16x2 b = __builtin_convertvector(v, f16x2); return __builtin_bit_cast(unsigned, b); }

constexpr int DM = 1024, BATCH = 8, SEQ = 2048, DEPTH = 4, T = BATCH * SEQ;
constexpr int FOX_H = 16, FOX_D = 64, FOX_IN = 4 * DM + FOX_H;
constexpr int RET_H = 4, RET_DK = 256, RET_DV = 512, RET_IN = 6144;
constexpr int NG = 4, EPG = 8, NE = 32, EFF = 512;
constexpr int PAIRS = T * 2;
constexpr int LISTCAP = 16384;
constexpr int PROWS = PAIRS + NE * 256;
constexpr float EPS = 1e-6f;
constexpr float LOG2E = 1.4426950408889634f;

namespace pg8 {
constexpr int BM = 256, BK = 64, HALF = 128, HTB = HALF * BK * 2, STAGE_BYTES = 8 * HTB, NXCD = 8, WGM = 8;
__host__ __device__ __forceinline__ int lds_byte(int r, int c) { const int st = (r >> 4) * 2 + (c >> 5), rr = r & 15, cc = c & 31, ob = rr * 64 + cc * 2; return st * 1024 + (ob ^ (((ob >> 9) & 1) << 5)); }
__host__ __device__ __forceinline__ void stage_rc(int b, int& R, int& C) { const int st = b / 1024, sb = b % 1024, swz = sb ^ (((sb >> 9) & 1) << 5); R = (st >> 1) * 16 + swz / 64; C = (st & 1) * 32 + (swz % 64) / 2; }
__host__ __device__ __forceinline__ int perm32(int rho) { const int n = rho >> 4, i = rho & 15; return 8 * (i >> 2) + 4 * n + (i & 3); }

struct Unit { int pm, pn, e, mt; };

struct StaticOrder {
    static constexpr bool GATHER = false;
    int nM, nN, nwg, G, c, K; const char* A; const char* Bt;
    __device__ void init(const void* A_, const void* Bt_, int M, int N, int K_, int G_, int c_) { A = (const char*)A_; Bt = (const char*)Bt_; K = K_; nM = M / BM; nN = N / BM; nwg = nM * nN; G = G_; c = c_; }
    __device__ bool next(int i, Unit& u) const {
        const long L = (long)i * G + c; if (L >= nwg) return false;
        int wgid = (int)L; { const int q = nwg / NXCD, r = nwg % NXCD, xcd = wgid % NXCD, off = wgid / NXCD; wgid = (xcd < r ? xcd * (q + 1) : r * (q + 1) + (xcd - r) * q) + off; }
        const int nig = WGM * nN, gid = wgid / nig, fm = gid * WGM, gsz = (nM - fm) < WGM ? (nM - fm) : WGM;
        u.pm = fm + ((wgid % nig) % gsz); u.pn = (wgid % nig) / gsz; u.e = 0; u.mt = 0; return true;
    }
    __device__ __forceinline__ const char* abase() const { return A; }
    __device__ __forceinline__ void aoff(const Unit& u, const int (&R)[2], const int (&C)[2], unsigned (&ao)[2][2]) const {
#pragma unroll
        for (int h = 0; h < 2; ++h)
#pragma unroll
            for (int i = 0; i < 2; ++i) ao[h][i] = (unsigned)(((size_t)(u.pm * BM + h * HALF + R[i]) * K + C[i]) * 2);
    }
    __device__ __forceinline__ const char* bbase(const Unit& u) const { return Bt + (size_t)u.pn * BM * K * 2; }
};

#define PG8_WAIT_V(n) asm volatile("s_waitcnt vmcnt(" #n ")" ::: "memory")
#define PG8_WAIT_L(n) asm volatile("s_waitcnt lgkmcnt(" #n ")" ::: "memory")
#define PG8_BAR __builtin_amdgcn_s_barrier()
#define PG8_SCHED __builtin_amdgcn_sched_barrier(0)

template <class Epi, class Sched, bool ALIGN_EPI>
__device__ __forceinline__ void gemm_phase(LAS unsigned char* lds, const int K, const Sched& S, const Epi& E, const int tid) {
    constexpr bool GATHER = Sched::GATHER;
    const int wid = __builtin_amdgcn_readfirstlane(tid >> 6), lane = tid & 63, wr = wid >> 2, wc = wid & 3, fr = lane & 15, fq = lane >> 4;
    const int nt = K / BK;
    int Rr[2], Cc[2]; unsigned voffB[2], voffA[2];
#pragma unroll
    for (int i = 0; i < 2; ++i) { int R, C; stage_rc(tid * 16 + i * 8192, R, C); Rr[i] = R; Cc[i] = C; const int Rb = Epi::PERM ? ((R & ~31) + perm32(R & 31)) : R; voffB[i] = (unsigned)(Rb * K + C) * 2u; voffA[i] = (unsigned)(R * K + C) * 2u; }
    const size_t kstep = (size_t)(BK * 2);
    const size_t hstep = (size_t)HALF * K * 2;
    const size_t tstep = 2 * hstep;
    const unsigned ldsw = (unsigned)wid * 1024u;
    const int aoff_l = lds_byte(wr * 64 + fr, fq * 8), boff_l = lds_byte(wc * 32 + fr, fq * 8);
    const char* const gA = S.abase();
    LAS u32x4* const park = (LAS u32x4*)(lds + STAGE_BYTES) + tid;
#define PG8_SA(b, h) (((b) * 2 + (h)) * HTB)
#define PG8_SB(b, h) ((4 + (b) * 2 + (h)) * HTB)
#define PG8_STAGE(bufoff, gbase, voff) do { _Pragma("unroll") for (int _i = 0; _i < 2; ++_i) \
        __builtin_amdgcn_global_load_lds((const unsigned*)((const char*)(gbase) + (voff)[_i]), (LAS unsigned*)(lds + (bufoff) + ldsw + _i * 8192), 16, 0, 0); } while (0)
#define PG8_STAGEA(bufoff, ubase, h, kb) do { if constexpr (GATHER) { \
        __builtin_amdgcn_global_load_lds((const unsigned*)((gA + (kb)) + aoC[h][0]), (LAS unsigned*)(lds + (bufoff) + ldsw), 16, 0, 0); \
        __builtin_amdgcn_global_load_lds((const unsigned*)((gA + (kb)) + aoC[h][1]), (LAS unsigned*)(lds + (bufoff) + ldsw + 8192), 16, 0, 0); \
      } else { PG8_STAGE(bufoff, (ubase) + (size_t)(h) * hstep + (kb), voffA); } } while (0)
#define PG8_LDA(dst, b, h) do { _Pragma("unroll") for (int m = 0; m < 4; ++m) _Pragma("unroll") for (int k = 0; k < 2; ++k) dst[m][k] = *(const LAS f16x8*)(lds + PG8_SA(b, h) + aoff_l + m * 2048 + k * 1024); } while (0)
#define PG8_LDB(dst, b, h) do { _Pragma("unroll") for (int n = 0; n < 2; ++n) _Pragma("unroll") for (int k = 0; k < 2; ++k) dst[n][k] = *(const LAS f16x8*)(lds + PG8_SB(b, h) + boff_l + n * 2048 + k * 1024); } while (0)
#define PG8_MMA(ai, bj, At, Bt) do { __builtin_amdgcn_s_setprio(1); _Pragma("unroll") for (int m = 0; m < 4; ++m) _Pragma("unroll") for (int n = 0; n < 2; ++n) _Pragma("unroll") for (int k = 0; k < 2; ++k) \
        acc[ai][bj][m][n] = __builtin_amdgcn_mfma_f32_16x16x32_f16(Bt[n][k], At[m][k], acc[ai][bj][m][n], 0, 0, 0); __builtin_amdgcn_s_setprio(0); } while (0)
    Unit cur, nxt; int ui = 0;
    if (!S.next(0, cur)) return;
    f32x4 acc[2][2][4][2];
#pragma unroll
    for (int a = 0; a < 2; ++a)
#pragma unroll
        for (int b = 0; b < 2; ++b)
#pragma unroll
            for (int m = 0; m < 4; ++m)
#pragma unroll
                for (int n = 0; n < 2; ++n) acc[a][b][m][n] = (f32x4){0.f, 0.f, 0.f, 0.f};
    f16x8 At[4][2], B0[2][2], B1[2][2];
    unsigned aoC[2][2] = {{0u, 0u}, {0u, 0u}};
    if constexpr (GATHER) S.aoff(cur, Rr, Cc, aoC);
    const char* cA = gA + (size_t)cur.pm * tstep;
    const char* cB = S.bbase(cur);
    PG8_STAGE(PG8_SB(0, 0), cB, voffB); PG8_STAGE(PG8_SB(0, 1), cB + hstep, voffB); PG8_STAGEA(PG8_SA(0, 0), cA, 0, 0); PG8_STAGEA(PG8_SA(0, 1), cA, 1, 0);
    if (wr == 1) PG8_BAR;
    PG8_WAIT_V(2); PG8_BAR;
    PG8_STAGE(PG8_SB(1, 0), cB + kstep, voffB); PG8_STAGEA(PG8_SA(1, 0), cA, 0, kstep); PG8_STAGE(PG8_SB(1, 1), cB + hstep + kstep, voffB);
    PG8_WAIT_V(6); PG8_BAR;
    for (;;) {
        const bool has_next = S.next(ui + 1, nxt);
        const char* nB = cB; const char* nA = cA;
        if (has_next) { nB = S.bbase(nxt); nA = gA + (size_t)nxt.pm * tstep; }
        if constexpr (GATHER) { unsigned aoN[2][2];
            if (has_next) S.aoff(nxt, Rr, Cc, aoN); else { aoN[0][0] = aoC[0][0]; aoN[0][1] = aoC[0][1]; aoN[1][0] = aoC[1][0]; aoN[1][1] = aoC[1][1]; }
            *park = (u32x4){aoN[0][0], aoN[0][1], aoN[1][0], aoN[1][1]}; }
        for (int t = 0; t < nt; t += 2) {
            const bool last = (t == nt - 2);
            const size_t k1 = (size_t)(t + 1) * kstep;
            const size_t k2 = last ? 0 : (size_t)(t + 2) * kstep, k3 = k2 + kstep;
            const char* a2 = last ? nA : cA;
            const char* b2 = (last ? nB : cB) + k2; const char* b3 = b2 + kstep;
            PG8_LDB(B0, 0, 0); PG8_LDB(B1, 0, 1); PG8_SCHED; PG8_LDA(At, 0, 0); PG8_STAGEA(PG8_SA(1, 1), cA, 1, k1);
            if constexpr (GATHER) { if (last) { const u32x4 p = *park; aoC[0][0] = p.x; aoC[0][1] = p.y; aoC[1][0] = p.z; aoC[1][1] = p.w; } }
            PG8_WAIT_V(8); PG8_WAIT_L(0); PG8_BAR; PG8_MMA(0, 0, At, B0); PG8_MMA(0, 1, At, B1); PG8_BAR; PG8_SCHED;
            PG8_LDA(At, 0, 1); PG8_STAGE(PG8_SB(0, 0), b2, voffB); PG8_STAGE(PG8_SB(0, 1), b2 + hstep, voffB); PG8_STAGEA(PG8_SA(0, 0), a2, 0, k2);
            PG8_WAIT_V(8); PG8_WAIT_L(0); PG8_BAR; PG8_MMA(1, 0, At, B0); PG8_MMA(1, 1, At, B1); PG8_BAR; PG8_SCHED;
            PG8_LDB(B0, 1, 0); PG8_LDB(B1, 1, 1); PG8_SCHED; PG8_LDA(At, 1, 0); PG8_STAGEA(PG8_SA(0, 1), a2, 1, k2);
            PG8_WAIT_V(8); PG8_WAIT_L(0); PG8_BAR; PG8_MMA(0, 0, At, B0); PG8_MMA(0, 1, At, B1); PG8_BAR; PG8_SCHED;
            PG8_LDA(At, 1, 1); PG8_STAGE(PG8_SB(1, 0), b3, voffB); PG8_STAGE(PG8_SB(1, 1), b3 + hstep, voffB); PG8_STAGEA(PG8_SA(1, 0), a2, 0, k3);
            PG8_WAIT_V(8); PG8_WAIT_L(0); PG8_BAR; PG8_MMA(1, 0, At, B0); PG8_MMA(1, 1, At, B1); PG8_BAR; PG8_SCHED;
        }
        if constexpr (ALIGN_EPI) { if (wr == 0) PG8_BAR; }
        E(acc, cur, wr, wc, fr, fq);
        if (!has_next) break;
#pragma unroll
        for (int a = 0; a < 2; ++a)
#pragma unroll
            for (int b = 0; b < 2; ++b)
#pragma unroll
                for (int m = 0; m < 4; ++m)
#pragma unroll
                    for (int n = 0; n < 2; ++n) acc[a][b][m][n] = (f32x4){0.f, 0.f, 0.f, 0.f};
        cur = nxt; cB = nB; cA = nA; ++ui;
        if constexpr (ALIGN_EPI) { if (wr == 1) PG8_BAR; }
    }
    PG8_WAIT_V(0);
    if constexpr (!ALIGN_EPI) { if (wr == 0) PG8_BAR; }
    PG8_BAR;
#undef PG8_SA
#undef PG8_SB
#undef PG8_STAGE
#undef PG8_STAGEA
#undef PG8_LDA
#undef PG8_LDB
#undef PG8_MMA
}

struct EpiH16 {
    static constexpr bool PERM = true;
    h16* O; int ldc; int split_cols; size_t split_stride; const float* rstd; float scale0, scale1; int rot; const float* ct; const float* st;
    __device__ __forceinline__ void operator()(const f32x4 (&acc)[2][2][4][2], const Unit& u, int wr, int wc, int fr, int fq) const {
        const int row0 = u.pm * BM + wr * 64 + fr; int colt = u.pn * BM; h16* base = O;
        const int t = colt / split_cols; base += (size_t)t * split_stride; colt -= t * split_cols;
        const float sc = (t == 0) ? scale0 : ((t == 1) ? scale1 : 1.f);
        const int col0 = colt + wc * 32 + 8 * fq;
        const bool dorot = rot && (t < 2);
#pragma unroll
        for (int ai = 0; ai < 2; ++ai)
#pragma unroll
            for (int m = 0; m < 4; ++m) {
                const int row = row0 + ai * HALF + m * 16; const float rs = rstd[row] * sc;
                h16* rowp = base + (size_t)row * ldc + col0;
                if (dorot) {
                    const int pos = row & (SEQ - 1); const int d0 = wc * 32 + 8 * fq;
                    const f32x4 c0 = *(const f32x4*)(ct + pos * 128 + d0), c1 = *(const f32x4*)(ct + pos * 128 + d0 + 4);
                    const f32x4 s0 = *(const f32x4*)(st + pos * 128 + d0), s1 = *(const f32x4*)(st + pos * 128 + d0 + 4);
                    const f32x4 a0 = acc[ai][0][m][0] * rs, a1 = acc[ai][0][m][1] * rs, b0 = acc[ai][1][m][0] * rs, b1 = acc[ai][1][m][1] * rs;
                    const f32x4 o10 = a0 * c0 - b0 * s0, o11 = a1 * c1 - b1 * s1, o20 = a0 * s0 + b0 * c0, o21 = a1 * s1 + b1 * c1;
                    u32x4 w; w.x = pk2h(o10[0], o10[1]); w.y = pk2h(o10[2], o10[3]); w.z = pk2h(o11[0], o11[1]); w.w = pk2h(o11[2], o11[3]);
                    *(u32x4*)(rowp) = w;
                    w.x = pk2h(o20[0], o20[1]); w.y = pk2h(o20[2], o20[3]); w.z = pk2h(o21[0], o21[1]); w.w = pk2h(o21[2], o21[3]);
                    *(u32x4*)(rowp + HALF) = w;
                } else {
#pragma unroll
                    for (int bj = 0; bj < 2; ++bj) { const f32x4 v0 = acc[ai][bj][m][0] * rs, v1 = acc[ai][bj][m][1] * rs;
                        u32x4 w; w.x = pk2h(v0[0], v0[1]); w.y = pk2h(v0[2], v0[3]); w.z = pk2h(v1[0], v1[1]); w.w = pk2h(v1[2], v1[3]);
                        *(u32x4*)(rowp + bj * HALF) = w; }
                }
            }
    }
};
struct EpiResid {
    static constexpr bool PERM = false;
    float* H; int ldc;
    __device__ __forceinline__ void operator()(const f32x4 (&acc)[2][2][4][2], const Unit& u, int wr, int wc, int fr, int fq) const {
        const int col0 = u.pn * BM + wc * 32 + 4 * fq, row0 = u.pm * BM + wr * 64 + fr;
#pragma unroll
        for (int ai = 0; ai < 2; ++ai)
#pragma unroll
            for (int m = 0; m < 4; ++m) { float* rp = H + (size_t)(row0 + ai * HALF + m * 16) * ldc + col0;
#pragma unroll
                for (int bj = 0; bj < 2; ++bj)
#pragma unroll
                    for (int n = 0; n < 2; ++n) { f32x4* p = (f32x4*)(rp + bj * HALF + n * 16); *p = *p + acc[ai][bj][m][n]; } }
    }
};
struct EpiStoreF32 {
    static constexpr bool PERM = false;
    float* Y; int ldc;
    __device__ __forceinline__ void operator()(const f32x4 (&acc)[2][2][4][2], const Unit& u, int wr, int wc, int fr, int fq) const {
        const int col0 = u.pn * BM + wc * 32 + 4 * fq, row0 = u.pm * BM + wr * 64 + fr;
#pragma unroll
        for (int ai = 0; ai < 2; ++ai)
#pragma unroll
            for (int m = 0; m < 4; ++m) { float* rp = Y + (size_t)(row0 + ai * HALF + m * 16) * ldc + col0;
#pragma unroll
                for (int bj = 0; bj < 2; ++bj)
#pragma unroll
                    for (int n = 0; n < 2; ++n) *(f32x4*)(rp + bj * HALF + n * 16) = acc[ai][bj][m][n]; }
    }
};
struct EpiStoreH16 {
    static constexpr bool PERM = true;
    h16* Y; int ldc;
    __device__ __forceinline__ void operator()(const f32x4 (&acc)[2][2][4][2], const Unit& u, int wr, int wc, int fr, int fq) const {
        const int col0 = u.pn * BM + wc * 32 + 8 * fq, row0 = u.pm * BM + wr * 64 + fr;
#pragma unroll
        for (int ai = 0; ai < 2; ++ai)
#pragma unroll
            for (int m = 0; m < 4; ++m) { h16* rp = Y + (size_t)(row0 + ai * HALF + m * 16) * ldc + col0;
#pragma unroll
                for (int bj = 0; bj < 2; ++bj) { const f32x4 v0 = acc[ai][bj][m][0], v1 = acc[ai][bj][m][1];
                    u32x4 w; w.x = pk2h(v0[0], v0[1]); w.y = pk2h(v0[2], v0[3]); w.z = pk2h(v1[0], v1[1]); w.w = pk2h(v1[2], v1[3]);
                    *(u32x4*)(rp + bj * HALF) = w; } }
    }
};
struct EpiSwiGLU {
    static constexpr bool PERM = true;
    h16* ACT; const float* rstd; const int* list; const int* cnt;
    __device__ __forceinline__ void operator()(const f32x4 (&acc)[2][2][4][2], const Unit& u, int wr, int wc, int fr, int fq) const {
        const int row0 = u.pm * BM + wr * 64 + fr, rank0 = u.mt * BM + wr * 64 + fr; const int c = cnt[u.e];
        const int col0 = u.pn * 128 + wc * 16 + 4 * fq;
#pragma unroll
        for (int ai = 0; ai < 2; ++ai)
#pragma unroll
            for (int m = 0; m < 4; ++m) {
                const int rank = rank0 + ai * HALF + m * 16; float rs = 0.f;
                if (rank < c) rs = rstd[list[u.e * LISTCAP + rank] >> 1];
                h16* rowp = ACT + (size_t)(row0 + ai * HALF + m * 16) * EFF + col0;
#pragma unroll
                for (int bj = 0; bj < 2; ++bj) { const f32x4 a = acc[ai][bj][m][0] * rs, b = acc[ai][bj][m][1] * rs; f32x4 o;
#pragma unroll
                    for (int q = 0; q < 4; ++q) o[q] = a[q] * __builtin_amdgcn_rcpf(1.0f + __builtin_amdgcn_exp2f(-a[q] * LOG2E)) * b[q];
                    u32x2 w; w.x = pk2h(o[0], o[1]); w.y = pk2h(o[2], o[3]); *(u32x2*)(rowp + bj * 64) = w; }
            }
    }
};
}
namespace attn_body {
constexpr int D = 64, DMP = 1024;
constexpr int NW = 8, QBLK = 32, QB = QBLK * NW, KVBLK = 64, NQB = SEQ / QB;
__device__ __forceinline__ int crow(int r, int hi) { return (r & 3) + 8 * (r >> 2) + 4 * hi; }
#define SBAR() __builtin_amdgcn_sched_barrier(0)
__device__ __forceinline__ void cmask(f32x16& p0, f32x16& p1, int jb, int qrel, int hi) {
    const float NEG = -INFINITY; int kb = 64 * jb + 4 * hi;
#pragma unroll
    for (int r = 0; r < 16; ++r) { int kv = kb + (r & 3) + 8 * (r >> 2); if (kv > qrel) p0[r] = NEG; if (kv + 32 > qrel) p1[r] = NEG; }
}
constexpr int NSLOT = 3, SLOTB = 8192;
constexpr int LDS_K = 0, LDS_V = NSLOT * SLOTB, LDS_WS = 2 * NSLOT * SLOTB, LDS_OST = LDS_WS + NW * 64 * 4, LDS_BIAS = LDS_OST + NW * 4096, LDS_BYTES = LDS_BIAS + SEQ * 4;
constexpr float C2 = 0.125f * LOG2E;
__device__ __forceinline__ void glds16(const void* gsrc, unsigned lds_dst) { unsigned keep;
    asm volatile("s_mov_b32 %0, m0\n\ts_mov_b32 m0, %2\n\ts_nop 0\n\tglobal_load_lds_dwordx4 %1, off\n\ts_mov_b32 m0, %0" : "=&s"(keep) : "v"(gsrc), "s"(lds_dst) : "memory"); }
__device__ __forceinline__ float max3f(float a, float b, float c) { float r; asm("v_max3_f32 %0, %1, %2, %3" : "=v"(r) : "v"(a), "v"(b), "v"(c)); return r; }
__device__ __forceinline__ float max2f(float a, float b) { float r; asm("v_max_f32_e32 %0, %1, %2" : "=v"(r) : "v"(a), "v"(b)); return r; }
__device__ __forceinline__ float fadd_s(float a, float b) { float r; asm("v_add_f32_e32 %0, %1, %2" : "=v"(r) : "v"(a), "v"(b)); return r; }
__device__ __forceinline__ float fsub_s(float a, float b) { float r; asm("v_sub_f32_e32 %0, %1, %2" : "=v"(r) : "v"(a), "v"(b)); return r; }
__device__ __forceinline__ unsigned split_hl(float v) { const h16 hi = (h16)v; const h16 lo = (h16)(v - (float)hi); return (unsigned)__builtin_bit_cast(unsigned short, hi) | ((unsigned)__builtin_bit_cast(unsigned short, lo) << 16); }
#define WAIT_BAR(N) asm volatile("s_waitcnt vmcnt(" #N ") lgkmcnt(0)\n\ts_barrier" ::: "memory")
#define MF16(a, b, c) __builtin_amdgcn_mfma_f32_32x32x16_f16(a, b, c, 0, 0, 0)
typedef LAS const char* lds_cptr;
typedef short v4i16_t __attribute__((ext_vector_type(4)));
__device__ __forceinline__ void kload8(f16x8* kf, lds_cptr kp) {
    kf[0] = *(const LAS f16x8*)(kp);        kf[1] = *(const LAS f16x8*)(kp + 512);
    kf[2] = *(const LAS f16x8*)(kp + 2048); kf[3] = *(const LAS f16x8*)(kp + 2560);
    kf[4] = *(const LAS f16x8*)(kp + 4096); kf[5] = *(const LAS f16x8*)(kp + 4608);
    kf[6] = *(const LAS f16x8*)(kp + 6144); kf[7] = *(const LAS f16x8*)(kp + 6656);
}
__device__ __forceinline__ void kload2(f16x8* kf, lds_cptr kp, int j) { kf[2 * j] = *(const LAS f16x8*)(kp + j * 2048); kf[2 * j + 1] = *(const LAS f16x8*)(kp + j * 2048 + 512); }
__device__ __forceinline__ s16x4 vtr(lds_cptr p) { return __builtin_bit_cast(s16x4, __builtin_amdgcn_ds_read_tr16_b64_v4i16((LAS v4i16_t*)p)); }
__device__ __forceinline__ f16x8 mk8(s16x4 lo, s16x4 hi) { typedef short s16x8 __attribute__((ext_vector_type(8))); s16x8 t = {lo[0], lo[1], lo[2], lo[3], hi[0], hi[1], hi[2], hi[3]}; return __builtin_bit_cast(f16x8, t); }
__device__ __forceinline__ f16x4 ext_frag(unsigned w0, unsigned w1) { u32x2 t = {w0, w1}; return __builtin_bit_cast(f16x4, t); }
#define MF8(a, b, c) __builtin_amdgcn_mfma_f32_32x32x8f16(a, b, c, 0, 0, 0)
__device__ __forceinline__ float rowmax(const f32x16& p0, const f32x16& p1) {
    float a = max3f(p0[0], p0[1], p1[0]), b = max3f(p0[2], p0[3], p1[1]); a = max3f(a, p1[2], p1[3]);
#pragma unroll
    for (int r = 4; r < 16; r += 4) { a = max3f(a, p0[r], p0[r + 1]); b = max3f(b, p0[r + 2], p0[r + 3]); a = max3f(a, p1[r], p1[r + 1]); b = max3f(b, p1[r + 2], p1[r + 3]); }
    const float m = max2f(a, b);
    auto rr = __builtin_amdgcn_permlane32_swap(__float_as_uint(m), __float_as_uint(m), false, false);
    return max2f(__uint_as_float(rr[0]), __uint_as_float(rr[1]));
}
__device__ __forceinline__ void qkt(f32x16& p0, f32x16& p1, const char* Kslot, const f16x8* qr, f16x4 kb0, f16x4 kb1, f16x4 qe, int r32, int hi) {
    const char* kb = Kslot + hi * 1024 + r32 * 16;
    const f32x16 z = {};
    p0 = MF8(kb0, qe, z); p1 = MF8(kb1, qe, z);
#pragma unroll
    for (int d0 = 0; d0 < 4; ++d0) {
        const f16x8 b0 = *reinterpret_cast<const f16x8*>(kb + d0 * 2048);
        const f16x8 b1 = *reinterpret_cast<const f16x8*>(kb + d0 * 2048 + 512);
        p0 = MF16(b0, qr[d0], p0); p1 = MF16(b1, qr[d0], p1); }
}
__device__ __forceinline__ void pv(f32x16* o, int vb, f16x8 pa0, f16x8 pa1, f16x8 pa2, f16x8 pa3) {
#pragma unroll
    for (int d0 = 0; d0 < 2; ++d0) { s16x4 lo[4], hi[4];
#pragma unroll
        for (int ks = 0; ks < 4; ++ks) {
            asm volatile("ds_read_b64_tr_b16 %0,%1 offset:%c2" : "=&v"(lo[ks]) : "v"(vb), "i"(d0 * 4096 + ks * 1024) : "memory");
            asm volatile("ds_read_b64_tr_b16 %0,%1 offset:%c2" : "=&v"(hi[ks]) : "v"(vb), "i"(d0 * 4096 + ks * 1024 + 512) : "memory"); }
        asm volatile("s_waitcnt lgkmcnt(0)" ::: "memory"); SBAR();
        o[d0] = MF16(pa0, mk8(lo[0], hi[0]), o[d0]);
        o[d0] = MF16(pa1, mk8(lo[1], hi[1]), o[d0]);
        o[d0] = MF16(pa2, mk8(lo[2], hi[2]), o[d0]);
        o[d0] = MF16(pa3, mk8(lo[3], hi[3]), o[d0]);
    }
}
#define ATTN_ONES 0x3C003C00u
template <int THRL> __device__ __forceinline__ void attn_unit(int b, int h, int qb, const h16* Q, const h16* __restrict__ K, const h16* __restrict__ V, const h16* __restrict__ G, const float* __restrict__ cum, h16* O, char* shm, const int tid) {
    const int lane = tid & 63, r32 = lane & 31, hi = lane >> 5; const int wid = __builtin_amdgcn_readfirstlane(tid >> 6);
    const long rowbase = (long)b * SEQ; const int q0 = qb * QB;
    const h16* Qw = Q + (rowbase + q0 + wid * QBLK) * DMP + h * D;
    const h16* Kh = K + rowbase * DMP + h * D, *Vh = V + rowbase * DMP + h * D;
    const unsigned lds0 = (unsigned)(uintptr_t)shm;
    float* wsf = (float*)(shm + LDS_WS) + wid * 64;
    const h16* ksrc = Kh + (long)lane * DMP + wid * 8;
    const h16* vsrc = Vh + (long)(16 * (wid & 3) + (lane >> 2)) * DMP + (wid >> 2) * 32 + (lane & 3) * 8;
    const unsigned kdst = lds0 + LDS_K + wid * 1024, vdst = lds0 + LDS_V + wid * 1024;
#define DMA_K(t, slot) glds16(ksrc + (long)(t) * KVBLK * DMP, (unsigned)__builtin_amdgcn_readfirstlane(kdst + (slot)))
#define DMA_V(t, slot) glds16(vsrc + (long)(t) * KVBLK * DMP, (unsigned)__builtin_amdgcn_readfirstlane(vdst + (slot)))
    const int vb0 = (int)(lds0 + LDS_V) + ((lane >> 4) & 1) * 32 + (lane & 3) * 8 + (4 * hi + ((lane & 15) >> 2)) * 64;
    const char* Kbase = shm + LDS_K; f16x8 kf[8];
    const lds_cptr shm3 = (lds_cptr)shm; const lds_cptr kp0 = shm3 + LDS_K + hi * 1024 + r32 * 16; const lds_cptr vp0 = shm3 + LDS_V + ((lane >> 4) & 1) * 32 + (lane & 3) * 8 + (4 * hi + ((lane & 15) >> 2)) * 64;
    const LAS unsigned* biasw = (const LAS unsigned*)(shm3 + LDS_BIAS);
    const int NT = (q0 + QB) / KVBLK;
    DMA_K(0, 0); DMA_V(0, 0); DMA_K(1, SLOTB);
    { const float* cb = cum + (long)(b * FOX_H + h) * SEQ; const float cref = cb[q0];
      LAS unsigned* bw = (LAS unsigned*)(shm3 + LDS_BIAS);
      for (int j = tid; j < q0 + QB; j += NW * 64) bw[j] = split_hl(fmaxf((cref - cb[j]) * LOG2E, -30000.f)); }
    f16x8 qr[4];
#pragma unroll
    for (int d0 = 0; d0 < 4; ++d0) qr[d0] = *reinterpret_cast<const f16x8*>(&Qw[(long)r32 * DMP + d0 * 16 + hi * 8]);
    float mhat = 0.f, l_reg = 0.f; f32x16 o[2]; o[0] = f32x16{}; o[1] = f32x16{};
    unsigned qew1 = 0u;
    const unsigned qew0 = hi ? 0u : ATTN_ONES, kew1 = hi ? 0u : ATTN_ONES;
#define QE() ext_frag(qew0, qew1)
#define KE(w) ext_frag(hi ? 0u : (w), kew1)
#define SETM() do { qew1 = hi ? 0u : split_hl(-mhat); } while (0)
    const int qrel = wid * QBLK + r32;
#define CMASK(P0, P1, t) do { int jb_ = (t) - (NT - 4); if (jb_ >= 0) cmask(P0, P1, jb_, qrel, hi); } while (0)
    bool resc = false;
#define START(P0, P1) do { const float rm = rowmax(P0, P1); resc = false; \
    { const float dl = rm; mhat = fadd_s(mhat, dl); \
      _Pragma("unroll") for (int r = 0; r < 16; ++r) { P0[r] = fsub_s(P0[r], dl); P1[r] = fsub_s(P1[r], dl); } \
      SETM(); } \
    _Pragma("unroll") for (int r = 0; r < 16; ++r) P0[r] = __builtin_amdgcn_exp2f(P0[r]); } while (0)
#define RESC() do { if (resc) { asm volatile("s_waitcnt lgkmcnt(0)" ::: "memory"); \
      _Pragma("unroll") for (int d_ = 0; d_ < 2; ++d_) _Pragma("unroll") for (int r = 0; r < 16; ++r) o[d_][r] *= wsf[crow(r, hi)]; } } while (0)
    f32x16 pA0, pA1, pB0, pB1;
    int sl_prev = 0, sl_cur = 0, sl_next = SLOTB;
#define ROT() do { sl_prev = sl_cur; sl_cur = sl_next; sl_next = (sl_next == (NSLOT - 1) * SLOTB) ? 0 : sl_next + SLOTB; } while (0)
    DMA_K(2, 2 * SLOTB);
    WAIT_BAR(3);
    unsigned bw0 = biasw[r32], bw1 = biasw[32 + r32];
    qkt(pA0, pA1, Kbase, qr, KE(bw0), KE(bw1), QE(), r32, hi); asm volatile("s_nop 15\n\ts_nop 7" : "+v"(pA0), "+v"(pA1)); CMASK(pA0, pA1, 0);
    START(pA0, pA1);
    _Pragma("unroll") for (int r = 0; r < 16; ++r) pA1[r] = __builtin_amdgcn_exp2f(pA1[r]);
    WAIT_BAR(0);
    DMA_K(3, 0); DMA_V(1, SLOTB);
    ROT();
    kload8(kf, kp0 + sl_cur);
    bw0 = biasw[64 + r32]; bw1 = biasw[96 + r32];
    WAIT_BAR(2);
    s16x4 vlo[8], vhi[8]; u32x4 pw0, pw1, pw2, pw3;
#define PKW(P, B) pk2h(P[B], P[B + 1])
#define PAF(k) __builtin_bit_cast(f16x8, pw##k)
#define VFR(i) mk8(vlo[i], vhi[i])
#define PIN(x) asm volatile("" : "+v"(x))
#define MX3(a, b, c) __builtin_fmaxf(__builtin_fmaxf((a), (b)), (c))
#define GAPA(MF, A0, A1, A2, A3, W0, W1, PW) do { MF; sacc += A0; sacc += A1; sacc += A2; sacc += A3; PIN(sacc); W0; W1; PIN(PW); SBAR(); } while (0)
#define EX(v) __builtin_amdgcn_exp2f(v)
#define GAPB(MF, X, B) do { MF; X[B] = EX(X[B]); X[B + 1] = EX(X[B + 1]); X[B + 2] = EX(X[B + 2]); X[B + 3] = EX(X[B + 3]); PIN(X); SBAR(); } while (0)
#define VRD(i) do { vlo[i] = vtr(vp_ + (((i) >> 2) * 4096 + ((i) & 3) * 1024)); vhi[i] = vtr(vp_ + (((i) >> 2) * 4096 + ((i) & 3) * 1024 + 512)); } while (0)
#define KRD(G_, j) do { if (G_) { kload2(kf, kp0 + sl_next, j); SBAR(); } } while (0)
#define STEP(C0, C1, P0, P1, t, GK, GV, GL) do { SBAR(); \
    const lds_cptr vp_ = vp0 + sl_prev; const f32x16 z_ = {}; \
    C0 = MF8(KE(bw0), QE(), z_); C1 = MF8(KE(bw1), QE(), z_); SBAR(); \
    VRD(0); SBAR(); float sacc = (P0[0] + P0[1]); \
    GAPA(C0 = MF16(kf[0], qr[0], C0), P0[2], P0[3], P0[4], P0[5],     pw0[0] = PKW(P0, 0), pw0[1] = PKW(P0, 2), pw0); \
    VRD(4); SBAR(); GAPA(C1 = MF16(kf[1], qr[0], C1), P0[6], P0[7], P0[8], P0[9],     pw0[2] = PKW(P0, 4), pw0[3] = PKW(P0, 6), pw0); \
    VRD(1); SBAR(); GAPA(C0 = MF16(kf[2], qr[1], C0),   P0[10], P0[11], P0[12], P0[13], pw1[0] = PKW(P0, 8), pw1[1] = PKW(P0, 10), pw1); \
    VRD(5); SBAR(); GAPA(C1 = MF16(kf[3], qr[1], C1),   P0[14], P0[15], P1[0], P1[1],   pw1[2] = PKW(P0, 12), pw1[3] = PKW(P0, 14), pw1); \
    VRD(2); SBAR(); GAPA(C0 = MF16(kf[4], qr[2], C0),   P1[2], P1[3], P1[4], P1[5],     pw2[0] = PKW(P1, 0), pw2[1] = PKW(P1, 2), pw2); \
    VRD(6); SBAR(); GAPA(C1 = MF16(kf[5], qr[2], C1),   P1[6], P1[7], P1[8], P1[9],     pw2[2] = PKW(P1, 4), pw2[3] = PKW(P1, 6), pw2); \
    VRD(3); SBAR(); GAPA(C0 = MF16(kf[6], qr[3], C0),   P1[10], P1[11], P1[12], P1[13], pw3[0] = PKW(P1, 8), pw3[1] = PKW(P1, 10), pw3); \
    VRD(7); SBAR(); GAPA(C1 = MF16(kf[7], qr[3], C1),   P1[14], P1[15], 0.f, 0.f,       pw3[2] = PKW(P1, 12), pw3[3] = PKW(P1, 14), pw3); \
    l_reg += sacc; \
    if (GK) { DMA_K((t) + 3, sl_cur); } if (GV) { DMA_V((t) + 1, sl_next); } \
    CMASK(C0, C1, t); \
    { float a = MX3(C0[0], C0[1], C1[0]), b_ = MX3(C0[2], C0[3], C1[1]); a = MX3(a, C1[2], C1[3]); \
      _Pragma("unroll") for (int r = 4; r < 16; r += 4) { a = MX3(a, C0[r], C0[r + 1]); b_ = MX3(b_, C0[r + 2], C0[r + 3]); a = MX3(a, C1[r], C1[r + 1]); b_ = MX3(b_, C1[r + 2], C1[r + 3]); } \
      float rm = __builtin_fmaxf(a, b_); { auto rr = __builtin_amdgcn_permlane32_swap(__float_as_uint(rm), __float_as_uint(rm), false, false); rm = __builtin_fmaxf(__uint_as_float(rr[0]), __uint_as_float(rr[1])); } \
      resc = false; \
      if (__builtin_expect(__any(rm > (float)THRL), 0)) { const float dl = __builtin_fmaxf(rm, 0.f); mhat += dl; \
        _Pragma("unroll") for (int r = 0; r < 16; ++r) { C0[r] -= dl; C1[r] -= dl; } \
        SETM(); \
        const float f = __builtin_amdgcn_exp2f(-dl); l_reg *= f; if (hi == 0) wsf[r32] = f; resc = true; } } \
    SBAR(); \
    if (GL) { bw0 = biasw[((t) + 1) * 64 + r32]; bw1 = biasw[((t) + 1) * 64 + 32 + r32]; } \
    GAPB(o[0] = MF16(PAF(0), VFR(0), o[0]), C0, 0); \
    GAPB(o[1] = MF16(PAF(0), VFR(4), o[1]), C0, 4); \
    KRD(GL, 0); GAPB(o[0] = MF16(PAF(1), VFR(1), o[0]), C0, 8); \
    KRD(GL, 1); GAPB(o[1] = MF16(PAF(1), VFR(5), o[1]), C0, 12); \
    KRD(GL, 2); GAPB(o[0] = MF16(PAF(2), VFR(2), o[0]), C1, 0); \
    KRD(GL, 3); GAPB(o[1] = MF16(PAF(2), VFR(6), o[1]), C1, 4); \
    GAPB(o[0] = MF16(PAF(3), VFR(3), o[0]), C1, 8); \
    GAPB(o[1] = MF16(PAF(3), VFR(7), o[1]), C1, 12); \
    } while (0)
    int t = 1;
#undef CMASK
#define CMASK(P0, P1, t) do {} while (0)
    for (; t + 5 < NT; t += 2) {
        STEP(pB0, pB1, pA0, pA1, t, true, true, true);     WAIT_BAR(2); RESC(); ROT();
        STEP(pA0, pA1, pB0, pB1, t + 1, true, true, true); WAIT_BAR(2); RESC(); ROT();
    }
#undef CMASK
#define CMASK(P0, P1, t) do { int jb_ = (t) - (NT - 4); if (jb_ >= 0) cmask(P0, P1, jb_, qrel, hi); } while (0)
#define ENDW(tt) do { if ((tt) + 3 < NT) { WAIT_BAR(2); } else if ((tt) + 2 < NT) { WAIT_BAR(1); } else { WAIT_BAR(0); } } while (0)
    for (; t + 1 < NT; t += 2) {
        STEP(pB0, pB1, pA0, pA1, t, (t + 3 < NT), (t + 1 < NT), (t + 1 < NT));         ENDW(t);     RESC(); ROT();
        STEP(pA0, pA1, pB0, pB1, t + 1, (t + 4 < NT), (t + 2 < NT), (t + 2 < NT));     ENDW(t + 1); RESC(); ROT();
    }
    STEP(pB0, pB1, pA0, pA1, NT - 1, false, false, false); RESC();
    { float sacc = pB0[0] + pB0[1]; _Pragma("unroll") for (int r = 2; r < 16; ++r) sacc += pB0[r]; _Pragma("unroll") for (int r = 0; r < 16; ++r) sacc += pB1[r]; l_reg += sacc;
      pw0 = (u32x4){PKW(pB0, 0), PKW(pB0, 2), PKW(pB0, 4), PKW(pB0, 6)}; pw1 = (u32x4){PKW(pB0, 8), PKW(pB0, 10), PKW(pB0, 12), PKW(pB0, 14)}; pw2 = (u32x4){PKW(pB1, 0), PKW(pB1, 2), PKW(pB1, 4), PKW(pB1, 6)}; pw3 = (u32x4){PKW(pB1, 8), PKW(pB1, 10), PKW(pB1, 12), PKW(pB1, 14)};
      SBAR(); pv(o, vb0 + sl_cur, PAF(0), PAF(1), PAF(2), PAF(3)); }
#undef PKW
#undef PAF
#undef VFR
#undef PIN
#undef MX3
#undef GAPA
#undef GAPB
#undef EX
#undef VRD
#undef KRD
#undef STEP
#undef ENDW
    { auto rr = __builtin_amdgcn_permlane32_swap(__float_as_uint(l_reg), __float_as_uint(l_reg), false, false); l_reg = __uint_as_float(rr[0]) + __uint_as_float(rr[1]); }
    if (hi == 0) wsf[32 + r32] = l_reg; asm volatile("s_waitcnt lgkmcnt(0)" ::: "memory");
    float rli[16];
#pragma unroll
    for (int r = 0; r < 16; ++r) rli[r] = __builtin_amdgcn_rcpf(wsf[32 + crow(r, hi)]);
    h16* Ow = O + (rowbase + q0 + wid * QBLK) * DMP + h * D;
    const h16* Gw = G + (rowbase + q0 + wid * QBLK) * DMP + h * D;
    { h16* stg = (h16*)(shm + LDS_OST) + wid * 2048;
#pragma unroll
      for (int r = 0; r < 16; ++r) { const int orow = crow(r, hi);
#pragma unroll
        for (int d0 = 0; d0 < 2; ++d0) stg[orow * 64 + d0 * 32 + r32] = (h16)(o[d0][r] * rli[r]); }
      asm volatile("s_waitcnt lgkmcnt(0)" ::: "memory");
#pragma unroll
      for (int i = 0; i < 4; ++i) { const int row = i * 8 + (lane >> 3), ch = lane & 7; const f16x8 v = *(const f16x8*)(stg + row * 64 + ch * 8); const f16x8 g = *(const f16x8*)(Gw + (long)row * DMP + ch * 8);
        float r8[8];
#pragma unroll
        for (int e = 0; e < 8; ++e) { const float gg = (float)g[e]; r8[e] = (float)v[e] * __builtin_amdgcn_rcpf(1.0f + __builtin_amdgcn_exp2f(-gg * LOG2E)); }
        u32x4 w; w.x = pk2h(r8[0], r8[1]); w.y = pk2h(r8[2], r8[3]); w.z = pk2h(r8[4], r8[5]); w.w = pk2h(r8[6], r8[7]);
        *(u32x4*)(Ow + (long)row * DMP + ch * 8) = w; } }
    asm volatile("s_waitcnt lgkmcnt(0)\n\ts_barrier" ::: "memory");
#undef DMA_K
#undef DMA_V
#undef CMASK
#undef START
#undef RESC
#undef ROT
#undef QE
#undef KE
#undef SETM
}
#undef SBAR
#undef WAIT_BAR
#undef MF16
#undef MF8
}
constexpr int NWAVES = 8;
#ifndef MK_N_LAUNCHES
#define MK_N_LAUNCHES 1
#endif
constexpr int NPHASE = 2 + 8 * DEPTH;
constexpr size_t MiB = 1u << 20;
constexpr size_t WS_CTL = 0, CTL_ZERO_BYTES = 1 * MiB;
constexpr size_t SZ_WFOX = (size_t)4096 * 1024 * 2, SZ_WFO = (size_t)1024 * 1024 * 2, SZ_WRET = (size_t)6144 * 1024 * 2, SZ_WRO = (size_t)1024 * 2048 * 2;
constexpr size_t SZ_WGU = (size_t)1024 * 1024 * 2, SZ_WD = (size_t)1024 * 512 * 2;
constexpr size_t WS_WFOX = 1 * MiB, WS_WFO = WS_WFOX + 2 * SZ_WFOX, WS_WRET = WS_WFO + 2 * SZ_WFO, WS_WRO = WS_WRET + 2 * SZ_WRET;
constexpr size_t WS_WGU = WS_WRO + 2 * SZ_WRO, WS_WD = WS_WGU + (size_t)DEPTH * NE * SZ_WGU, WS_WEND = WS_WD + (size_t)DEPTH * NE * SZ_WD;
constexpr size_t SZ_RW = (size_t)32 * 64 * 24 * 2, SZ_FW = (size_t)32 * 64 * 8 * 2;
constexpr size_t WS_RW = WS_WEND, WS_FW = WS_RW + DEPTH * SZ_RW, WS_ROPE = WS_FW + 2 * SZ_FW;
constexpr size_t WS_H = WS_ROPE + 2 * (size_t)SEQ * 128 * 4;
constexpr size_t WS_HN = WS_H + (size_t)T * DM * 4;
constexpr size_t WS_RSTD = WS_HN + (size_t)(T + 8) * DM * 2;
constexpr size_t WS_FLOG = WS_RSTD + (size_t)T * 4, WS_CUM = WS_FLOG + (size_t)T * 16 * 4;
constexpr size_t WS_EID = WS_CUM + (size_t)BATCH * FOX_H * SEQ * 4, WS_RANK = WS_EID + PAIRS * 4, WS_GATE = WS_RANK + PAIRS * 4, WS_LIST = WS_GATE + PAIRS * 4;
constexpr size_t WS_QKVG = (WS_LIST + (size_t)NE * LISTCAP * 4 + 255) & ~(size_t)255;
constexpr size_t SZ_T1K = (size_t)T * 1024 * 2;
constexpr size_t WS_OG = WS_QKVG + 6 * SZ_T1K;
constexpr size_t WS_RO = WS_OG + 2 * SZ_T1K;
constexpr size_t WS_END0 = WS_RO + 2 * SZ_T1K;
constexpr size_t WS_DUMMY = WS_END0;
constexpr size_t WS_END = WS_DUMMY + 160 * MiB;
constexpr size_t WS_Y = WS_QKVG;
constexpr size_t WS_ACT = WS_RO;
static_assert((size_t)PROWS * 1024 * 2 <= 6 * SZ_T1K && (size_t)PROWS * 512 * 2 <= 2 * SZ_T1K, "overlays");
constexpr int CW_TMO = 0, CW_BAR = 4096, CW_CNT = 16384, CW_CNT2 = 16384 + 1024;
constexpr int RING_BYTES = 147456;
constexpr int LDSCTL_OFF = RING_BYTES, MISC_OFF = LDSCTL_OFF;
constexpr int LDS_BYTES = RING_BYTES + 1024;

typedef GAS unsigned gu32;
#define RLX_AGENT __ATOMIC_RELAXED, __HIP_MEMORY_SCOPE_AGENT
#define LDS_WAIT() asm volatile("s_waitcnt lgkmcnt(0)" ::: "memory")

#define XB_TMO      128
#define XB_XCNT(j)  (256  + 64 * (j))
#define XB_XSUB(j)  (1280 + 64 * (j))
#define XB_XGEN(j)  (2304 + 64 * (j))
#define XB_TOP      3328
#define XB_TOPGEN   3392
#define XCD_BAR_WORDS 3456
#define XB_SPIN_CAP (1u << 18)
__device__ __forceinline__ unsigned xb_ld(unsigned* p)              { return __hip_atomic_load(p, __ATOMIC_RELAXED, __HIP_MEMORY_SCOPE_AGENT); }
__device__ __forceinline__ unsigned xb_add(unsigned* p, unsigned v) { return __hip_atomic_fetch_add(p, v, __ATOMIC_RELAXED, __HIP_MEMORY_SCOPE_AGENT); }
__device__ __forceinline__ unsigned xb_xcc_id() { return (unsigned)__builtin_amdgcn_s_getreg((3 << 11) | 20) & 0xFu; }
#define XB_SPIN(cond, bar) do { unsigned _sp = 0; while (cond) { __builtin_amdgcn_s_sleep(1); \
    if ((++_sp & 255u) == 0u) { if (xb_ld(&(bar)[XB_TMO])) break; if (_sp > XB_SPIN_CAP) { atomicAdd(&(bar)[XB_TMO], 1u); break; } } } } while (0)
struct XcdBarrier { unsigned* bar; unsigned x; volatile LAS unsigned* st; };
__device__ __forceinline__ XcdBarrier xcd_barrier_post(unsigned* bar, volatile LAS unsigned* st) {
    XcdBarrier b; b.bar = bar; b.x = xb_xcc_id(); b.st = st;
    if (threadIdx.x == 0) (void)xb_add(&bar[XB_XCNT(b.x)], 1u);
    return b;
}
__device__ __forceinline__ void xcd_barrier_complete(unsigned* bar, unsigned x, unsigned& nloc, unsigned& nx) {
    const unsigned G = gridDim.x * gridDim.y * gridDim.z;
    unsigned sum, cnt, mine, sp = 0u;
    for (;;) {
        sum = 0u; cnt = 0u; mine = 0u;
#pragma unroll
        for (unsigned j = 0; j < 16; ++j) { const unsigned c = xb_ld(&bar[XB_XCNT(j)]); sum += c; cnt += (c > 0u) ? 1u : 0u; mine = (j == x) ? c : mine; }
        if (sum == G) break;
        __builtin_amdgcn_s_sleep(1);
        if ((++sp & 255u) == 0u) { if (xb_ld(&bar[XB_TMO])) break; if (sp > XB_SPIN_CAP) { atomicAdd(&bar[XB_TMO], 1u); break; } }
    }
    nloc = mine > 0u ? mine : 1u; nx = cnt > 0u ? cnt : 1u;
}
__device__ __forceinline__ void xcd_barrier(const XcdBarrier& b) {
    asm volatile("s_waitcnt vmcnt(0)" ::: "memory");
    __syncthreads();
    if (threadIdx.x == 0) {
        unsigned* bar = b.bar;
        __builtin_amdgcn_s_waitcnt(0);
        unsigned nloc = b.st[0], nx = b.st[1];
        if (nloc == 0u) { xcd_barrier_complete(bar, b.x, nloc, nx); b.st[0] = nloc; b.st[1] = nx; }
        const unsigned old = xb_add(&bar[XB_XSUB(b.x)], 1u);
        const unsigned gen = old / nloc;
        if (old + 1u == (gen + 1u) * nloc) {
            __builtin_amdgcn_fence(__ATOMIC_RELEASE, "agent");
            asm volatile("s_waitcnt vmcnt(0)" ::: "memory");
            const unsigned og = xb_add(&bar[XB_TOP], 1u);
            const unsigned tg = og / nx;
            if (og + 1u == (tg + 1u) * nx) xb_add(&bar[XB_TOPGEN], 1u);
            else XB_SPIN(xb_ld(&bar[XB_TOPGEN]) == tg, bar);
            __builtin_amdgcn_fence(__ATOMIC_ACQUIRE, "agent");
            xb_add(&bar[XB_XGEN(b.x)], 1u);
            asm volatile("s_waitcnt vmcnt(0)" ::: "memory");
        } else {
            XB_SPIN(xb_ld(&bar[XB_XGEN(b.x)]) == gen, bar);
            __builtin_amdgcn_fence(__ATOMIC_ACQUIRE, "agent");
            asm volatile("s_waitcnt vmcnt(0)" ::: "memory");
        }
    }
    __syncthreads();
}

struct Args { const float* in[16]; float* out; unsigned char* ws; int ph_lo, ph_hi, li, pad; };

template <bool GU>
__device__ __forceinline__ void transpose_item(const float* W, int K, int ld, h16* WT, LAS float* scr, int kb, int nb, int lane) {
    const int k0 = 64 * kb, n0 = 64 * nb;
    const int lc = (lane & 15) * 4;
    const int srccol = GU ? ((lc < 32) ? (n0 / 2 + lc) : (512 + n0 / 2 + (lc - 32))) : (n0 + lc);
#pragma unroll 4
    for (int it = 0; it < 16; ++it) { const int kk = 4 * it + (lane >> 4);
        const f32x4 v = *(const f32x4*)(W + (size_t)(k0 + kk) * ld + srccol);
        scr[kk * 65 + lc + 0] = v[0]; scr[kk * 65 + lc + 1] = v[1]; scr[kk * 65 + lc + 2] = v[2]; scr[kk * 65 + lc + 3] = v[3]; }
    LDS_WAIT(); asm volatile("" ::: "memory");
    const int c = lane & 7;
#pragma unroll
    for (int j = 0; j < 8; ++j) { const int nn = 8 * j + (lane >> 3);
        const int cc = GU ? (((nn & 7) < 4) ? (4 * (nn >> 3) + (nn & 7)) : (32 + 4 * (nn >> 3) + ((nn & 7) - 4))) : nn;
        const LAS float* s = scr + (8 * c) * 65 + cc;
        u32x4 o; o.x = pk2h(s[0 * 65], s[1 * 65]); o.y = pk2h(s[2 * 65], s[3 * 65]); o.z = pk2h(s[4 * 65], s[5 * 65]); o.w = pk2h(s[6 * 65], s[7 * 65]);
        *(GAS u32x4*)(WT + (size_t)(n0 + nn) * K + k0 + 8 * c) = o; }
    LDS_WAIT(); asm volatile("" ::: "memory");
}

__device__ __forceinline__ float shfl_idx(float v, int src) { return __int_as_float(__builtin_amdgcn_ds_bpermute(src << 2, __float_as_int(v))); }
__device__ __forceinline__ float wave_sum(float v, int lane) {
#pragma unroll
    for (int o = 1; o < 64; o <<= 1) v += shfl_idx(v, lane ^ o);
    return v;
}
__device__ __forceinline__ void rope_cs(int pos, int m, float& c, float& s) {
    const float e = -(float)m * (13.287712379549449f / 127.0f);
    const float inv = exp2f(e);
    const float ang = (float)pos * inv;
    const float k = rintf(ang * 0.6366197723675814f);
    float r = fmaf(-k, 1.5703125f, ang); r = fmaf(-k, 4.837512969970703125e-4f, r); r = fmaf(-k, 7.54978995489188216e-8f, r);
    const float z = r * r;
    const float sp = fmaf(r * z, fmaf(z, fmaf(z, -1.9515295891e-4f, 8.3321608736e-3f), -1.6666654611e-1f), r);
    const float cp = fmaf(z * z, fmaf(z, fmaf(z, 2.443315711809948e-5f, -1.388731625493765e-3f), 4.166664568298827e-2f), fmaf(z, -0.5f, 1.0f));
    const int q = ((int)k) & 3;
    c = (q == 0) ? cp : (q == 1) ? -sp : (q == 2) ? -cp : sp;
    s = (q == 0) ? sp : (q == 1) ? cp : (q == 2) ? -sp : -cp;
}
#if defined(PROBE_A) && defined(PROBE_B)
#define PROBE_MARK(id) do { if ((id) == PROBE_A || (id) == PROBE_B) { if (blockIdx.x == 0 && threadIdx.x == 0) { \
    volatile LAS unsigned* pm_ = (volatile LAS unsigned*)(size_t)(MISC_OFF + 800); if ((id) == PROBE_A) pm_[0] = (unsigned)__builtin_amdgcn_s_memrealtime(); if ((id) == PROBE_B) pm_[1] = (unsigned)__builtin_amdgcn_s_memrealtime(); } } } while (0)
#else
#define PROBE_MARK(id) do {} while (0)
#endif
struct RowArgs {
    const float* src; float* h; h16* hn; float* rstd; const float* gnorm;
    const h16* y; const int* eidp; const int* rankp; const float* gatep;
    const h16* tabh; const float* bias0; const float* bias1; float* flog;
    int* eid; int* rank; float* gate; unsigned* counts; int* list;
};
template <bool COMBINE, bool STORE_H, int NT_>
__device__ __forceinline__ void row_pass(const RowArgs& A, int g, bool valid, int lane, int ch, int wave, LAS float* xch, LAS float* scr, LAS unsigned* blk, const volatile LAS unsigned* padstart) {
    const int r = lane & 15, kq = lane >> 4; const int t = 16 * g + r;
    constexpr int NA = NT_ > 0 ? NT_ : 1;
    f32x4 acc[NA];
#pragma unroll
    for (int i = 0; i < NA; ++i) acc[i] = (f32x4){0.f, 0.f, 0.f, 0.f};
    float ss = 0.f; float bia[NA];
#pragma unroll
    for (int i = 0; i < NA; ++i) bia[i] = 0.f;
    if (NT_ == 3) { if (wave == 0) blk[lane] = 0u; }
    if (NT_ == 3) PROBE_MARK(61);
    if (valid) {
        if (NT_ == 1) bia[0] = A.bias0[r];
        if (NT_ == 3) { bia[0] = A.bias1[r]; bia[1] = A.bias1[16 + r]; bia[2] = A.bias0[r & 3]; }
        const float* srow = A.src + (size_t)t * DM + 8 * kq + 512 * ch; float* hrow = A.h + (size_t)t * DM + 8 * kq + 512 * ch; h16* nrow = A.hn + (size_t)t * DM + 8 * kq + 512 * ch;
        const h16* y0 = nullptr; const h16* y1 = nullptr; float g0 = 0.f, g1 = 0.f;
        if (COMBINE) { const int e0 = A.eidp[2 * t], e1 = A.eidp[2 * t + 1]; const int p0 = (int)padstart[e0] + A.rankp[2 * t], p1 = (int)padstart[e1] + A.rankp[2 * t + 1];
            g0 = A.gatep[2 * t]; g1 = A.gatep[2 * t + 1]; y0 = A.y + (size_t)p0 * DM + 8 * kq + 512 * ch; y1 = A.y + (size_t)p1 * DM + 8 * kq + 512 * ch; }
        const float* gnp = A.gnorm + 8 * kq + 512 * ch;
        const h16* tabp = A.tabh + ((size_t)(16 * ch) * 64 + lane) * (8 * NA);
#pragma unroll 4
        for (int it = 0; it < 16; ++it) {
            f32x4 v0 = *(const f32x4*)(srow + 32 * it), v1 = *(const f32x4*)(srow + 32 * it + 4);
            if (COMBINE) { const f16x8 a = *(const f16x8*)(y0 + 32 * it), b = *(const f16x8*)(y1 + 32 * it);
#pragma unroll
                for (int q = 0; q < 4; ++q) { v0[q] += (float)a[q] * g0 + (float)b[q] * g1; v1[q] += (float)a[4 + q] * g0 + (float)b[4 + q] * g1; } }
            if (STORE_H) { *(f32x4*)(hrow + 32 * it) = v0; *(f32x4*)(hrow + 32 * it + 4) = v1; }
            ss += (v0[0] * v0[0] + v0[1] * v0[1]) + (v0[2] * v0[2] + v0[3] * v0[3]) + (v1[0] * v1[0] + v1[1] * v1[1]) + (v1[2] * v1[2] + v1[3] * v1[3]);
            const f32x4 gn0 = *(const f32x4*)(gnp + 32 * it), gn1 = *(const f32x4*)(gnp + 32 * it + 4);
            const f32x4 a0 = v0 * gn0, a1 = v1 * gn1;
            u32x4 w; w.x = pk2h(a0[0], a0[1]); w.y = pk2h(a0[2], a0[3]); w.z = pk2h(a1[0], a1[1]); w.w = pk2h(a1[2], a1[3]);
            *(u32x4*)(nrow + 32 * it) = w;
            if (NT_ > 0) {
                const h16* tp = tabp + (size_t)it * 64 * 8 * NA;
                const f16x8 af = __builtin_bit_cast(f16x8, w);
#pragma unroll
                for (int tl = 0; tl < NT_; ++tl) acc[tl] = __builtin_amdgcn_mfma_f32_16x16x32_f16(af, *(const f16x8*)(tp + 8 * tl), acc[tl], 0, 0, 0);
            }
        }
        ss += shfl_idx(ss, lane ^ 16); ss += shfl_idx(ss, lane ^ 32);
        if (NT_ == 3) PROBE_MARK(62);
        if (ch == 1) { xch[lane] = ss;
#pragma unroll
            for (int tl = 0; tl < NT_; ++tl)
#pragma unroll
                for (int q = 0; q < 4; ++q) xch[64 * (1 + 4 * tl + q) + lane] = acc[tl][q]; }
    }
    __syncthreads();
    if (NT_ == 3) PROBE_MARK(63);
    int e0 = 0, e1 = 0, lr0 = 0, lr1 = 0; float ga = 0.f, gb = 0.f;
    if (valid && ch == 0) {
        ss += xch[lane];
#pragma unroll
        for (int tl = 0; tl < NT_; ++tl)
#pragma unroll
            for (int q = 0; q < 4; ++q) acc[tl][q] += xch[64 * (1 + 4 * tl + q) + lane];
        const float rs = 1.0f / sqrtf(ss * (1.0f / DM) + EPS);
        if (kq == 0) A.rstd[t] = rs;
        if (NT_ > 0) {
            float rst[4];
#pragma unroll
            for (int q = 0; q < 4; ++q) rst[q] = shfl_idx(rs, 4 * kq + q);
            if (NT_ == 1) {
#pragma unroll
                for (int q = 0; q < 4; ++q) A.flog[(size_t)(16 * g + 4 * kq + q) * 16 + r] = acc[0][q] * rst[q] + bia[0];
            } else {
#pragma unroll
                for (int tl = 0; tl < NT_; ++tl)
#pragma unroll
                    for (int q = 0; q < 4; ++q) scr[(4 * kq + q) * 48 + 16 * tl + r] = acc[tl][q] * rst[q] + bia[tl];
                LDS_WAIT(); asm volatile("" ::: "memory");
                if (lane < 16) {
                    const LAS float* sr = scr + r * 48;
                    float gl[4];
#pragma unroll
                    for (int q = 0; q < 4; ++q) gl[q] = sr[32 + q];
                    int gi = 0; float gmax = gl[0];
#pragma unroll
                    for (int q = 1; q < 4; ++q) if (gl[q] > gmax) { gmax = gl[q]; gi = q; }
                    float gs = 0.f;
#pragma unroll
                    for (int q = 0; q < 4; ++q) gs += __expf(gl[q] - gmax);
                    const float pg = 1.0f / gs;
                    float el[8];
#pragma unroll
                    for (int e = 0; e < 8; ++e) el[e] = sr[gi * 8 + e];
                    int i0 = 0; float emax = el[0];
#pragma unroll
                    for (int e = 1; e < 8; ++e) if (el[e] > emax) { emax = el[e]; i0 = e; }
                    int i1 = -1; float b1 = -3.0e38f;
#pragma unroll
                    for (int e = 0; e < 8; ++e) if (e != i0 && el[e] > b1) { b1 = el[e]; i1 = e; }
                    const float p1 = __expf(b1 - emax);
                    ga = pg / (1.0f + p1); gb = pg * p1 / (1.0f + p1);
                    e0 = gi * 8 + i0; e1 = gi * 8 + i1;
                    lr0 = (int)__hip_atomic_fetch_add(blk + e0, 1u, __ATOMIC_RELAXED, __HIP_MEMORY_SCOPE_WORKGROUP);
                    lr1 = (int)__hip_atomic_fetch_add(blk + e1, 1u, __ATOMIC_RELAXED, __HIP_MEMORY_SCOPE_WORKGROUP);
                }
            }
        }
    }
    if (NT_ == 3) {
        __syncthreads();
        if (wave == 0 && lane < NE) { const unsigned c = blk[lane]; unsigned base = 0u; if (c) base = atomicAdd(A.counts + lane, c); blk[32 + lane] = base; }
        __syncthreads();
        if (valid && ch == 0 && lane < 16) {
            const int r0 = (int)blk[32 + e0] + lr0, r1 = (int)blk[32 + e1] + lr1;
            A.list[e0 * LISTCAP + r0] = 2 * t; A.list[e1 * LISTCAP + r1] = 2 * t + 1;
            A.eid[2 * t] = e0; A.eid[2 * t + 1] = e1; A.rank[2 * t] = r0; A.rank[2 * t + 1] = r1; A.gate[2 * t] = ga; A.gate[2 * t + 1] = gb;
        }
    }
    if (NT_ == 3) PROBE_MARK(64);
    __syncthreads();
    if (NT_ == 3) PROBE_MARK(65);
}
template <bool COMBINE, bool STORE_H, int NT_>
__device__ __forceinline__ void row_pass_all(const RowArgs& A, int vcu, int G, int wave, int lane, LAS unsigned char* lds, const volatile LAS unsigned* padstart) {
    const int pr = wave & 3, ch = wave >> 2;
    LAS float* xch = (LAS float*)(lds + pr * 4096); LAS float* scr = (LAS float*)(lds + 16384 + pr * 4096); LAS unsigned* blk = (LAS unsigned*)(lds + 32768);
    for (int base = 0; base < T / 16; base += 4 * G) { const int g = base + pr * G + vcu; row_pass<COMBINE, STORE_H, NT_>(A, g, g < T / 16, lane, ch, wave, xch, scr, blk, padstart); }
}
__device__ __forceinline__ void final_row(const float* h, const h16* y, const int* eidp, const int* rankp, const float* gatep, const volatile LAS unsigned* padstart, const float* gf, float* out, int t, int lane) {
    const int e0 = eidp[2 * t], e1 = eidp[2 * t + 1]; const int p0 = (int)padstart[e0] + rankp[2 * t], p1 = (int)padstart[e1] + rankp[2 * t + 1];
    const float g0 = gatep[2 * t], g1 = gatep[2 * t + 1];
    const f32x4* hr = (const f32x4*)(h + (size_t)t * DM) + lane; const f16x4* ya = (const f16x4*)(y + (size_t)p0 * DM) + lane; const f16x4* yb = (const f16x4*)(y + (size_t)p1 * DM) + lane;
    f32x4 v[4]; float s = 0.f;
#pragma unroll
    for (int j = 0; j < 4; ++j) { const f16x4 a = ya[64 * j], b = yb[64 * j]; v[j] = hr[64 * j];
#pragma unroll
        for (int q = 0; q < 4; ++q) v[j][q] += (float)a[q] * g0 + (float)b[q] * g1;
        s += (v[j][0] * v[j][0] + v[j][1] * v[j][1]) + (v[j][2] * v[j][2] + v[j][3] * v[j][3]); }
    const float rs = 1.0f / sqrtf(wave_sum(s, lane) * (1.0f / DM) + EPS);
    f32x4* o = (f32x4*)(out + (size_t)t * DM) + lane;
#pragma unroll
    for (int j = 0; j < 4; ++j) o[64 * j] = v[j] * rs * ((const f32x4*)gf)[lane + 64 * j];
}
__device__ __forceinline__ void ret_gn_item(const h16* ro, const h16* gate, const float* gain, h16* og, int w, int lane) {
    const int t = w >> 2, h = w & 3;
    const f16x8 ov = *(const f16x8*)(ro + (size_t)t * 2048 + h * 512 + lane * 8);
    const f16x8 gv = *(const f16x8*)(gate + (size_t)(h >> 1) * T * 1024 + (size_t)t * 1024 + (h & 1) * 512 + lane * 8);
    float v[8]; float s = 0.f;
#pragma unroll
    for (int j = 0; j < 8; ++j) { v[j] = (float)ov[j]; s += v[j]; }
    const float mu = wave_sum(s, lane) * (1.0f / RET_DV); float q = 0.f;
#pragma unroll
    for (int j = 0; j < 8; ++j) { v[j] -= mu; q += v[j] * v[j]; }
    const float rs = 1.0f / sqrtf(wave_sum(q, lane) * (1.0f / RET_DV) + EPS);
    const f32x4 ga = *(const f32x4*)(gain + h * 512 + lane * 8), gb = *(const f32x4*)(gain + h * 512 + lane * 8 + 4);
    float o[8];
#pragma unroll
    for (int j = 0; j < 8; ++j) { const float gg = (float)gv[j]; const float gn = (j < 4) ? ga[j & 3] : gb[j & 3];
        o[j] = v[j] * rs * gn * gg * __builtin_amdgcn_rcpf(1.0f + __builtin_amdgcn_exp2f(-gg * LOG2E)); }
    u32x4 wv; wv.x = pk2h(o[0], o[1]); wv.y = pk2h(o[2], o[3]); wv.z = pk2h(o[4], o[5]); wv.w = pk2h(o[6], o[7]);
    *(u32x4*)(og + (size_t)t * 2048 + h * 512 + lane * 8) = wv;
}

namespace ret_body {
constexpr int KLP = 528, VLP = 144, RLP = 528;
constexpr int OFF_KL = 0, OFF_VL = 128 * KLP, OFF_VD = OFF_VL + 128 * VLP, OFF_RL = OFF_VD + 128 * VLP, END = OFF_RL + 64 * RLP, OFF_OS = 0;
static_assert(END <= RING_BYTES, "retention LDS");
#define MF16(a, b, c) __builtin_amdgcn_mfma_f32_32x32x16_f16(a, b, c, 0, 0, 0)
__device__ __forceinline__ int crow(int r, int hi) { return (r & 3) + 8 * (r >> 2) + 4 * hi; }
typedef short v4i16_t __attribute__((ext_vector_type(4)));
__device__ __forceinline__ s16x4 vtr(LAS const char* p) { return __builtin_bit_cast(s16x4, __builtin_amdgcn_ds_read_tr16_b64_v4i16((LAS v4i16_t*)p)); }
__device__ __forceinline__ f16x8 mk8(s16x4 lo, s16x4 hi) { typedef short s16x8 __attribute__((ext_vector_type(8))); s16x8 t = {lo[0], lo[1], lo[2], lo[3], hi[0], hi[1], hi[2], hi[3]}; return __builtin_bit_cast(f16x8, t); }
__device__ __forceinline__ f16x8 pack8(const f32x16& S, int b) { u32x4 w; w.x = pk2h(S[b], S[b + 1]); w.y = pk2h(S[b + 2], S[b + 3]); w.z = pk2h(S[b + 4], S[b + 5]); w.w = pk2h(S[b + 6], S[b + 7]); return __builtin_bit_cast(f16x8, w); }
__device__ __forceinline__ void ret_item(int b, int h, int sl, const h16* __restrict__ Qr, const h16* __restrict__ Kr, const h16* __restrict__ Vb, h16* __restrict__ O, LAS unsigned char* lds, const int tid_arg) {
    const int tid_in = tid_arg;
    const float lg2 = log2f(1.0f - exp2f(-5.0f - (float)h));
    const float cd = exp2f(128.0f * lg2);
    f32x16 R0 = {}, R1 = {};
    for (int n = 0; n < SEQ / 128; ++n) {
        int tid = tid_in; asm volatile("" : "+v"(tid));
        const int lane = tid & 63, r32 = lane & 31, hi = lane >> 5; const int wid = __builtin_amdgcn_readfirstlane(tid >> 6);
        const int wi = wid & 3, wj = wid >> 2;
        const bool act_s = !(wj == 1 && wi < 2);
        const int trq = (lane & 15) >> 2, trp = lane & 3, trg = (lane >> 4) & 1;
        const size_t t0 = (size_t)b * SEQ + (size_t)n * 128;
#pragma unroll
        for (int i = 0; i < 8; ++i) { const int p = tid + 512 * i, j = p >> 5, c16 = p & 31;
            const u32x4 v = *(const u32x4*)(Kr + (t0 + j) * 1024 + h * 256 + c16 * 8);
            *(LAS u32x4*)(lds + OFF_KL + j * KLP + c16 * 16) = v; }
#pragma unroll
        for (int i = 0; i < 2; ++i) { const int p = tid + 512 * i, j = p >> 3, c16 = p & 7;
            const f16x8 v = *(const f16x8*)(Vb + (t0 + j) * 1024 + c16 * 8);
            *(LAS f16x8*)(lds + OFF_VL + j * VLP + c16 * 16) = v;
            const float kd = exp2f(lg2 * (float)(127 - j));
            u32x4 w; w.x = pk2h((float)v[0] * kd, (float)v[1] * kd); w.y = pk2h((float)v[2] * kd, (float)v[3] * kd); w.z = pk2h((float)v[4] * kd, (float)v[5] * kd); w.w = pk2h((float)v[6] * kd, (float)v[7] * kd);
            *(LAS u32x4*)(lds + OFF_VD + j * VLP + c16 * 16) = w; }
        const h16* qp = Qr + (t0 + 32 * wi + r32) * 1024 + h * 256 + 8 * hi;
        f16x8 qf[8];
#pragma unroll
        for (int s = 0; s < 8; ++s) qf[s] = *(const f16x8*)(qp + 16 * (8 * (1 - wj) + s));
        __syncthreads();
        f16x8 sf[2][2];
        {
            f32x16 S0 = {}, S1 = {};
            const LAS unsigned char* kp = lds + OFF_KL + (64 * wj + r32) * KLP + 16 * hi + 256 * (1 - wj);
            if (act_s) {
#pragma unroll
                for (int s = 0; s < 8; ++s) { const f16x8 a0 = *(const LAS f16x8*)(kp + 32 * s), a1 = *(const LAS f16x8*)(kp + 32 * KLP + 32 * s);
                    S0 = MF16(a0, qf[s], S0); S1 = MF16(a1, qf[s], S1); if ((s & 3) == 3) __builtin_amdgcn_sched_barrier(0); }
            }
#pragma unroll
            for (int s = 0; s < 8; ++s) qf[s] = *(const f16x8*)(qp + 16 * (8 * wj + s));
            if (act_s) {
                const LAS unsigned char* kp2 = lds + OFF_KL + (64 * wj + r32) * KLP + 16 * hi + 256 * wj;
#pragma unroll
                for (int s = 0; s < 8; ++s) { const f16x8 a0 = *(const LAS f16x8*)(kp2 + 32 * s), a1 = *(const LAS f16x8*)(kp2 + 32 * KLP + 32 * s);
                    S0 = MF16(a0, qf[s], S0); S1 = MF16(a1, qf[s], S1); if ((s & 3) == 3) __builtin_amdgcn_sched_barrier(0); }
                const int ig = 32 * wi + r32;
#pragma unroll
                for (int r = 0; r < 16; ++r) { const int j0 = 64 * wj + crow(r, hi), j1 = j0 + 32;
                    S0[r] = (ig >= j0) ? S0[r] * exp2f(lg2 * (float)(ig - j0)) : 0.f;
                    S1[r] = (ig >= j1) ? S1[r] * exp2f(lg2 * (float)(ig - j1)) : 0.f; }
            }
            sf[0][0] = pack8(S0, 0); sf[0][1] = pack8(S0, 8); sf[1][0] = pack8(S1, 0); sf[1][1] = pack8(S1, 8);
        }
        __builtin_amdgcn_sched_barrier(0);
        f32x16 OT0 = {}, OT1 = {};
        if (n > 0) {
            const LAS unsigned char* rp = lds + OFF_RL + r32 * RLP + 16 * hi + 256 * wj;
#pragma unroll
            for (int s = 0; s < 8; ++s) {
                const f16x8 a0 = *(const LAS f16x8*)(rp + 32 * s), a1 = *(const LAS f16x8*)(rp + 32 * RLP + 32 * s);
                OT0 = MF16(a0, qf[s], OT0); OT1 = MF16(a1, qf[s], OT1); if ((s & 3) == 3) __builtin_amdgcn_sched_barrier(0); }
            const float qd = exp2f(lg2 * (float)(32 * wi + r32 + 1));
#pragma unroll
            for (int r = 0; r < 16; ++r) { OT0[r] *= qd; OT1[r] *= qd; }
        }
        __builtin_amdgcn_sched_barrier(0);
        if (act_s) {
#pragma unroll
            for (int jt = 0; jt < 2; ++jt)
#pragma unroll
                for (int s2 = 0; s2 < 2; ++s2) {
                    const int jb = 64 * wj + 32 * jt + 16 * s2 + 4 * hi + trq;
                    const LAS char* vp = (const LAS char*)(lds + OFF_VL + jb * VLP + (16 * trg + 4 * trp) * 2);
                    const f16x8 v0 = mk8(vtr(vp), vtr(vp + 8 * VLP)), v1 = mk8(vtr(vp + 64), vtr(vp + 64 + 8 * VLP));
                    OT0 = MF16(v0, sf[jt][s2], OT0); OT1 = MF16(v1, sf[jt][s2], OT1); }
        }
        __builtin_amdgcn_sched_barrier(0);
#pragma unroll
        for (int r = 0; r < 16; ++r) { R0[r] *= cd; R1[r] *= cd; }
#pragma unroll
        for (int s = 0; s < 8; ++s) {
            const int jb = 16 * s + 8 * hi + trq;
            const LAS char* kp = (const LAS char*)(lds + OFF_KL + jb * KLP + (32 * wid + 16 * trg + 4 * trp) * 2);
            const LAS char* vp = (const LAS char*)(lds + OFF_VD + jb * VLP + (16 * trg + 4 * trp) * 2);
            const f16x8 ka = mk8(vtr(kp), vtr(kp + 4 * KLP));
            const f16x8 v0 = mk8(vtr(vp), vtr(vp + 4 * VLP)), v1 = mk8(vtr(vp + 64), vtr(vp + 64 + 4 * VLP));
            R0 = MF16(ka, v0, R0); R1 = MF16(ka, v1, R1); if ((s & 1) == 1) __builtin_amdgcn_sched_barrier(0); }
        __syncthreads();
        {
#pragma unroll
            for (int g4 = 0; g4 < 4; ++g4) {
                u32x2 w; w.x = pk2h(R0[4 * g4], R0[4 * g4 + 1]); w.y = pk2h(R0[4 * g4 + 2], R0[4 * g4 + 3]);
                *(LAS u32x2*)(lds + OFF_RL + r32 * RLP + (32 * wid + 8 * g4 + 4 * hi) * 2) = w;
                w.x = pk2h(R1[4 * g4], R1[4 * g4 + 1]); w.y = pk2h(R1[4 * g4 + 2], R1[4 * g4 + 3]);
                *(LAS u32x2*)(lds + OFF_RL + (32 + r32) * RLP + (32 * wid + 8 * g4 + 4 * hi) * 2) = w; }
            LAS float* os = (LAS float*)(lds + OFF_OS) + wid * 1024 + lane;
#pragma unroll
            for (int r = 0; r < 16; ++r) os[64 * r] = wj ? OT0[r] : OT1[r];
        }
        __syncthreads();
        {
            const LAS float* os = (const LAS float*)(lds + OFF_OS) + (wid ^ 4) * 1024 + lane;
            h16* op = O + (t0 + 32 * wi + r32) * 2048 + h * 512 + sl * 64 + 32 * wj + 4 * hi;
#pragma unroll
            for (int g4 = 0; g4 < 4; ++g4) { float f[4];
#pragma unroll
                for (int q = 0; q < 4; ++q) f[q] = (wj ? OT1[4 * g4 + q] : OT0[4 * g4 + q]) + os[64 * (4 * g4 + q)];
                u32x2 w; w.x = pk2h(f[0], f[1]); w.y = pk2h(f[2], f[3]); *(u32x2*)(op + 8 * g4) = w; }
        }
        __syncthreads();
    }
}
#undef MF16
}

template <bool GATHER_> struct MoeOrderT {
    static constexpr bool GATHER = GATHER_;
    const volatile LAS unsigned* cnt; const volatile LAS unsigned* tstart; int G, c, K; const char* A; const char* Bt; size_t bstride; const int* list;
    __device__ bool next(int i, pg8::Unit& u) const {
        const int NTt = __builtin_amdgcn_readfirstlane((int)tstart[NE]); const long L = (long)i * G + c; if (L >= (long)NTt * 4) return false;
        const int mtg = (int)(L >> 2); int e = 0;
        while (e < NE - 1 && mtg >= __builtin_amdgcn_readfirstlane((int)tstart[e + 1])) ++e;
        u.pm = mtg; u.pn = (int)(L & 3); u.e = e; u.mt = mtg - __builtin_amdgcn_readfirstlane((int)tstart[e]); return true;
    }
    __device__ __forceinline__ const char* abase() const { return A; }
    __device__ __forceinline__ void aoff(const pg8::Unit& u, const int (&R)[2], const int (&C)[2], unsigned (&ao)[2][2]) const {
        const int cn = (int)cnt[u.e];
#pragma unroll
        for (int h = 0; h < 2; ++h)
#pragma unroll
            for (int i = 0; i < 2; ++i) { const int rank = u.mt * 256 + h * 128 + R[i]; int row = T; if (rank < cn) row = list[u.e * LISTCAP + rank] >> 1;
                ao[h][i] = (unsigned)(((size_t)row * K + C[i]) * 2); }
    }
    __device__ __forceinline__ const char* bbase(const pg8::Unit& u) const { return Bt + (size_t)u.e * bstride + (size_t)u.pn * 256 * K * 2; }
};
__device__ __forceinline__ void moe_setup(volatile LAS unsigned* MISC, const unsigned* counts, const int tid) {
    __syncthreads();
    if (tid < NE) MISC[16 + tid] = __hip_atomic_load(counts + tid, RLX_AGENT);
    __syncthreads();
    if (tid == 0) { unsigned a = 0; for (int e = 0; e < NE; ++e) { MISC[48 + e] = a; MISC[96 + e] = a * 256u; a += (MISC[16 + e] + 255u) >> 8; } MISC[48 + NE] = a; }
    __syncthreads();
}

__global__ void __launch_bounds__(NWAVES * 64, 2) mk_fwd(Args args) {
    extern __shared__ __attribute__((aligned(16))) unsigned char lds_raw[];
    LAS unsigned char* lds = (LAS unsigned char*)lds_raw;
    volatile LAS unsigned* MISC = (volatile LAS unsigned*)(lds + MISC_OFF);
    const int G = gridDim.x; const int bx = blockIdx.x; const int vcu = (G % 8 == 0) ? (bx % 8) * (G / 8) + bx / 8 : bx;
    { gu32* ctl0 = (gu32*)(args.ws + WS_CTL);
      for (int u = threadIdx.x; u < (LDS_BYTES - LDSCTL_OFF) / 4; u += NWAVES * 64) ((LAS unsigned*)(lds + LDSCTL_OFF))[u] = 0u;
      __syncthreads();
      (void)ctl0; }
    XcdBarrier bar; bar.bar = (unsigned*)((gu32*)(args.ws + WS_CTL) + CW_BAR) + args.li * XCD_BAR_WORDS; bar.x = 0; bar.st = nullptr;
    const bool use_bar = (args.ph_hi - args.ph_lo) > 1;
    if (use_bar) bar = xcd_barrier_post((unsigned*)((gu32*)(args.ws + WS_CTL) + CW_BAR) + args.li * XCD_BAR_WORDS, MISC + 8);
#ifndef PROBE_DUP
#define PROBE_DUP -1
#endif
#ifdef PROBE_T
#ifndef PROBE_AMP
#define PROBE_AMP 8
#endif
    unsigned long long probe_t0 = __builtin_amdgcn_s_memrealtime(), probe_t1 = probe_t0;
#endif
    for (int pi = args.ph_lo; pi < args.ph_hi; ++pi) {
        const int ph = (PROBE_DUP >= 0 && pi > PROBE_DUP) ? pi - 1 : pi;
        bool did = true; const bool dummy = (PROBE_DUP >= 0 && pi == PROBE_DUP + 1);
        int tid = threadIdx.x; asm volatile("" : "+v"(tid));
        size_t zoff = 0; asm volatile("" : "+s"(zoff));
        unsigned char* ws = args.ws + zoff;
        const int lane = tid & 63, wave = __builtin_amdgcn_readfirstlane(tid >> 6);
        gu32* ctl = (gu32*)(ws + WS_CTL);
        const float* x = args.in[0]; const float* fox_w_in = args.in[1]; const float* fox_b_f = args.in[2]; const float* fox_w_out = args.in[3];
        const float* ret_w_in = args.in[4]; const float* ret_gn = args.in[5]; const float* ret_w_out = args.in[6];
        const float* norm_mix = args.in[7]; const float* norm_ffn = args.in[8];
        const float* rg_w = args.in[9]; const float* rg_b = args.in[10]; const float* re_w = args.in[11]; const float* re_b = args.in[12];
        const float* w_gu = args.in[13]; const float* w_down = args.in[14]; const float* norm_final = args.in[15];
        h16* WfoxT = (h16*)(ws + WS_WFOX); h16* WfoT = (h16*)(ws + WS_WFO); h16* WretT = (h16*)(ws + WS_WRET); h16* WroT = (h16*)(ws + WS_WRO); h16* WguT = (h16*)(ws + WS_WGU); h16* WdT = (h16*)(ws + WS_WD);
        h16* RW = (h16*)(ws + WS_RW); h16* FW = (h16*)(ws + WS_FW); float* ctab = (float*)(ws + WS_ROPE); float* stab = ctab + SEQ * 128;
        float* H = (float*)(ws + WS_H); h16* HN = (h16*)(ws + WS_HN); float* RSTD = (float*)(ws + WS_RSTD); float* FLOG = (float*)(ws + WS_FLOG); float* CUM = (float*)(ws + WS_CUM);
        int* EID = (int*)(ws + WS_EID); int* RANK = (int*)(ws + WS_RANK); float* GATE = (float*)(ws + WS_GATE); int* LIST = (int*)(ws + WS_LIST);
        h16* QKVG = (h16*)(ws + WS_QKVG); h16* OG = (h16*)(ws + WS_OG); h16* RO = (h16*)(ws + WS_RO); h16* Y = (h16*)(ws + WS_Y); h16* ACT = (h16*)(ws + WS_ACT);
        unsigned* COUNTS = (unsigned*)(ctl + CW_CNT);
        const int gw = vcu * NWAVES + wave, NGW = G * NWAVES;

        if (ph == 0) {
            LAS float* scr = (LAS float*)(lds + wave * 16640);
            constexpr int I_FOX = 2 * 16 * 64, I_FO = 2 * 16 * 16, I_RET = 2 * 16 * 96, I_RO = 2 * 32 * 16, I_GU = DEPTH * NE * 16 * 16, I_D = DEPTH * NE * 8 * 16;
            constexpr int NITEMS = I_FOX + I_FO + I_RET + I_RO + I_GU + I_D;
            for (int it = gw; it < NITEMS; it += NGW) {
                int r = it;
                if (r < I_FOX) { const int j = r / (16 * 64), q = r % (16 * 64); transpose_item<false>(fox_w_in + (size_t)j * DM * FOX_IN, DM, FOX_IN, WfoxT + (size_t)j * 4096 * 1024, scr, q / 64, q % 64, lane); continue; } r -= I_FOX;
                if (r < I_FO) { const int j = r / 256, q = r % 256; transpose_item<false>(fox_w_out + (size_t)j * DM * DM, DM, DM, WfoT + (size_t)j * 1024 * 1024, scr, q / 16, q % 16, lane); continue; } r -= I_FO;
                if (r < I_RET) { const int j = r / (16 * 96), q = r % (16 * 96); transpose_item<false>(ret_w_in + (size_t)j * DM * RET_IN, DM, RET_IN, WretT + (size_t)j * 6144 * 1024, scr, q / 96, q % 96, lane); continue; } r -= I_RET;
                if (r < I_RO) { const int j = r / 512, q = r % 512; transpose_item<false>(ret_w_out + (size_t)j * 2048 * DM, 2048, DM, WroT + (size_t)j * 1024 * 2048, scr, q / 16, q % 16, lane); continue; } r -= I_RO;
                if (r < I_GU) { const int m = r / 256, q = r % 256; transpose_item<true>(w_gu + (size_t)m * DM * 1024, DM, 1024, WguT + (size_t)m * 1024 * 1024, scr, q / 16, q % 16, lane); continue; } r -= I_GU;
                { const int m = r / 128, q = r % 128; transpose_item<false>(w_down + (size_t)m * EFF * DM, EFF, DM, WdT + (size_t)m * 1024 * 512, scr, q / 16, q % 16, lane); }
            }
            const int gt = vcu * NWAVES * 64 + tid, NGT = G * NWAVES * 64;
            for (int idx = gt; idx < DEPTH * 32 * 64 * 24; idx += NGT) { const int v = idx % 24, ln = (idx / 24) % 64, it = (idx / (24 * 64)) % 32, L = idx / (24 * 64 * 32);
                const int tl = v >> 3, i = v & 7, k = 32 * it + 8 * (ln >> 4) + i, c = ln & 15;
                float val = 0.f; if (tl < 2) val = re_w[((size_t)L * DM + k) * NE + 16 * tl + c]; else if (c < 4) val = rg_w[((size_t)L * DM + k) * NG + c];
                RW[idx] = (h16)val; }
            for (int idx = gt; idx < 2 * 32 * 64 * 8; idx += NGT) { const int i = idx % 8, ln = (idx / 8) % 64, it = (idx / 512) % 32, j = idx / (512 * 32);
                const int k = 32 * it + 8 * (ln >> 4) + i, c = ln & 15; FW[idx] = (h16)fox_w_in[((size_t)j * DM + k) * FOX_IN + 4096 + c]; }
            for (int idx = gt; idx < SEQ * 128; idx += NGT) { const int pos = idx / 128, m = idx % 128;
                float c_, s_; rope_cs(pos, m, c_, s_); ctab[idx] = c_; stab[idx] = s_; }
            for (int idx = gt; idx < DM / 2; idx += NGT) ((unsigned*)(HN + (size_t)T * DM))[idx] = 0u;
        } else if (ph == 1) {
            { RowArgs A{}; A.src = x; A.h = H; A.hn = HN; A.rstd = RSTD; A.gnorm = norm_mix; A.tabh = FW; A.bias0 = fox_b_f; A.flog = FLOG;
                row_pass_all<false, true, 1>(A, vcu, G, wave, lane, lds, nullptr); }
        } else {
            const int L = (ph - 2) >> 3, sub = (ph - 2) & 7, j = L >> 1; const bool fox = (L & 1) == 0;
            if (sub == 0) {
                if (fox) {
                    if (vcu < BATCH * FOX_H) {
                        const int bh = vcu, b = bh / FOX_H, hh = bh % FOX_H; float v[4]; float run = 0.f;
#pragma unroll
                        for (int i = 0; i < 4; ++i) { const float f = FLOG[((size_t)b * SEQ + 4 * tid + i) * 16 + hh]; run += fminf(f, 0.f) - log1pf(__expf(-fabsf(f))); v[i] = run; }
                        float incl = run;
#pragma unroll
                        for (int o = 1; o < 64; o <<= 1) { const float u = shfl_idx(incl, lane >= o ? lane - o : lane); if (lane >= o) incl += u; }
                        LAS float* wt = (LAS float*)lds;
                        if (lane == 63) wt[wave] = incl;
                        __syncthreads();
                        float base = incl - run;
                        for (int w = 0; w < wave; ++w) base += wt[w];
                        f32x4 o4 = {v[0] + base, v[1] + base, v[2] + base, v[3] + base};
                        *(f32x4*)(CUM + (size_t)bh * SEQ + 4 * tid) = o4;
                        __syncthreads();
                    }
                    pg8::StaticOrder S; S.init(HN, WfoxT + (size_t)j * 4096 * 1024, T, 4096, DM, G, bx);
                    pg8::EpiH16 E{QKVG, 1024, 1024, (size_t)T * 1024, RSTD, attn_body::C2, 1.f, 0, nullptr, nullptr};
                    pg8::gemm_phase<pg8::EpiH16, pg8::StaticOrder, true>(lds, DM, S, E, tid);
                } else {
                    pg8::StaticOrder S; S.init(HN, WretT + (size_t)j * 6144 * 1024, T, 6144, DM, G, bx);
                    pg8::EpiH16 E{QKVG, 1024, 1024, (size_t)T * 1024, RSTD, 1.f, 0.0625f, 1, ctab, stab};
                    pg8::gemm_phase<pg8::EpiH16, pg8::StaticOrder, true>(lds, DM, S, E, tid);
                }
            } else if (sub == 1) {
                if (fox) {
                    const h16* Q = QKVG; const h16* K = QKVG + (size_t)T * 1024; const h16* V = QKVG + (size_t)2 * T * 1024; const h16* Gt = QKVG + (size_t)3 * T * 1024;
                    for (int bh = vcu >> 1; bh < BATCH * FOX_H; bh += (G >> 1)) {
                        const int s = vcu & 1;
#pragma unroll 1
                        for (int i = 0; i < 4; ++i) { const int qb = (i == 0) ? s : (i == 1) ? 7 - s : (i == 2) ? 3 - s : 4 + s;
                            int tu = tid; asm volatile("" : "+v"(tu));
                            attn_body::attn_unit<8>(bh / FOX_H, bh % FOX_H, qb, Q, K, V, Gt, CUM, OG, (char*)lds_raw, tu); }
                    }
                } else {
                    for (int item = vcu; item < BATCH * RET_H * 8; item += G) { const int bh = item >> 3, sl = item & 7, b = bh >> 2, hh = bh & 3;
                        const h16* Vb = QKVG + (size_t)(2 + (hh >> 1)) * T * 1024 + (hh & 1) * 512 + sl * 64;
                        ret_body::ret_item(b, hh, sl, QKVG, QKVG + (size_t)T * 1024, Vb, RO, lds, tid); }
                }
            } else if (sub == 2) {
                if (fox) did = false;
                else { for (int w = gw; w < T * RET_H; w += NGW) ret_gn_item(RO, QKVG + (size_t)4 * T * 1024, ret_gn + (size_t)j * 2048, OG, w, lane); }
            } else if (sub == 3) {
                const int Kd = fox ? 1024 : 2048;
                pg8::StaticOrder S; S.init(OG, fox ? (const void*)(WfoT + (size_t)j * 1024 * 1024) : (const void*)(WroT + (size_t)j * 1024 * 2048), T, DM, Kd, G, bx);
                pg8::EpiResid E{dummy ? (float*)(ws + WS_DUMMY) : H, DM};
                pg8::gemm_phase<pg8::EpiResid, pg8::StaticOrder, false>(lds, Kd, S, E, tid);
            } else if (sub == 4) {
                { RowArgs A{}; A.src = H; A.h = H; A.hn = HN; A.rstd = RSTD; A.gnorm = norm_ffn + (size_t)L * DM; A.tabh = RW + (size_t)L * 32 * 64 * 24; A.bias0 = rg_b + L * NG; A.bias1 = re_b + L * NE;
                    A.eid = EID; A.rank = RANK; A.gate = GATE; A.counts = COUNTS + L * NE; A.list = LIST;
                    if (dummy) { unsigned char* dz = ws + WS_DUMMY; A.hn = (h16*)(dz + 64 * MiB); A.rstd = (float*)(dz + 100 * MiB); A.eid = (int*)(dz + 101 * MiB); A.rank = (int*)(dz + 102 * MiB); A.gate = (float*)(dz + 103 * MiB); A.list = (int*)(dz + 104 * MiB); A.counts = (unsigned*)(ctl + CW_CNT2); }
                    row_pass_all<false, false, 3>(A, vcu, G, wave, lane, lds, nullptr); }
            } else if (sub == 5) {
                moe_setup(MISC, COUNTS + L * NE, tid);
                MoeOrderT<true> S{MISC + 16, MISC + 48, G, vcu, DM, (const char*)HN, (const char*)(WguT + (size_t)L * NE * 1024 * 1024), SZ_WGU, LIST};
                pg8::EpiSwiGLU E{ACT, RSTD, LIST, (const int*)(COUNTS + L * NE)};
                pg8::gemm_phase<pg8::EpiSwiGLU, MoeOrderT<true>, true>(lds, DM, S, E, tid);
            } else if (sub == 6) {
                moe_setup(MISC, COUNTS + L * NE, tid);
                MoeOrderT<false> S{MISC + 16, MISC + 48, G, vcu, EFF, (const char*)ACT, (const char*)(WdT + (size_t)L * NE * 1024 * 512), SZ_WD, LIST};
                pg8::EpiStoreH16 E{Y, DM};
                pg8::gemm_phase<pg8::EpiStoreH16, MoeOrderT<false>, true>(lds, EFF, S, E, tid);
            } else {
                moe_setup(MISC, COUNTS + L * NE, tid);
                if (L == DEPTH - 1) {
                    for (int t = gw; t < T; t += NGW) final_row(H, Y, EID, RANK, GATE, MISC + 96, norm_final, dummy ? (float*)(ws + WS_DUMMY) : args.out, t, lane);
                } else {
                    const bool nfox = ((L + 1) & 1) == 0;
                    RowArgs A{}; A.src = H; A.h = H; A.hn = HN; A.rstd = RSTD; A.gnorm = norm_mix + (size_t)(L + 1) * DM; A.y = Y; A.eidp = EID; A.rankp = RANK; A.gatep = GATE;
                    if (dummy) { unsigned char* dz = ws + WS_DUMMY; A.h = (float*)dz; A.hn = (h16*)(dz + 64 * MiB); A.rstd = (float*)(dz + 100 * MiB); }
                    if (nfox) { A.tabh = FW + (size_t)((L + 1) >> 1) * 32 * 64 * 8; A.bias0 = fox_b_f + ((L + 1) >> 1) * FOX_H; A.flog = dummy ? (float*)(ws + WS_DUMMY + 106 * MiB) : FLOG;
                        row_pass_all<true, true, 1>(A, vcu, G, wave, lane, lds, MISC + 96); }
                    else { row_pass_all<true, true, 0>(A, vcu, G, wave, lane, lds, MISC + 96); }
                }
            }
        }
        if (did && pi + 1 < args.ph_hi) xcd_barrier(bar);
#ifdef PROBE_T
        if (ph == PROBE_T - 1 || (PROBE_T == 0 && pi == args.ph_lo)) { if (PROBE_T == 0) {} else probe_t0 = __builtin_amdgcn_s_memrealtime(); }
        if (ph == PROBE_T) probe_t1 = __builtin_amdgcn_s_memrealtime();
#endif
    }
#if defined(PROBE_A) && defined(PROBE_B)
    if (blockIdx.x == 0 && threadIdx.x == 0) { volatile LAS unsigned* pm_ = (volatile LAS unsigned*)(size_t)(MISC_OFF + 800); const unsigned long long d = (unsigned long long)(pm_[1] - pm_[0]) * 8ull; const unsigned long long s0 = __builtin_amdgcn_s_memrealtime();
        while (__builtin_amdgcn_s_memrealtime() - s0 < d) __builtin_amdgcn_s_sleep(8); }
#endif
#ifdef PROBE_T
    if (blockIdx.x == 0 && threadIdx.x == 0) { const unsigned long long d = (probe_t1 - probe_t0) * PROBE_AMP; const unsigned long long s0 = __builtin_amdgcn_s_memrealtime();
        while (__builtin_amdgcn_s_memrealtime() - s0 < d) __builtin_amdgcn_s_sleep(8); }
#endif
}

extern "C" void kernel_launch(void* const* d_in, const int* in_sizes, int n_in, void* d_out, int out_size, void* d_ws, size_t ws_size, hipStream_t stream) {
    static int grid = 0;
    if (grid == 0) {
        if (n_in != 16 || out_size != T * DM || ws_size < WS_END) { fprintf(stderr, "kernel_launch: unexpected problem (n_in %d out %d ws %zu need %zu)\n", n_in, out_size, ws_size, (size_t)WS_END); grid = -1; return; }
        int dev = 0, cus = 0;
        if (hipGetDevice(&dev) != hipSuccess || hipDeviceGetAttribute(&cus, hipDeviceAttributeMultiprocessorCount, dev) != hipSuccess) { grid = -1; return; }
        if (hipFuncSetAttribute((const void*)mk_fwd, hipFuncAttributeMaxDynamicSharedMemorySize, LDS_BYTES) != hipSuccess) { fprintf(stderr, "kernel_launch: hipFuncSetAttribute failed\n"); grid = -1; return; }
        (void)hipGetLastError();
        grid = cus;
    }
    if (grid < 0) return;
    if (hipMemsetAsync((char*)d_ws + WS_CTL, 0, CTL_ZERO_BYTES, stream) != hipSuccess) return;
    Args a{};
    for (int i = 0; i < 16; ++i) a.in[i] = (const float*)d_in[i];
    a.out = (float*)d_out; a.ws = (unsigned char*)d_ws;
#if MK_N_LAUNCHES == 1
    a.ph_lo = 0; a.ph_hi = NPHASE + (PROBE_DUP >= 0 ? 1 : 0); a.li = 0;
    hipLaunchKernelGGL(mk_fwd, dim3(grid), dim3(NWAVES * 64), LDS_BYTES, stream, a);
#else
    for (int p = 0; p < NPHASE; ++p) {
        if (p >= 2 && ((p - 2) & 7) == 2 && (((p - 2) >> 3) & 1) == 0) continue;
        a.ph_lo = p; a.ph_hi = p + 1; a.li = 0;
        hipLaunchKernelGGL(mk_fwd, dim3(grid), dim3(NWAVES * 64), LDS_BYTES, stream, a);
    }
#endif
}
```

```cpp
#include <hip/hip_runtime.h>
#include <cstdio>
#include <cstdint>
#include <cmath>
#define LAS __attribute__((address_space(3)))
#define GAS __attribute__((address_space(1)))
typedef _Float16 h16;
typedef _Float16 f16x8 __attribute__((ext_vector_type(8)));
typedef _Float16 f16x4 __attribute__((ext_vector_type(4)));
typedef _Float16 f16x2 __attribute__((ext_vector_type(2)));
typedef float f32x2 __attribute__((ext_vector_type(2)));
typedef float f32x4 __attribute__((ext_vector_type(4)));
typedef float f32x16 __attribute__((ext_vector_type(16)));
typedef unsigned u32x2 __attribute__((ext_vector_type(2)));
typedef unsigned u32x4 __attribute__((ext_vector_type(4)));
typedef short s16x4 __attribute__((ext_vector_type(4)));
__device__ __forceinline__ unsigned pk2h(float lo, float hi) { f32x2 v = {lo, hi}; f16x2 b = __builtin_convertvector(v, f16x2); return __builtin_bit_cast(unsigned, b); }

constexpr int DM = 1024, BATCH = 8, SEQ = 2048, DEPTH = 4, T = BATCH * SEQ;
constexpr int FOX_H = 16, FOX_D = 64, FOX_IN = 4 * DM + FOX_H;
constexpr int RET_H = 4, RET_DK = 256, RET_DV = 512, RET_IN = 6144;
constexpr int NG = 4, EPG = 8, NE = 32, EFF = 512;
constexpr int PAIRS = T * 2;
constexpr int LISTCAP = 16384;
constexpr int PROWS = PAIRS + NE * 256;
constexpr float EPS = 1e-6f;
constexpr float LOG2E = 1.4426950408889634f;

namespace pg8 {
constexpr int BM = 256, BK = 64, HALF = 128, HTB = HALF * BK * 2, STAGE_BYTES = 8 * HTB, NXCD = 8, WGM = 8;
__host__ __device__ __forceinline__ int lds_byte(int r, int c) { const int st = (r >> 4) * 2 + (c >> 5), rr = r & 15, cc = c & 31, ob = rr * 64 + cc * 2; return st * 1024 + (ob ^ (((ob >> 9) & 1) << 5)); }
__host__ __device__ __forceinline__ void stage_rc(int b, int& R, int& C) { const int st = b / 1024, sb = b % 1024, swz = sb ^ (((sb >> 9) & 1) << 5); R = (st >> 1) * 16 + swz / 64; C = (st & 1) * 32 + (swz % 64) / 2; }
__host__ __device__ __forceinline__ int perm32(int rho) { const int n = rho >> 4, i = rho & 15; return 8 * (i >> 2) + 4 * n + (i & 3); }

struct Unit { int pm, pn, e, mt; };

struct StaticOrder {
    static constexpr bool GATHER = false;
    int nM, nN, nwg, G, c, K; const char* A; const char* Bt;
    __device__ void init(const void* A_, const void* Bt_, int M, int N, int K_, int G_, int c_) { A = (const char*)A_; Bt = (const char*)Bt_; K = K_; nM = M / BM; nN = N / BM; nwg = nM * nN; G = G_; c = c_; }
    __device__ bool next(int i, Unit& u) const {
        const long L = (long)i * G + c; if (L >= nwg) return false;
        int wgid = (int)L; { const int q = nwg / NXCD, r = nwg % NXCD, xcd = wgid % NXCD, off = wgid / NXCD; wgid = (xcd < r ? xcd * (q + 1) : r * (q + 1) + (xcd - r) * q) + off; }
        const int nig = WGM * nN, gid = wgid / nig, fm = gid * WGM, gsz = (nM - fm) < WGM ? (nM - fm) : WGM;
        u.pm = fm + ((wgid % nig) % gsz); u.pn = (wgid % nig) / gsz; u.e = 0; u.mt = 0; return true;
    }
    __device__ __forceinline__ const char* abase() const { return A; }
    __device__ __forceinline__ void aoff(const Unit& u, const int (&R)[2], const int (&C)[2], unsigned (&ao)[2][2]) const {
#pragma unroll
        for (int h = 0; h < 2; ++h)
#pragma unroll
            for (int i = 0; i < 2; ++i) ao[h][i] = (unsigned)(((size_t)(u.pm * BM + h * HALF + R[i]) * K + C[i]) * 2);
    }
    __device__ __forceinline__ const char* bbase(const Unit& u) const { return Bt + (size_t)u.pn * BM * K * 2; }
};

#define PG8_WAIT_V(n) asm volatile("s_waitcnt vmcnt(" #n ")" ::: "memory")
#define PG8_WAIT_L(n) asm volatile("s_waitcnt lgkmcnt(" #n ")" ::: "memory")
#define PG8_BAR __builtin_amdgcn_s_barrier()
#define PG8_SCHED __builtin_amdgcn_sched_barrier(0)

template <class Epi, class Sched, bool ALIGN_EPI>
__device__ __forceinline__ void gemm_phase(LAS unsigned char* lds, const int K, const Sched& S, const Epi& E, const int tid) {
    constexpr bool GATHER = Sched::GATHER;
    const int wid = __builtin_amdgcn_readfirstlane(tid >> 6), lane = tid & 63, wr = wid >> 2, wc = wid & 3, fr = lane & 15, fq = lane >> 4;
    const int nt = K / BK;
    int Rr[2], Cc[2]; unsigned voffB[2], voffA[2];
#pragma unroll
    for (int i = 0; i < 2; ++i) { int R, C; stage_rc(tid * 16 + i * 8192, R, C); Rr[i] = R; Cc[i] = C; const int Rb = Epi::PERM ? ((R & ~31) + perm32(R & 31)) : R; voffB[i] = (unsigned)(Rb * K + C) * 2u; voffA[i] = (unsigned)(R * K + C) * 2u; }
    const size_t kstep = (size_t)(BK * 2);
    const size_t hstep = (size_t)HALF * K * 2;
    const size_t tstep = 2 * hstep;
    const unsigned ldsw = (unsigned)wid * 1024u;
    const int aoff_l = lds_byte(wr * 64 + fr, fq * 8), boff_l = lds_byte(wc * 32 + fr, fq * 8);
    const char* const gA = S.abase();
    LAS u32x4* const park = (LAS u32x4*)(lds + STAGE_BYTES) + tid;
#define PG8_SA(b, h) (((b) * 2 + (h)) * HTB)
#define PG8_SB(b, h) ((4 + (b) * 2 + (h)) * HTB)
#define PG8_STAGE(bufoff, gbase, voff) do { _Pragma("unroll") for (int _i = 0; _i < 2; ++_i) \
        __builtin_amdgcn_global_load_lds((const unsigned*)((const char*)(gbase) + (voff)[_i]), (LAS unsigned*)(lds + (bufoff) + ldsw + _i * 8192), 16, 0, 0); } while (0)
#define PG8_STAGEA(bufoff, ubase, h, kb) do { if constexpr (GATHER) { \
        __builtin_amdgcn_global_load_lds((const unsigned*)((gA + (kb)) + aoC[h][0]), (LAS unsigned*)(lds + (bufoff) + ldsw), 16, 0, 0); \
        __builtin_amdgcn_global_load_lds((const unsigned*)((gA + (kb)) + aoC[h][1]), (LAS unsigned*)(lds + (bufoff) + ldsw + 8192), 16, 0, 0); \
      } else { PG8_STAGE(bufoff, (ubase) + (size_t)(h) * hstep + (kb), voffA); } } while (0)
#define PG8_LDA(dst, b, h) do { _Pragma("unroll") for (int m = 0; m < 4; ++m) _Pragma("unroll") for (int k = 0; k < 2; ++k) dst[m][k] = *(const LAS f16x8*)(lds + PG8_SA(b, h) + aoff_l + m * 2048 + k * 1024); } while (0)
#define PG8_LDB(dst, b, h) do { _Pragma("unroll") for (int n = 0; n < 2; ++n) _Pragma("unroll") for (int k = 0; k < 2; ++k) dst[n][k] = *(const LAS f16x8*)(lds + PG8_SB(b, h) + boff_l + n * 2048 + k * 1024); } while (0)
#define PG8_MMA(ai, bj, At, Bt) do { __builtin_amdgcn_s_setprio(1); _Pragma("unroll") for (int m = 0; m < 4; ++m) _Pragma("unroll") for (int n = 0; n < 2; ++n) _Pragma("unroll") for (int k = 0; k < 2; ++k) \
        acc[ai][bj][m][n] = __builtin_amdgcn_mfma_f32_16x16x32_f16(Bt[n][k], At[m][k], acc[ai][bj][m][n], 0, 0, 0); __builtin_amdgcn_s_setprio(0); } while (0)
    Unit cur, nxt; int ui = 0;
    if (!S.next(0, cur)) return;
    f32x4 acc[2][2][4][2];
#pragma unroll
    for (int a = 0; a < 2; ++a)
#pragma unroll
        for (int b = 0; b < 2; ++b)
#pragma unroll
            for (int m = 0; m < 4; ++m)
#pragma unroll
                for (int n = 0; n < 2; ++n) acc[a][b][m][n] = (f32x4){0.f, 0.f, 0.f, 0.f};
    f16x8 At[4][2], B0[2][2], B1[2][2];
    unsigned aoC[2][2] = {{0u, 0u}, {0u, 0u}};
    if constexpr (GATHER) S.aoff(cur, Rr, Cc, aoC);
    const char* cA = gA + (size_t)cur.pm * tstep;
    const char* cB = S.bbase(cur);
    PG8_STAGE(PG8_SB(0, 0), cB, voffB); PG8_STAGE(PG8_SB(0, 1), cB + hstep, voffB); PG8_STAGEA(PG8_SA(0, 0), cA, 0, 0); PG8_STAGEA(PG8_SA(0, 1), cA, 1, 0);
    if (wr == 1) PG8_BAR;
    PG8_WAIT_V(2); PG8_BAR;
    PG8_STAGE(PG8_SB(1, 0), cB + kstep, voffB); PG8_STAGEA(PG8_SA(1, 0), cA, 0, kstep); PG8_STAGE(PG8_SB(1, 1), cB + hstep + kstep, voffB);
    PG8_WAIT_V(6); PG8_BAR;
    for (;;) {
        const bool has_next = S.next(ui + 1, nxt);
        const char* nB = cB; const char* nA = cA;
        if (has_next) { nB = S.bbase(nxt); nA = gA + (size_t)nxt.pm * tstep; }
        if constexpr (GATHER) { unsigned aoN[2][2];
            if (has_next) S.aoff(nxt, Rr, Cc, aoN); else { aoN[0][0] = aoC[0][0]; aoN[0][1] = aoC[0][1]; aoN[1][0] = aoC[1][0]; aoN[1][1] = aoC[1][1]; }
            *park = (u32x4){aoN[0][0], aoN[0][1], aoN[1][0], aoN[1][1]}; }
        for (int t = 0; t < nt; t += 2) {
            const bool last = (t == nt - 2);
            const size_t k1 = (size_t)(t + 1) * kstep;
            const size_t k2 = last ? 0 : (size_t)(t + 2) * kstep, k3 = k2 + kstep;
            const char* a2 = last ? nA : cA;
            const char* b2 = (last ? nB : cB) + k2; const char* b3 = b2 + kstep;
            PG8_LDB(B0, 0, 0); PG8_LDB(B1, 0, 1); PG8_SCHED; PG8_LDA(At, 0, 0); PG8_STAGEA(PG8_SA(1, 1), cA, 1, k1);
            if constexpr (GATHER) { if (last) { const u32x4 p = *park; aoC[0][0] = p.x; aoC[0][1] = p.y; aoC[1][0] = p.z; aoC[1][1] = p.w; } }
            PG8_WAIT_V(8); PG8_WAIT_L(0); PG8_BAR; PG8_MMA(0, 0, At, B0); PG8_MMA(0, 1, At, B1); PG8_BAR; PG8_SCHED;
            PG8_LDA(At, 0, 1); PG8_STAGE(PG8_SB(0, 0), b2, voffB); PG8_STAGE(PG8_SB(0, 1), b2 + hstep, voffB); PG8_STAGEA(PG8_SA(0, 0), a2, 0, k2);
            PG8_WAIT_V(8); PG8_WAIT_L(0); PG8_BAR; PG8_MMA(1, 0, At, B0); PG8_MMA(1, 1, At, B1); PG8_BAR; PG8_SCHED;
            PG8_LDB(B0, 1, 0); PG8_LDB(B1, 1, 1); PG8_SCHED; PG8_LDA(At, 1, 0); PG8_STAGEA(PG8_SA(0, 1), a2, 1, k2);
            PG8_WAIT_V(8); PG8_WAIT_L(0); PG8_BAR; PG8_MMA(0, 0, At, B0); PG8_MMA(0, 1, At, B1); PG8_BAR; PG8_SCHED;
            PG8_LDA(At, 1, 1); PG8_STAGE(PG8_SB(1, 0), b3, voffB); PG8_STAGE(PG8_SB(1, 1), b3 + hstep, voffB); PG8_STAGEA(PG8_SA(1, 0), a2, 0, k3);
            PG8_WAIT_V(8); PG8_WAIT_L(0); PG8_BAR; PG8_MMA(1, 0, At, B0); PG8_MMA(1, 1, At, B1); PG8_BAR; PG8_SCHED;
        }
        if constexpr (ALIGN_EPI) { if (wr == 0) PG8_BAR; }
        E(acc, cur, wr, wc, fr, fq);
        if (!has_next) break;
#pragma unroll
        for (int a = 0; a < 2; ++a)
#pragma unroll
            for (int b = 0; b < 2; ++b)
#pragma unroll
                for (int m = 0; m < 4; ++m)
#pragma unroll
                    for (int n = 0; n < 2; ++n) acc[a][b][m][n] = (f32x4){0.f, 0.f, 0.f, 0.f};
        cur = nxt; cB = nB; cA = nA; ++ui;
        if constexpr (ALIGN_EPI) { if (wr == 1) PG8_BAR; }
    }
    PG8_WAIT_V(0);
    if constexpr (!ALIGN_EPI) { if (wr == 0) PG8_BAR; }
    PG8_BAR;
#undef PG8_SA
#undef PG8_SB
#undef PG8_STAGE
#undef PG8_STAGEA
#undef PG8_LDA
#undef PG8_LDB
#undef PG8_MMA
}

struct EpiH16 {
    static constexpr bool PERM = true;
    h16* O; int ldc; int split_cols; size_t split_stride; const float* rstd; float scale0, scale1; int rot; const float* ct; const float* st;
    __device__ __forceinline__ void operator()(const f32x4 (&acc)[2][2][4][2], const Unit& u, int wr, int wc, int fr, int fq) const {
        const int row0 = u.pm * BM + wr * 64 + fr; int colt = u.pn * BM; h16* base = O;
        const int t = colt / split_cols; base += (size_t)t * split_stride; colt -= t * split_cols;
        const float sc = (t == 0) ? scale0 : ((t == 1) ? scale1 : 1.f);
        const int col0 = colt + wc * 32 + 8 * fq;
        const bool dorot = rot && (t < 2);
#pragma unroll
        for (int ai = 0; ai < 2; ++ai)
#pragma unroll
            for (int m = 0; m < 4; ++m) {
                const int row = row0 + ai * HALF + m * 16; const float rs = rstd[row] * sc;
                h16* rowp = base + (size_t)row * ldc + col0;
                if (dorot) {
                    const int pos = row & (SEQ - 1); const int d0 = wc * 32 + 8 * fq;
                    const f32x4 c0 = *(const f32x4*)(ct + pos * 128 + d0), c1 = *(const f32x4*)(ct + pos * 128 + d0 + 4);
                    const f32x4 s0 = *(const f32x4*)(st + pos * 128 + d0), s1 = *(const f32x4*)(st + pos * 128 + d0 + 4);
                    const f32x4 a0 = acc[ai][0][m][0] * rs, a1 = acc[ai][0][m][1] * rs, b0 = acc[ai][1][m][0] * rs, b1 = acc[ai][1][m][1] * rs;
                    const f32x4 o10 = a0 * c0 - b0 * s0, o11 = a1 * c1 - b1 * s1, o20 = a0 * s0 + b0 * c0, o21 = a1 * s1 + b1 * c1;
                    u32x4 w; w.x = pk2h(o10[0], o10[1]); w.y = pk2h(o10[2], o10[3]); w.z = pk2h(o11[0], o11[1]); w.w = pk2h(o11[2], o11[3]);
                    *(u32x4*)(rowp) = w;
                    w.x = pk2h(o20[0], o20[1]); w.y = pk2h(o20[2], o20[3]); w.z = pk2h(o21[0], o21[1]); w.w = pk2h(o21[2], o21[3]);
                    *(u32x4*)(rowp + HALF) = w;
                } else {
#pragma unroll
                    for (int bj = 0; bj < 2; ++bj) { const f32x4 v0 = acc[ai][bj][m][0] * rs, v1 = acc[ai][bj][m][1] * rs;
                        u32x4 w; w.x = pk2h(v0[0], v0[1]); w.y = pk2h(v0[2], v0[3]); w.z = pk2h(v1[0], v1[1]); w.w = pk2h(v1[2], v1[3]);
                        *(u32x4*)(rowp + bj * HALF) = w; }
                }
            }
    }
};
struct EpiResid {
    static constexpr bool PERM = false;
    float* H; int ldc;
    __device__ __forceinline__ void operator()(const f32x4 (&acc)[2][2][4][2], const Unit& u, int wr, int wc, int fr, int fq) const {
        const int col0 = u.pn * BM + wc * 32 + 4 * fq, row0 = u.pm * BM + wr * 64 + fr;
#pragma unroll
        for (int ai = 0; ai < 2; ++ai)
#pragma unroll
            for (int m = 0; m < 4; ++m) { float* rp = H + (size_t)(row0 + ai * HALF + m * 16) * ldc + col0;
#pragma unroll
                for (int bj = 0; bj < 2; ++bj)
#pragma unroll
                    for (int n = 0; n < 2; ++n) { f32x4* p = (f32x4*)(rp + bj * HALF + n * 16); *p = *p + acc[ai][bj][m][n]; } }
    }
};
struct EpiStoreF32 {
    static constexpr bool PERM = false;
    float* Y; int ldc;
    __device__ __forceinline__ void operator()(const f32x4 (&acc)[2][2][4][2], const Unit& u, int wr, int wc, int fr, int fq) const {
        const int col0 = u.pn * BM + wc * 32 + 4 * fq, row0 = u.pm * BM + wr * 64 + fr;
#pragma unroll
        for (int ai = 0; ai < 2; ++ai)
#pragma unroll
            for (int m = 0; m < 4; ++m) { float* rp = Y + (size_t)(row0 + ai * HALF + m * 16) * ldc + col0;
#pragma unroll
                for (int bj = 0; bj < 2; ++bj)
#pragma unroll
                    for (int n = 0; n < 2; ++n) *(f32x4*)(rp + bj * HALF + n * 16) = acc[ai][bj][m][n]; }
    }
};
struct EpiStoreH16 {
    static constexpr bool PERM = true;
    h16* Y; int ldc;
    __device__ __forceinline__ void operator()(const f32x4 (&acc)[2][2][4][2], const Unit& u, int wr, int wc, int fr, int fq) const {
        const int col0 = u.pn * BM + wc * 32 + 8 * fq, row0 = u.pm * BM + wr * 64 + fr;
#pragma unroll
        for (int ai = 0; ai < 2; ++ai)
#pragma unroll
            for (int m = 0; m < 4; ++m) { h16* rp = Y + (size_t)(row0 + ai * HALF + m * 16) * ldc + col0;
#pragma unroll
                for (int bj = 0; bj < 2; ++bj) { const f32x4 v0 = acc[ai][bj][m][0], v1 = acc[ai][bj][m][1];
                    u32x4 w; w.x = pk2h(v0[0], v0[1]); w.y = pk2h(v0[2], v0[3]); w.z = pk2h(v1[0], v1[1]); w.w = pk2h(v1[2], v1[3]);
                    *(u32x4*)(rp + bj * HALF) = w; } }
    }
};
struct EpiSwiGLU {
    static constexpr bool PERM = true;
    h16* ACT; const float* rstd; const int* list; const int* cnt;
    __device__ __forceinline__ void operator()(const f32x4 (&acc)[2][2][4][2], const Unit& u, int wr, int wc, int fr, int fq) const {
        const int row0 = u.pm * BM + wr * 64 + fr, rank0 = u.mt * BM + wr * 64 + fr; const int c = cnt[u.e];
        const int col0 = u.pn * 128 + wc * 16 + 4 * fq;
#pragma unroll
        for (int ai = 0; ai < 2; ++ai)
#pragma unroll
            for (int m = 0; m < 4; ++m) {
                const int rank = rank0 + ai * HALF + m * 16; float rs = 0.f;
                if (rank < c) rs = rstd[list[u.e * LISTCAP + rank] >> 1];
                h16* rowp = ACT + (size_t)(row0 + ai * HALF + m * 16) * EFF + col0;
#pragma unroll
                for (int bj = 0; bj < 2; ++bj) { const f32x4 a = acc[ai][bj][m][0] * rs, b = acc[ai][bj][m][1] * rs; f32x4 o;
#pragma unroll
                    for (int q = 0; q < 4; ++q) o[q] = a[q] * __builtin_amdgcn_rcpf(1.0f + __builtin_amdgcn_exp2f(-a[q] * LOG2E)) * b[q];
                    u32x2 w; w.x = pk2h(o[0], o[1]); w.y = pk2h(o[2], o[3]); *(u32x2*)(rowp + bj * 64) = w; }
            }
    }
};
}
namespace attn_body {
constexpr int D = 64, DMP = 1024;
constexpr int NW = 8, QBLK = 32, QB = QBLK * NW, KVBLK = 64, NQB = SEQ / QB;
__device__ __forceinline__ int crow(int r, int hi) { return (r & 3) + 8 * (r >> 2) + 4 * hi; }
#define SBAR() __builtin_amdgcn_sched_barrier(0)
__device__ __forceinline__ void cmask(f32x16& p0, f32x16& p1, int jb, int qrel, int hi) {
    const float NEG = -INFINITY; int kb = 64 * jb + 4 * hi;
#pragma unroll
    for (int r = 0; r < 16; ++r) { int kv = kb + (r & 3) + 8 * (r >> 2); if (kv > qrel) p0[r] = NEG; if (kv + 32 > qrel) p1[r] = NEG; }
}
constexpr int NSLOT = 3, SLOTB = 8192;
constexpr int LDS_K = 0, LDS_V = NSLOT * SLOTB, LDS_WS = 2 * NSLOT * SLOTB, LDS_OST = LDS_WS + NW * 64 * 4, LDS_BIAS = LDS_OST + NW * 4096, LDS_BYTES = LDS_BIAS + SEQ * 4;
constexpr float C2 = 0.125f * LOG2E;
__device__ __forceinline__ void glds16(const void* gsrc, unsigned lds_dst) { unsigned keep;
    asm volatile("s_mov_b32 %0, m0\n\ts_mov_b32 m0, %2\n\ts_nop 0\n\tglobal_load_lds_dwordx4 %1, off\n\ts_mov_b32 m0, %0" : "=&s"(keep) : "v"(gsrc), "s"(lds_dst) : "memory"); }
__device__ __forceinline__ float max3f(float a, float b, float c) { float r; asm("v_max3_f32 %0, %1, %2, %3" : "=v"(r) : "v"(a), "v"(b), "v"(c)); return r; }
__device__ __forceinline__ float max2f(float a, float b) { float r; asm("v_max_f32_e32 %0, %1, %2" : "=v"(r) : "v"(a), "v"(b)); return r; }
__device__ __forceinline__ float fadd_s(float a, float b) { float r; asm("v_add_f32_e32 %0, %1, %2" : "=v"(r) : "v"(a), "v"(b)); return r; }
__device__ __forceinline__ float fsub_s(float a, float b) { float r; asm("v_sub_f32_e32 %0, %1, %2" : "=v"(r) : "v"(a), "v"(b)); return r; }
__device__ __forceinline__ unsigned split_hl(float v) { const h16 hi = (h16)v; const h16 lo = (h16)(v - (float)hi); return (unsigned)__builtin_bit_cast(unsigned short, hi) | ((unsigned)__builtin_bit_cast(unsigned short, lo) << 16); }
#define WAIT_BAR(N) asm volatile("s_waitcnt vmcnt(" #N ") lgkmcnt(0)\n\ts_barrier" ::: "memory")
#define MF16(a, b, c) __builtin_amdgcn_mfma_f32_32x32x16_f16(a, b, c, 0, 0, 0)
typedef LAS const char* lds_cptr;
typedef short v4i16_t __attribute__((ext_vector_type(4)));
__device__ __forceinline__ void kload8(f16x8* kf, lds_cptr kp) {
    kf[0] = *(const LAS f16x8*)(kp);        kf[1] = *(const LAS f16x8*)(kp + 512);
    kf[2] = *(const LAS f16x8*)(kp + 2048); kf[3] = *(const LAS f16x8*)(kp + 2560);
    kf[4] = *(const LAS f16x8*)(kp + 4096); kf[5] = *(const LAS f16x8*)(kp + 4608);
    kf[6] = *(const LAS f16x8*)(kp + 6144); kf[7] = *(const LAS f16x8*)(kp + 6656);
}
__device__ __forceinline__ void kload2(f16x8* kf, lds_cptr kp, int j) { kf[2 * j] = *(const LAS f16x8*)(kp + j * 2048); kf[2 * j + 1] = *(const LAS f16x8*)(kp + j * 2048 + 512); }
__device__ __forceinline__ s16x4 vtr(lds_cptr p) { return __builtin_bit_cast(s16x4, __builtin_amdgcn_ds_read_tr16_b64_v4i16((LAS v4i16_t*)p)); }
__device__ __forceinline__ f16x8 mk8(s16x4 lo, s16x4 hi) { typedef short s16x8 __attribute__((ext_vector_type(8))); s16x8 t = {lo[0], lo[1], lo[2], lo[3], hi[0], hi[1], hi[2], hi[3]}; return __builtin_bit_cast(f16x8, t); }
__device__ __forceinline__ f16x4 ext_frag(unsigned w0, unsigned w1) { u32x2 t = {w0, w1}; return __builtin_bit_cast(f16x4, t); }
#define MF8(a, b, c) __builtin_amdgcn_mfma_f32_32x32x8f16(a, b, c, 0, 0, 0)
__device__ __forceinline__ float rowmax(const f32x16& p0, const f32x16& p1) {
    float a = max3f(p0[0], p0[1], p1[0]), b = max3f(p0[2], p0[3], p1[1]); a = max3f(a, p1[2], p1[3]);
#pragma unroll
    for (int r = 4; r < 16; r += 4) { a = max3f(a, p0[r], p0[r + 1]); b = max3f(b, p0[r + 2], p0[r + 3]); a = max3f(a, p1[r], p1[r + 1]); b = max3f(b, p1[r + 2], p1[r + 3]); }
    const float m = max2f(a, b);
    auto rr = __builtin_amdgcn_permlane32_swap(__float_as_uint(m), __float_as_uint(m), false, false);
    return max2f(__uint_as_float(rr[0]), __uint_as_float(rr[1]));
}
__device__ __forceinline__ void qkt(f32x16& p0, f32x16& p1, const char* Kslot, const f16x8* qr, f16x4 kb0, f16x4 kb1, f16x4 qe, int r32, int hi) {
    const char* kb = Kslot + hi * 1024 + r32 * 16;
    const f32x16 z = {};
    p0 = MF8(kb0, qe, z); p1 = MF8(kb1, qe, z);
#pragma unroll
    for (int d0 = 0; d0 < 4; ++d0) {
        const f16x8 b0 = *reinterpret_cast<const f16x8*>(kb + d0 * 2048);
        const f16x8 b1 = *reinterpret_cast<const f16x8*>(kb + d0 * 2048 + 512);
        p0 = MF16(b0, qr[d0], p0); p1 = MF16(b1, qr[d0], p1); }
}
__device__ __forceinline__ void pv(f32x16* o, int vb, f16x8 pa0, f16x8 pa1, f16x8 pa2, f16x8 pa3) {
#pragma unroll
    for (int d0 = 0; d0 < 2; ++d0) { s16x4 lo[4], hi[4];
#pragma unroll
        for (int ks = 0; ks < 4; ++ks) {
            asm volatile("ds_read_b64_tr_b16 %0,%1 offset:%c2" : "=&v"(lo[ks]) : "v"(vb), "i"(d0 * 4096 + ks * 1024) : "memory");
            asm volatile("ds_read_b64_tr_b16 %0,%1 offset:%c2" : "=&v"(hi[ks]) : "v"(vb), "i"(d0 * 4096 + ks * 1024 + 512) : "memory"); }
        asm volatile("s_waitcnt lgkmcnt(0)" ::: "memory"); SBAR();
        o[d0] = MF16(pa0, mk8(lo[0], hi[0]), o[d0]);
        o[d0] = MF16(pa1, mk8(lo[1], hi[1]), o[d0]);
        o[d0] = MF16(pa2, mk8(lo[2], hi[2]), o[d0]);
        o[d0] = MF16(pa3, mk8(lo[3], hi[3]), o[d0]);
    }
}
#define ATTN_ONES 0x3C003C00u
template <int THRL> __device__ __forceinline__ void attn_unit(int b, int h, int qb, const h16* Q, const h16* __restrict__ K, const h16* __restrict__ V, const h16* __restrict__ G, const float* __restrict__ cum, h16* O, char* shm, const int tid) {
    const int lane = tid & 63, r32 = lane & 31, hi = lane >> 5; const int wid = __builtin_amdgcn_readfirstlane(tid >> 6);
    const long rowbase = (long)b * SEQ; const int q0 = qb * QB;
    const h16* Qw = Q + (rowbase + q0 + wid * QBLK) * DMP + h * D;
    const h16* Kh = K + rowbase * DMP + h * D, *Vh = V + rowbase * DMP + h * D;
    const unsigned lds0 = (unsigned)(uintptr_t)shm;
    float* wsf = (float*)(shm + LDS_WS) + wid * 64;
    const h16* ksrc = Kh + (long)lane * DMP + wid * 8;
    const h16* vsrc = Vh + (long)(16 * (wid & 3) + (lane >> 2)) * DMP + (wid >> 2) * 32 + (lane & 3) * 8;
    const unsigned kdst = lds0 + LDS_K + wid * 1024, vdst = lds0 + LDS_V + wid * 1024;
#define DMA_K(t, slot) glds16(ksrc + (long)(t) * KVBLK * DMP, (unsigned)__builtin_amdgcn_readfirstlane(kdst + (slot)))
#define DMA_V(t, slot) glds16(vsrc + (long)(t) * KVBLK * DMP, (unsigned)__builtin_amdgcn_readfirstlane(vdst + (slot)))
    const int vb0 = (int)(lds0 + LDS_V) + ((lane >> 4) & 1) * 32 + (lane & 3) * 8 + (4 * hi + ((lane & 15) >> 2)) * 64;
    const char* Kbase = shm + LDS_K; f16x8 kf[8];
    const lds_cptr shm3 = (lds_cptr)shm; const lds_cptr kp0 = shm3 + LDS_K + hi * 1024 + r32 * 16; const lds_cptr vp0 = shm3 + LDS_V + ((lane >> 4) & 1) * 32 + (lane & 3) * 8 + (4 * hi + ((lane & 15) >> 2)) * 64;
    const LAS unsigned* biasw = (const LAS unsigned*)(shm3 + LDS_BIAS);
    const int NT = (q0 + QB) / KVBLK;
    DMA_K(0, 0); DMA_V(0, 0); DMA_K(1, SLOTB);
    { const float* cb = cum + (long)(b * FOX_H + h) * SEQ; const float cref = cb[q0];
      LAS unsigned* bw = (LAS unsigned*)(shm3 + LDS_BIAS);
      for (int j = tid; j < q0 + QB; j += NW * 64) bw[j] = split_hl(fmaxf((cref - cb[j]) * LOG2E, -30000.f)); }
    f16x8 qr[4];
#pragma unroll
    for (int d0 = 0; d0 < 4; ++d0) qr[d0] = *reinterpret_cast<const f16x8*>(&Qw[(long)r32 * DMP + d0 * 16 + hi * 8]);
    float mhat = 0.f, l_reg = 0.f; f32x16 o[2]; o[0] = f32x16{}; o[1] = f32x16{};
    unsigned qew1 = 0u;
    const unsigned qew0 = hi ? 0u : ATTN_ONES, kew1 = hi ? 0u : ATTN_ONES;
#define QE() ext_frag(qew0, qew1)
#define KE(w) ext_frag(hi ? 0u : (w), kew1)
#define SETM() do { qew1 = hi ? 0u : split_hl(-mhat); } while (0)
    const int qrel = wid * QBLK + r32;
#define CMASK(P0, P1, t) do { int jb_ = (t) - (NT - 4); if (jb_ >= 0) cmask(P0, P1, jb_, qrel, hi); } while (0)
    bool resc = false;
#define START(P0, P1) do { const float rm = rowmax(P0, P1); resc = false; \
    { const float dl = rm; mhat = fadd_s(mhat, dl); \
      _Pragma("unroll") for (int r = 0; r < 16; ++r) { P0[r] = fsub_s(P0[r], dl); P1[r] = fsub_s(P1[r], dl); } \
      SETM(); } \
    _Pragma("unroll") for (int r = 0; r < 16; ++r) P0[r] = __builtin_amdgcn_exp2f(P0[r]); } while (0)
#define RESC() do { if (resc) { asm volatile("s_waitcnt lgkmcnt(0)" ::: "memory"); \
      _Pragma("unroll") for (int d_ = 0; d_ < 2; ++d_) _Pragma("unroll") for (int r = 0; r < 16; ++r) o[d_][r] *= wsf[crow(r, hi)]; } } while (0)
    f32x16 pA0, pA1, pB0, pB1;
    int sl_prev = 0, sl_cur = 0, sl_next = SLOTB;
#define ROT() do { sl_prev = sl_cur; sl_cur = sl_next; sl_next = (sl_next == (NSLOT - 1) * SLOTB) ? 0 : sl_next + SLOTB; } while (0)
    DMA_K(2, 2 * SLOTB);
    WAIT_BAR(3);
    unsigned bw0 = biasw[r32], bw1 = biasw[32 + r32];
    qkt(pA0, pA1, Kbase, qr, KE(bw0), KE(bw1), QE(), r32, hi); asm volatile("s_nop 15\n\ts_nop 7" : "+v"(pA0), "+v"(pA1)); CMASK(pA0, pA1, 0);
    START(pA0, pA1);
    _Pragma("unroll") for (int r = 0; r < 16; ++r) pA1[r] = __builtin_amdgcn_exp2f(pA1[r]);
    WAIT_BAR(0);
    DMA_K(3, 0); DMA_V(1, SLOTB);
    ROT();
    kload8(kf, kp0 + sl_cur);
    bw0 = biasw[64 + r32]; bw1 = biasw[96 + r32];
    WAIT_BAR(2);
    s16x4 vlo[8], vhi[8]; u32x4 pw0, pw1, pw2, pw3;
#define PKW(P, B) pk2h(P[B], P[B + 1])
#define PAF(k) __builtin_bit_cast(f16x8, pw##k)
#define VFR(i) mk8(vlo[i], vhi[i])
#define PIN(x) asm volatile("" : "+v"(x))
#define MX3(a, b, c) __builtin_fmaxf(__builtin_fmaxf((a), (b)), (c))
#define GAPA(MF, A0, A1, A2, A3, W0, W1, PW) do { MF; sacc += A0; sacc += A1; sacc += A2; sacc += A3; PIN(sacc); W0; W1; PIN(PW); SBAR(); } while (0)
#define EX(v) __builtin_amdgcn_exp2f(v)
#define GAPB(MF, X, B) do { MF; X[B] = EX(X[B]); X[B + 1] = EX(X[B + 1]); X[B + 2] = EX(X[B + 2]); X[B + 3] = EX(X[B + 3]); PIN(X); SBAR(); } while (0)
#define VRD(i) do { vlo[i] = vtr(vp_ + (((i) >> 2) * 4096 + ((i) & 3) * 1024)); vhi[i] = vtr(vp_ + (((i) >> 2) * 4096 + ((i) & 3) * 1024 + 512)); } while (0)
#define KRD(G_, j) do { if (G_) { kload2(kf, kp0 + sl_next, j); SBAR(); } } while (0)
#define STEP(C0, C1, P0, P1, t, GK, GV, GL) do { SBAR(); \
    const lds_cptr vp_ = vp0 + sl_prev; const f32x16 z_ = {}; \
    C0 = MF8(KE(bw0), QE(), z_); C1 = MF8(KE(bw1), QE(), z_); SBAR(); \
    VRD(0); SBAR(); float sacc = (P0[0] + P0[1]); \
    GAPA(C0 = MF16(kf[0], qr[0], C0), P0[2], P0[3], P0[4], P0[5],     pw0[0] = PKW(P0, 0), pw0[1] = PKW(P0, 2), pw0); \
    VRD(4); SBAR(); GAPA(C1 = MF16(kf[1], qr[0], C1), P0[6], P0[7], P0[8], P0[9],     pw0[2] = PKW(P0, 4), pw0[3] = PKW(P0, 6), pw0); \
    VRD(1); SBAR(); GAPA(C0 = MF16(kf[2], qr[1], C0),   P0[10], P0[11], P0[12], P0[13], pw1[0] = PKW(P0, 8), pw1[1] = PKW(P0, 10), pw1); \
    VRD(5); SBAR(); GAPA(C1 = MF16(kf[3], qr[1], C1),   P0[14], P0[15], P1[0], P1[1],   pw1[2] = PKW(P0, 12), pw1[3] = PKW(P0, 14), pw1); \
    VRD(2); SBAR(); GAPA(C0 = MF16(kf[4], qr[2], C0),   P1[2], P1[3], P1[4], P1[5],     pw2[0] = PKW(P1, 0), pw2[1] = PKW(P1, 2), pw2); \
    VRD(6); SBAR(); GAPA(C1 = MF16(kf[5], qr[2], C1),   P1[6], P1[7], P1[8], P1[9],     pw2[2] = PKW(P1, 4), pw2[3] = PKW(P1, 6), pw2); \
    VRD(3); SBAR(); GAPA(C0 = MF16(kf[6], qr[3], C0),   P1[10], P1[11], P1[12], P1[13], pw3[0] = PKW(P1, 8), pw3[1] = PKW(P1, 10), pw3); \
    VRD(7); SBAR(); GAPA(C1 = MF16(kf[7], qr[3], C1),   P1[14], P1[15], 0.f, 0.f,       pw3[2] = PKW(P1, 12), pw3[3] = PKW(P1, 14), pw3); \
    l_reg += sacc; \
    if (GK) { DMA_K((t) + 3, sl_cur); } if (GV) { DMA_V((t) + 1, sl_next); } \
    CMASK(C0, C1, t); \
    { float a = MX3(C0[0], C0[1], C1[0]), b_ = MX3(C0[2], C0[3], C1[1]); a = MX3(a, C1[2], C1[3]); \
      _Pragma("unroll") for (int r = 4; r < 16; r += 4) { a = MX3(a, C0[r], C0[r + 1]); b_ = MX3(b_, C0[r + 2], C0[r + 3]); a = MX3(a, C1[r], C1[r + 1]); b_ = MX3(b_, C1[r + 2], C1[r + 3]); } \
      float rm = __builtin_fmaxf(a, b_); { auto rr = __builtin_amdgcn_permlane32_swap(__float_as_uint(rm), __float_as_uint(rm), false, false); rm = __builtin_fmaxf(__uint_as_float(rr[0]), __uint_as_float(rr[1])); } \
      resc = false; \
      if (__builtin_expect(__any(rm > (float)THRL), 0)) { const float dl = __builtin_fmaxf(rm, 0.f); mhat += dl; \
        _Pragma("unroll") for (int r = 0; r < 16; ++r) { C0[r] -= dl; C1[r] -= dl; } \
        SETM(); \
        const float f = __builtin_amdgcn_exp2f(-dl); l_reg *= f; if (hi == 0) wsf[r32] = f; resc = true; } } \
    SBAR(); \
    if (GL) { bw0 = biasw[((t) + 1) * 64 + r32]; bw1 = biasw[((t) + 1) * 64 + 32 + r32]; } \
    GAPB(o[0] = MF16(PAF(0), VFR(0), o[0]), C0, 0); \
    GAPB(o[1] = MF16(PAF(0), VFR(4), o[1]), C0, 4); \
    KRD(GL, 0); GAPB(o[0] = MF16(PAF(1), VFR(1), o[0]), C0, 8); \
    KRD(GL, 1); GAPB(o[1] = MF16(PAF(1), VFR(5), o[1]), C0, 12); \
    KRD(GL, 2); GAPB(o[0] = MF16(PAF(2), VFR(2), o[0]), C1, 0); \
    KRD(GL, 3); GAPB(o[1] = MF16(PAF(2), VFR(6), o[1]), C1, 4); \
    GAPB(o[0] = MF16(PAF(3), VFR(3), o[0]), C1, 8); \
    GAPB(o[1] = MF16(PAF(3), VFR(7), o[1]), C1, 12); \
    } while (0)
    int t = 1;
#undef CMASK
#define CMASK(P0, P1, t) do {} while (0)
    for (; t + 5 < NT; t += 2) {
        STEP(pB0, pB1, pA0, pA1, t, true, true, true);     WAIT_BAR(2); RESC(); ROT();
        STEP(pA0, pA1, pB0, pB1, t + 1, true, true, true); WAIT_BAR(2); RESC(); ROT();
    }
#undef CMASK
#define CMASK(P0, P1, t) do { int jb_ = (t) - (NT - 4); if (jb_ >= 0) cmask(P0, P1, jb_, qrel, hi); } while (0)
#define ENDW(tt) do { if ((tt) + 3 < NT) { WAIT_BAR(2); } else if ((tt) + 2 < NT) { WAIT_BAR(1); } else { WAIT_BAR(0); } } while (0)
    for (; t + 1 < NT; t += 2) {
        STEP(pB0, pB1, pA0, pA1, t, (t + 3 < NT), (t + 1 < NT), (t + 1 < NT));         ENDW(t);     RESC(); ROT();
        STEP(pA0, pA1, pB0, pB1, t + 1, (t + 4 < NT), (t + 2 < NT), (t + 2 < NT));     ENDW(t + 1); RESC(); ROT();
    }
    STEP(pB0, pB1, pA0, pA1, NT - 1, false, false, false); RESC();
    { float sacc = pB0[0] + pB0[1]; _Pragma("unroll") for (int r = 2; r < 16; ++r) sacc += pB0[r]; _Pragma("unroll") for (int r = 0; r < 16; ++r) sacc += pB1[r]; l_reg += sacc;
      pw0 = (u32x4){PKW(pB0, 0), PKW(pB0, 2), PKW(pB0, 4), PKW(pB0, 6)}; pw1 = (u32x4){PKW(pB0, 8), PKW(pB0, 10), PKW(pB0, 12), PKW(pB0, 14)}; pw2 = (u32x4){PKW(pB1, 0), PKW(pB1, 2), PKW(pB1, 4), PKW(pB1, 6)}; pw3 = (u32x4){PKW(pB1, 8), PKW(pB1, 10), PKW(pB1, 12), PKW(pB1, 14)};
      SBAR(); pv(o, vb0 + sl_cur, PAF(0), PAF(1), PAF(2), PAF(3)); }
#undef PKW
#undef PAF
#undef VFR
#undef PIN
#undef MX3
#undef GAPA
#undef GAPB
#undef EX
#undef VRD
#undef KRD
#undef STEP
#undef ENDW
    { auto rr = __builtin_amdgcn_permlane32_swap(__float_as_uint(l_reg), __float_as_uint(l_reg), false, false); l_reg = __uint_as_float(rr[0]) + __uint_as_float(rr[1]); }
    if (hi == 0) wsf[32 + r32] = l_reg; asm volatile("s_waitcnt lgkmcnt(0)" ::: "memory");
    float rli[16];
#pragma unroll
    for (int r = 0; r < 16; ++r) rli[r] = __builtin_amdgcn_rcpf(wsf[32 + crow(r, hi)]);
    h16* Ow = O + (rowbase + q0 + wid * QBLK) * DMP + h * D;
    const h16* Gw = G + (rowbase + q0 + wid * QBLK) * DMP + h * D;
    { h16* stg = (h16*)(shm + LDS_OST) + wid * 2048;
#pragma unroll
      for (int r = 0; r < 16; ++r) { const int orow = crow(r, hi);
#pragma unroll
        for (int d0 = 0; d0 < 2; ++d0) stg[orow * 64 + d0 * 32 + r32] = (h16)(o[d0][r] * rli[r]); }
      asm volatile("s_waitcnt lgkmcnt(0)" ::: "memory");
#pragma unroll
      for (int i = 0; i < 4; ++i) { const int row = i * 8 + (lane >> 3), ch = lane & 7; const f16x8 v = *(const f16x8*)(stg + row * 64 + ch * 8); const f16x8 g = *(const f16x8*)(Gw + (long)row * DMP + ch * 8);
        float r8[8];
#pragma unroll
        for (int e = 0; e < 8; ++e) { const float gg = (float)g[e]; r8[e] = (float)v[e] * __builtin_amdgcn_rcpf(1.0f + __builtin_amdgcn_exp2f(-gg * LOG2E)); }
        u32x4 w; w.x = pk2h(r8[0], r8[1]); w.y = pk2h(r8[2], r8[3]); w.z = pk2h(r8[4], r8[5]); w.w = pk2h(r8[6], r8[7]);
        *(u32x4*)(Ow + (long)row * DMP + ch * 8) = w; } }
    asm volatile("s_waitcnt lgkmcnt(0)\n\ts_barrier" ::: "memory");
#undef DMA_K
#undef DMA_V
#undef CMASK
#undef START
#undef RESC
#undef ROT
#undef QE
#undef KE
#undef SETM
}
#undef SBAR
#undef WAIT_BAR
#undef MF16
#undef MF8
}
constexpr int NWAVES = 8;
#ifndef MK_N_LAUNCHES
#define MK_N_LAUNCHES 1
#endif
constexpr int NPHASE = 2 + 8 * DEPTH;
constexpr size_t MiB = 1u << 20;
constexpr size_t WS_CTL = 0, CTL_ZERO_BYTES = 1 * MiB;
constexpr size_t SZ_WFOX = (size_t)4096 * 1024 * 2, SZ_WFO = (size_t)1024 * 1024 * 2, SZ_WRET = (size_t)6144 * 1024 * 2, SZ_WRO = (size_t)1024 * 2048 * 2;
constexpr size_t SZ_WGU = (size_t)1024 * 1024 * 2, SZ_WD = (size_t)1024 * 512 * 2;
constexpr size_t WS_WFOX = 1 * MiB, WS_WFO = WS_WFOX + 2 * SZ_WFOX, WS_WRET = WS_WFO + 2 * SZ_WFO, WS_WRO = WS_WRET + 2 * SZ_WRET;
constexpr size_t WS_WGU = WS_WRO + 2 * SZ_WRO, WS_WD = WS_WGU + (size_t)DEPTH * NE * SZ_WGU, WS_WEND = WS_WD + (size_t)DEPTH * NE * SZ_WD;
constexpr size_t SZ_RW = (size_t)32 * 64 * 24 * 2, SZ_FW = (size_t)32 * 64 * 8 * 2;
constexpr size_t WS_RW = WS_WEND, WS_FW = WS_RW + DEPTH * SZ_RW, WS_ROPE = WS_FW + 2 * SZ_FW;
constexpr size_t WS_H = WS_ROPE + 2 * (size_t)SEQ * 128 * 4;
constexpr size_t WS_HN = WS_H + (size_t)T * DM * 4;
constexpr size_t WS_RSTD = WS_HN + (size_t)(T + 8) * DM * 2;
constexpr size_t WS_FLOG = WS_RSTD + (size_t)T * 4, WS_CUM = WS_FLOG + (size_t)T * 16 * 4;
constexpr size_t WS_EID = WS_CUM + (size_t)BATCH * FOX_H * SEQ * 4, WS_RANK = WS_EID + PAIRS * 4, WS_GATE = WS_RANK + PAIRS * 4, WS_LIST = WS_GATE + PAIRS * 4;
constexpr size_t WS_QKVG = (WS_LIST + (size_t)NE * LISTCAP * 4 + 255) & ~(size_t)255;
constexpr size_t SZ_T1K = (size_t)T * 1024 * 2;
constexpr size_t WS_OG = WS_QKVG + 6 * SZ_T1K;
constexpr size_t WS_RO = WS_OG + 2 * SZ_T1K;
constexpr size_t WS_END0 = WS_RO + 2 * SZ_T1K;
constexpr size_t WS_DUMMY = WS_END0;
constexpr size_t WS_END = WS_DUMMY + 160 * MiB;
constexpr size_t WS_Y = WS_QKVG;
constexpr size_t WS_ACT = WS_RO;
static_assert((size_t)PROWS * 1024 * 2 <= 6 * SZ_T1K && (size_t)PROWS * 512 * 2 <= 2 * SZ_T1K, "overlays");
constexpr int CW_TMO = 0, CW_BAR = 4096, CW_CNT = 16384, CW_CNT2 = 16384 + 1024;
constexpr int RING_BYTES = 147456;
constexpr int LDSCTL_OFF = RING_BYTES, MISC_OFF = LDSCTL_OFF;
constexpr int LDS_BYTES = RING_BYTES + 1024;

typedef GAS unsigned gu32;
__device__ __forceinline__ int lane_id_() { return (int)__builtin_amdgcn_mbcnt_hi(~0u, __builtin_amdgcn_mbcnt_lo(~0u, 0u)); }
#define TID0() (wave_sgpr == 0 && lane_id_() == 0)
#define RLX_AGENT __ATOMIC_RELAXED, __HIP_MEMORY_SCOPE_AGENT
#define LDS_WAIT() asm volatile("s_waitcnt lgkmcnt(0)" ::: "memory")

#define XB_TMO      128
#define XB_XCNT(j)  (256  + 64 * (j))
#define XB_XSUB(j)  (1280 + 64 * (j))
#define XB_XGEN(j)  (2304 + 64 * (j))
#define XB_TOP      3328
#define XB_TOPGEN   3392
#define XCD_BAR_WORDS 3456
#define XB_SPIN_CAP (1u << 18)
__device__ __forceinline__ unsigned xb_ld(unsigned* p)              { return __hip_atomic_load(p, __ATOMIC_RELAXED, __HIP_MEMORY_SCOPE_AGENT); }
__device__ __forceinline__ unsigned xb_add(unsigned* p, unsigned v) { return __hip_atomic_fetch_add(p, v, __ATOMIC_RELAXED, __HIP_MEMORY_SCOPE_AGENT); }
__device__ __forceinline__ unsigned xb_xcc_id() { return (unsigned)__builtin_amdgcn_s_getreg((3 << 11) | 20) & 0xFu; }
#define XB_SPIN(cond, bar) do { unsigned _sp = 0; while (cond) { __builtin_amdgcn_s_sleep(1); \
    if ((++_sp & 255u) == 0u) { if (xb_ld(&(bar)[XB_TMO])) break; if (_sp > XB_SPIN_CAP) { atomicAdd(&(bar)[XB_TMO], 1u); break; } } } } while (0)
struct XcdBarrier { unsigned* bar; unsigned x; volatile LAS unsigned* st; };
__device__ __forceinline__ XcdBarrier xcd_barrier_post(unsigned* bar, volatile LAS unsigned* st, const int wave_sgpr) {
    XcdBarrier b; b.bar = bar; b.x = xb_xcc_id(); b.st = st;
    if (TID0()) (void)xb_add(&bar[XB_XCNT(b.x)], 1u);
    return b;
}
__device__ __forceinline__ void xcd_barrier_complete(unsigned* bar, unsigned x, unsigned& nloc, unsigned& nx) {
    const unsigned G = gridDim.x * gridDim.y * gridDim.z;
    unsigned sum, cnt, mine, sp = 0u;
    for (;;) {
        sum = 0u; cnt = 0u; mine = 0u;
#pragma unroll
        for (unsigned j = 0; j < 16; ++j) { const unsigned c = xb_ld(&bar[XB_XCNT(j)]); sum += c; cnt += (c > 0u) ? 1u : 0u; mine = (j == x) ? c : mine; }
        if (sum == G) break;
        __builtin_amdgcn_s_sleep(1);
        if ((++sp & 255u) == 0u) { if (xb_ld(&bar[XB_TMO])) break; if (sp > XB_SPIN_CAP) { atomicAdd(&bar[XB_TMO], 1u); break; } }
    }
    nloc = mine > 0u ? mine : 1u; nx = cnt > 0u ? cnt : 1u;
}
__device__ __forceinline__ void xcd_barrier(const XcdBarrier& b, const bool leader) {
    asm volatile("s_waitcnt vmcnt(0)" ::: "memory");
    __syncthreads();
    if (leader) {
        unsigned* bar = b.bar;
        __builtin_amdgcn_s_waitcnt(0);
        unsigned nloc = b.st[0], nx = b.st[1];
        if (nloc == 0u) { xcd_barrier_complete(bar, b.x, nloc, nx); b.st[0] = nloc; b.st[1] = nx; }
        const unsigned old = xb_add(&bar[XB_XSUB(b.x)], 1u);
        const unsigned gen = old / nloc;
        if (old + 1u == (gen + 1u) * nloc) {
            __builtin_amdgcn_fence(__ATOMIC_RELEASE, "agent");
            asm volatile("s_waitcnt vmcnt(0)" ::: "memory");
            const unsigned og = xb_add(&bar[XB_TOP], 1u);
            const unsigned tg = og / nx;
            if (og + 1u == (tg + 1u) * nx) xb_add(&bar[XB_TOPGEN], 1u);
            else XB_SPIN(xb_ld(&bar[XB_TOPGEN]) == tg, bar);
            __builtin_amdgcn_fence(__ATOMIC_ACQUIRE, "agent");
            xb_add(&bar[XB_XGEN(b.x)], 1u);
            asm volatile("s_waitcnt vmcnt(0)" ::: "memory");
        } else {
            XB_SPIN(xb_ld(&bar[XB_XGEN(b.x)]) == gen, bar);
            __builtin_amdgcn_fence(__ATOMIC_ACQUIRE, "agent");
            asm volatile("s_waitcnt vmcnt(0)" ::: "memory");
        }
    }
    __syncthreads();
}

struct Args { const float* in[16]; float* out; unsigned char* ws; int ph_lo, ph_hi, li, pad; };

template <bool GU>
__device__ __forceinline__ void transpose_item(const float* W, int K, int ld, h16* WT, LAS float* scr, int kb, int nb, int lane) {
    const int k0 = 64 * kb, n0 = 64 * nb;
    const int lc = (lane & 15) * 4;
    const int srccol = GU ? ((lc < 32) ? (n0 / 2 + lc) : (512 + n0 / 2 + (lc - 32))) : (n0 + lc);
#pragma unroll 4
    for (int it = 0; it < 16; ++it) { const int kk = 4 * it + (lane >> 4);
        const f32x4 v = *(const f32x4*)(W + (size_t)(k0 + kk) * ld + srccol);
        scr[kk * 65 + lc + 0] = v[0]; scr[kk * 65 + lc + 1] = v[1]; scr[kk * 65 + lc + 2] = v[2]; scr[kk * 65 + lc + 3] = v[3]; }
    LDS_WAIT(); asm volatile("" ::: "memory");
    const int c = lane & 7;
#pragma unroll
    for (int j = 0; j < 8; ++j) { const int nn = 8 * j + (lane >> 3);
        const int cc = GU ? (((nn & 7) < 4) ? (4 * (nn >> 3) + (nn & 7)) : (32 + 4 * (nn >> 3) + ((nn & 7) - 4))) : nn;
        const LAS float* s = scr + (8 * c) * 65 + cc;
        u32x4 o; o.x = pk2h(s[0 * 65], s[1 * 65]); o.y = pk2h(s[2 * 65], s[3 * 65]); o.z = pk2h(s[4 * 65], s[5 * 65]); o.w = pk2h(s[6 * 65], s[7 * 65]);
        *(GAS u32x4*)(WT + (size_t)(n0 + nn) * K + k0 + 8 * c) = o; }
    LDS_WAIT(); asm volatile("" ::: "memory");
}

__device__ __forceinline__ float shfl_idx(float v, int src) { return __int_as_float(__builtin_amdgcn_ds_bpermute(src << 2, __float_as_int(v))); }
__device__ __forceinline__ float wave_sum(float v, int lane) {
#pragma unroll
    for (int o = 1; o < 64; o <<= 1) v += shfl_idx(v, lane ^ o);
    return v;
}
__device__ __forceinline__ void rope_cs(int pos, int m, float& c, float& s) {
    const float e = -(float)m * (13.287712379549449f / 127.0f);
    const float inv = exp2f(e);
    const float ang = (float)pos * inv;
    const float k = rintf(ang * 0.6366197723675814f);
    float r = fmaf(-k, 1.5703125f, ang); r = fmaf(-k, 4.837512969970703125e-4f, r); r = fmaf(-k, 7.54978995489188216e-8f, r);
    const float z = r * r;
    const float sp = fmaf(r * z, fmaf(z, fmaf(z, -1.9515295891e-4f, 8.3321608736e-3f), -1.6666654611e-1f), r);
    const float cp = fmaf(z * z, fmaf(z, fmaf(z, 2.443315711809948e-5f, -1.388731625493765e-3f), 4.166664568298827e-2f), fmaf(z, -0.5f, 1.0f));
    const int q = ((int)k) & 3;
    c = (q == 0) ? cp : (q == 1) ? -sp : (q == 2) ? -cp : sp;
    s = (q == 0) ? sp : (q == 1) ? cp : (q == 2) ? -sp : -cp;
}
#ifndef PROBE_AMP2
#define PROBE_AMP2 8
#endif
#if defined(PROBE_A) && defined(PROBE_B)
#define PROBE_MARK(id) do { if ((id) == PROBE_A || (id) == PROBE_B) { if (blockIdx.x == 0 && __builtin_amdgcn_readfirstlane(threadIdx.x) == 0 && lane_id_() == 0) { \
    volatile LAS unsigned* pm_ = (volatile LAS unsigned*)(size_t)(MISC_OFF + 800); if ((id) == PROBE_A) pm_[0] = (unsigned)__builtin_amdgcn_s_memrealtime(); if ((id) == PROBE_B) pm_[1] = (unsigned)__builtin_amdgcn_s_memrealtime(); } } } while (0)
#else
#define PROBE_MARK(id) do {} while (0)
#endif
struct RowArgs {
    const float* src; float* h; h16* hn; float* rstd; const float* gnorm;
    const h16* y; const int* eidp; const int* rankp; const float* gatep;
    const h16* tabh; const float* bias0; const float* bias1; float* flog;
    int* eid; int* rank; float* gate; unsigned* counts; int* list;
};
template <bool COMBINE, bool STORE_H, int NT_>
__device__ __forceinline__ void row_pass(const RowArgs& A, int g, bool valid, int lane, int ch, int wave, LAS float* xch, LAS float* scr, LAS unsigned* blk, const volatile LAS unsigned* padstart) {
    const int r = lane & 15, kq = lane >> 4; const int t = 16 * g + r;
    constexpr int NA = NT_ > 0 ? NT_ : 1;
    f32x4 acc[NA];
#pragma unroll
    for (int i = 0; i < NA; ++i) acc[i] = (f32x4){0.f, 0.f, 0.f, 0.f};
    float ss = 0.f; float bia[NA];
#pragma unroll
    for (int i = 0; i < NA; ++i) bia[i] = 0.f;
    if (NT_ == 3) { if (wave == 0) blk[lane] = 0u; }
    if (NT_ == 3) PROBE_MARK(61);
    if (valid) {
        if (NT_ == 1) bia[0] = A.bias0[r];
        if (NT_ == 3) { bia[0] = A.bias1[r]; bia[1] = A.bias1[16 + r]; bia[2] = A.bias0[r & 3]; }
        const float* srow = A.src + (size_t)t * DM + 8 * kq + 512 * ch; float* hrow = A.h + (size_t)t * DM + 8 * kq + 512 * ch; h16* nrow = A.hn + (size_t)t * DM + 8 * kq + 512 * ch;
        const h16* y0 = nullptr; const h16* y1 = nullptr; float g0 = 0.f, g1 = 0.f;
        if (COMBINE) { const int e0 = A.eidp[2 * t], e1 = A.eidp[2 * t + 1]; const int p0 = (int)padstart[e0] + A.rankp[2 * t], p1 = (int)padstart[e1] + A.rankp[2 * t + 1];
            g0 = A.gatep[2 * t]; g1 = A.gatep[2 * t + 1]; y0 = A.y + (size_t)p0 * DM + 8 * kq + 512 * ch; y1 = A.y + (size_t)p1 * DM + 8 * kq + 512 * ch; }
        const float* gnp = A.gnorm + 8 * kq + 512 * ch;
        const h16* tabp = A.tabh + ((size_t)(16 * ch) * 64 + lane) * (8 * NA);
#pragma unroll 4
        for (int it = 0; it < 16; ++it) {
            f32x4 v0 = *(const f32x4*)(srow + 32 * it), v1 = *(const f32x4*)(srow + 32 * it + 4);
            if (COMBINE) { const f16x8 a = *(const f16x8*)(y0 + 32 * it), b = *(const f16x8*)(y1 + 32 * it);
#pragma unroll
                for (int q = 0; q < 4; ++q) { v0[q] += (float)a[q] * g0 + (float)b[q] * g1; v1[q] += (float)a[4 + q] * g0 + (float)b[4 + q] * g1; } }
            if (STORE_H) { *(f32x4*)(hrow + 32 * it) = v0; *(f32x4*)(hrow + 32 * it + 4) = v1; }
            ss += (v0[0] * v0[0] + v0[1] * v0[1]) + (v0[2] * v0[2] + v0[3] * v0[3]) + (v1[0] * v1[0] + v1[1] * v1[1]) + (v1[2] * v1[2] + v1[3] * v1[3]);
            const f32x4 gn0 = *(const f32x4*)(gnp + 32 * it), gn1 = *(const f32x4*)(gnp + 32 * it + 4);
            const f32x4 a0 = v0 * gn0, a1 = v1 * gn1;
            u32x4 w; w.x = pk2h(a0[0], a0[1]); w.y = pk2h(a0[2], a0[3]); w.z = pk2h(a1[0], a1[1]); w.w = pk2h(a1[2], a1[3]);
            *(u32x4*)(nrow + 32 * it) = w;
            if (NT_ > 0) {
                const h16* tp = tabp + (size_t)it * 64 * 8 * NA;
                const f16x8 af = __builtin_bit_cast(f16x8, w);
#pragma unroll
                for (int tl = 0; tl < NT_; ++tl) acc[tl] = __builtin_amdgcn_mfma_f32_16x16x32_f16(af, *(const f16x8*)(tp + 8 * tl), acc[tl], 0, 0, 0);
            }
        }
        ss += shfl_idx(ss, lane ^ 16); ss += shfl_idx(ss, lane ^ 32);
        if (NT_ == 3) PROBE_MARK(62);
        if (ch == 1) { xch[lane] = ss;
#pragma unroll
            for (int tl = 0; tl < NT_; ++tl)
#pragma unroll
                for (int q = 0; q < 4; ++q) xch[64 * (1 + 4 * tl + q) + lane] = acc[tl][q]; }
    }
    __syncthreads();
    if (NT_ == 3) PROBE_MARK(63);
    int e0 = 0, e1 = 0, lr0 = 0, lr1 = 0; float ga = 0.f, gb = 0.f;
    if (valid && ch == 0) {
        ss += xch[lane];
#pragma unroll
        for (int tl = 0; tl < NT_; ++tl)
#pragma unroll
            for (int q = 0; q < 4; ++q) acc[tl][q] += xch[64 * (1 + 4 * tl + q) + lane];
        const float rs = 1.0f / sqrtf(ss * (1.0f / DM) + EPS);
        if (kq == 0) A.rstd[t] = rs;
        if (NT_ > 0) {
            float rst[4];
#pragma unroll
            for (int q = 0; q < 4; ++q) rst[q] = shfl_idx(rs, 4 * kq + q);
            if (NT_ == 1) {
#pragma unroll
                for (int q = 0; q < 4; ++q) A.flog[(size_t)(16 * g + 4 * kq + q) * 16 + r] = acc[0][q] * rst[q] + bia[0];
            } else {
#pragma unroll
                for (int tl = 0; tl < NT_; ++tl)
#pragma unroll
                    for (int q = 0; q < 4; ++q) scr[(4 * kq + q) * 48 + 16 * tl + r] = acc[tl][q] * rst[q] + bia[tl];
                LDS_WAIT(); asm volatile("" ::: "memory");
                if (lane < 16) {
                    const LAS float* sr = scr + r * 48;
                    float gl[4];
#pragma unroll
                    for (int q = 0; q < 4; ++q) gl[q] = sr[32 + q];
                    int gi = 0; float gmax = gl[0];
#pragma unroll
                    for (int q = 1; q < 4; ++q) if (gl[q] > gmax) { gmax = gl[q]; gi = q; }
                    float gs = 0.f;
#pragma unroll
                    for (int q = 0; q < 4; ++q) gs += __expf(gl[q] - gmax);
                    const float pg = 1.0f / gs;
                    float el[8];
#pragma unroll
                    for (int e = 0; e < 8; ++e) el[e] = sr[gi * 8 + e];
                    int i0 = 0; float emax = el[0];
#pragma unroll
                    for (int e = 1; e < 8; ++e) if (el[e] > emax) { emax = el[e]; i0 = e; }
                    int i1 = -1; float b1 = -3.0e38f;
#pragma unroll
                    for (int e = 0; e < 8; ++e) if (e != i0 && el[e] > b1) { b1 = el[e]; i1 = e; }
                    const float p1 = __expf(b1 - emax);
                    ga = pg / (1.0f + p1); gb = pg * p1 / (1.0f + p1);
                    e0 = gi * 8 + i0; e1 = gi * 8 + i1;
                    lr0 = (int)__hip_atomic_fetch_add(blk + e0, 1u, __ATOMIC_RELAXED, __HIP_MEMORY_SCOPE_WORKGROUP);
                    lr1 = (int)__hip_atomic_fetch_add(blk + e1, 1u, __ATOMIC_RELAXED, __HIP_MEMORY_SCOPE_WORKGROUP);
                }
            }
        }
    }
    if (NT_ == 3) {
        __syncthreads();
        if (wave == 0 && lane < NE) { const unsigned c = blk[lane]; unsigned base = 0u; if (c) base = atomicAdd(A.counts + lane, c); blk[32 + lane] = base; }
        __syncthreads();
        if (valid && ch == 0 && lane < 16) {
            const int r0 = (int)blk[32 + e0] + lr0, r1 = (int)blk[32 + e1] + lr1;
            A.list[e0 * LISTCAP + r0] = 2 * t; A.list[e1 * LISTCAP + r1] = 2 * t + 1;
            A.eid[2 * t] = e0; A.eid[2 * t + 1] = e1; A.rank[2 * t] = r0; A.rank[2 * t + 1] = r1; A.gate[2 * t] = ga; A.gate[2 * t + 1] = gb;
        }
    }
    if (NT_ == 3) PROBE_MARK(64);
    __syncthreads();
    if (NT_ == 3) PROBE_MARK(65);
}
template <bool COMBINE, bool STORE_H, int NT_>
__device__ __forceinline__ void row_pass_all(const RowArgs& A, int vcu, int G, int wave, int lane, LAS unsigned char* lds, const volatile LAS unsigned* padstart) {
    const int pr = wave & 3, ch = wave >> 2;
    LAS float* xch = (LAS float*)(lds + pr * 4096); LAS float* scr = (LAS float*)(lds + 16384 + pr * 4096); LAS unsigned* blk = (LAS unsigned*)(lds + 32768);
    for (int base = 0; base < T / 16; base += 4 * G) { const int g = base + pr * G + vcu; row_pass<COMBINE, STORE_H, NT_>(A, g, g < T / 16, lane, ch, wave, xch, scr, blk, padstart); }
}
__device__ __forceinline__ void final_row(const float* h, const h16* y, const int* eidp, const int* rankp, const float* gatep, const volatile LAS unsigned* padstart, const float* gf, float* out, int t, int lane) {
    const int e0 = eidp[2 * t], e1 = eidp[2 * t + 1]; const int p0 = (int)padstart[e0] + rankp[2 * t], p1 = (int)padstart[e1] + rankp[2 * t + 1];
    const float g0 = gatep[2 * t], g1 = gatep[2 * t + 1];
    const f32x4* hr = (const f32x4*)(h + (size_t)t * DM) + lane; const f16x4* ya = (const f16x4*)(y + (size_t)p0 * DM) + lane; const f16x4* yb = (const f16x4*)(y + (size_t)p1 * DM) + lane;
    f32x4 v[4]; float s = 0.f;
#pragma unroll
    for (int j = 0; j < 4; ++j) { const f16x4 a = ya[64 * j], b = yb[64 * j]; v[j] = hr[64 * j];
#pragma unroll
        for (int q = 0; q < 4; ++q) v[j][q] += (float)a[q] * g0 + (float)b[q] * g1;
        s += (v[j][0] * v[j][0] + v[j][1] * v[j][1]) + (v[j][2] * v[j][2] + v[j][3] * v[j][3]); }
    const float rs = 1.0f / sqrtf(wave_sum(s, lane) * (1.0f / DM) + EPS);
    f32x4* o = (f32x4*)(out + (size_t)t * DM) + lane;
#pragma unroll
    for (int j = 0; j < 4; ++j) o[64 * j] = v[j] * rs * ((const f32x4*)gf)[lane + 64 * j];
}
__device__ __forceinline__ void ret_gn_item(const h16* ro, const h16* gate, const float* gain, h16* og, int w, int lane) {
    const int t = w >> 2, h = w & 3;
    const f16x8 ov = *(const f16x8*)(ro + (size_t)t * 2048 + h * 512 + lane * 8);
    const f16x8 gv = *(const f16x8*)(gate + (size_t)(h >> 1) * T * 1024 + (size_t)t * 1024 + (h & 1) * 512 + lane * 8);
    float v[8]; float s = 0.f;
#pragma unroll
    for (int j = 0; j < 8; ++j) { v[j] = (float)ov[j]; s += v[j]; }
    const float mu = wave_sum(s, lane) * (1.0f / RET_DV); float q = 0.f;
#pragma unroll
    for (int j = 0; j < 8; ++j) { v[j] -= mu; q += v[j] * v[j]; }
    const float rs = 1.0f / sqrtf(wave_sum(q, lane) * (1.0f / RET_DV) + EPS);
    const f32x4 ga = *(const f32x4*)(gain + h * 512 + lane * 8), gb = *(const f32x4*)(gain + h * 512 + lane * 8 + 4);
    float o[8];
#pragma unroll
    for (int j = 0; j < 8; ++j) { const float gg = (float)gv[j]; const float gn = (j < 4) ? ga[j & 3] : gb[j & 3];
        o[j] = v[j] * rs * gn * gg * __builtin_amdgcn_rcpf(1.0f + __builtin_amdgcn_exp2f(-gg * LOG2E)); }
    u32x4 wv; wv.x = pk2h(o[0], o[1]); wv.y = pk2h(o[2], o[3]); wv.z = pk2h(o[4], o[5]); wv.w = pk2h(o[6], o[7]);
    *(u32x4*)(og + (size_t)t * 2048 + h * 512 + lane * 8) = wv;
}

namespace ret_body {
constexpr int KLP = 528, VLP = 144, RLP = 528;
constexpr int OFF_KL = 0, OFF_VL = 128 * KLP, OFF_VD = OFF_VL + 128 * VLP, OFF_RL = OFF_VD + 128 * VLP, END = OFF_RL + 64 * RLP, OFF_OS = 0;
static_assert(END <= RING_BYTES, "retention LDS");
#define MF16(a, b, c) __builtin_amdgcn_mfma_f32_32x32x16_f16(a, b, c, 0, 0, 0)
__device__ __forceinline__ int crow(int r, int hi) { return (r & 3) + 8 * (r >> 2) + 4 * hi; }
typedef short v4i16_t __attribute__((ext_vector_type(4)));
__device__ __forceinline__ s16x4 vtr(LAS const char* p) { return __builtin_bit_cast(s16x4, __builtin_amdgcn_ds_read_tr16_b64_v4i16((LAS v4i16_t*)p)); }
__device__ __forceinline__ f16x8 mk8(s16x4 lo, s16x4 hi) { typedef short s16x8 __attribute__((ext_vector_type(8))); s16x8 t = {lo[0], lo[1], lo[2], lo[3], hi[0], hi[1], hi[2], hi[3]}; return __builtin_bit_cast(f16x8, t); }
__device__ __forceinline__ f16x8 pack8(const f32x16& S, int b) { u32x4 w; w.x = pk2h(S[b], S[b + 1]); w.y = pk2h(S[b + 2], S[b + 3]); w.z = pk2h(S[b + 4], S[b + 5]); w.w = pk2h(S[b + 6], S[b + 7]); return __builtin_bit_cast(f16x8, w); }
__device__ __forceinline__ void ret_item(int b, int h, int sl, const h16* __restrict__ Qr, const h16* __restrict__ Kr, const h16* __restrict__ Vb, h16* __restrict__ O, LAS unsigned char* lds, const int tid_arg) {
    int tid_in = tid_arg; asm volatile("" : "+v"(tid_in));
    const float lg2 = log2f(1.0f - exp2f(-5.0f - (float)h));
    const float cd = exp2f(128.0f * lg2);
    f32x16 R0 = {}, R1 = {};
    u32x4 kreg[8];
    { const int lane = tid_in & 63, r32 = lane & 31, hi = lane >> 5; const int wi = (tid_in >> 6) & 3; const size_t t0 = (size_t)b * SEQ;
#pragma unroll
      for (int i = 0; i < 8; ++i) { const int p = tid_in + 512 * i, j = p >> 5, c16 = p & 31; kreg[i] = *(const u32x4*)(Kr + (t0 + j) * 1024 + h * 256 + c16 * 8); }
      (void)r32; (void)hi; (void)wi; }
    for (int n = 0; n < SEQ / 128; ++n) {
        int tid = tid_in; asm volatile("" : "+v"(tid));
        const int lane = tid & 63, r32 = lane & 31, hi = lane >> 5; const int wid = __builtin_amdgcn_readfirstlane(tid >> 6);
        const int wi = wid & 3, wj = wid >> 2;
        const bool act_s = !(wj == 1 && wi < 2);
        const int trq = (lane & 15) >> 2, trp = lane & 3, trg = (lane >> 4) & 1;
        const size_t t0 = (size_t)b * SEQ + (size_t)n * 128;
        f16x8 qf[16];
        if (n == 8) PROBE_MARK(71);
        f16x8 vreg[2];
#pragma unroll
        for (int i = 0; i < 2; ++i) { const int p = tid + 512 * i, j = p >> 3, c16 = p & 7; vreg[i] = *(const f16x8*)(Vb + (t0 + j) * 1024 + c16 * 8); }
        { const h16* qp = Qr + (t0 + 32 * wi + r32) * 1024 + h * 256 + 8 * hi;
#pragma unroll
          for (int s = 0; s < 16; ++s) qf[s] = *(const f16x8*)(qp + 16 * s); }
#pragma unroll
        for (int i = 0; i < 8; ++i) { const int p = tid + 512 * i, j = p >> 5, c16 = p & 31; *(LAS u32x4*)(lds + OFF_KL + j * KLP + c16 * 16) = kreg[i]; }
#pragma unroll
        for (int i = 0; i < 2; ++i) { const int p = tid + 512 * i, j = p >> 3, c16 = p & 7; const f16x8 v = vreg[i];
            *(LAS f16x8*)(lds + OFF_VL + j * VLP + c16 * 16) = v;
            const float kd = __builtin_amdgcn_exp2f(lg2 * (float)(127 - j));
            u32x4 w; w.x = pk2h((float)v[0] * kd, (float)v[1] * kd); w.y = pk2h((float)v[2] * kd, (float)v[3] * kd); w.z = pk2h((float)v[4] * kd, (float)v[5] * kd); w.w = pk2h((float)v[6] * kd, (float)v[7] * kd);
            *(LAS u32x4*)(lds + OFF_VD + j * VLP + c16 * 16) = w; }
        __syncthreads();
        if (n == 8) PROBE_MARK(72);
        f16x8 sf[2][2];
        {
            f32x16 S0 = {}, S1 = {};
            if (act_s) {
                const LAS unsigned char* kp = lds + OFF_KL + (64 * wj + r32) * KLP + 16 * hi;
#pragma unroll
                for (int s = 0; s < 16; ++s) { const f16x8 a0 = *(const LAS f16x8*)(kp + 32 * s), a1 = *(const LAS f16x8*)(kp + 32 * KLP + 32 * s);
                    S0 = MF16(a0, qf[s], S0); S1 = MF16(a1, qf[s], S1); if ((s & 1) == 1) __builtin_amdgcn_sched_barrier(0); }
                const int ig = 32 * wi + r32;
#pragma unroll
                for (int r = 0; r < 16; ++r) { const int j0 = 64 * wj + crow(r, hi), j1 = j0 + 32;
                    S0[r] = (ig >= j0) ? S0[r] * __builtin_amdgcn_exp2f(lg2 * (float)(ig - j0)) : 0.f;
                    S1[r] = (ig >= j1) ? S1[r] * __builtin_amdgcn_exp2f(lg2 * (float)(ig - j1)) : 0.f; }
            }
            sf[0][0] = pack8(S0, 0); sf[0][1] = pack8(S0, 8); sf[1][0] = pack8(S1, 0); sf[1][1] = pack8(S1, 8);
        }
        __builtin_amdgcn_sched_barrier(0);
        if (n + 1 < SEQ / 128) {
            const size_t t1 = t0 + 128;
#pragma unroll
            for (int i = 0; i < 8; ++i) { const int p = tid + 512 * i, j = p >> 5, c16 = p & 31; kreg[i] = *(const u32x4*)(Kr + (t1 + j) * 1024 + h * 256 + c16 * 8); }
        }
        __builtin_amdgcn_sched_barrier(0);
        if (n == 8) PROBE_MARK(73);
        f32x16 OT0 = {}, OT1 = {};
        if (n > 0) {
            const LAS unsigned char* rp = lds + OFF_RL + r32 * RLP + 16 * hi + 256 * wj;
            if (wj == 0) {
#pragma unroll
                for (int s = 0; s < 8; ++s) { const f16x8 a0 = *(const LAS f16x8*)(rp + 32 * s), a1 = *(const LAS f16x8*)(rp + 32 * RLP + 32 * s);
                    OT0 = MF16(a0, qf[s], OT0); OT1 = MF16(a1, qf[s], OT1); if ((s & 3) == 3) __builtin_amdgcn_sched_barrier(0); }
            } else {
#pragma unroll
                for (int s = 0; s < 8; ++s) { const f16x8 a0 = *(const LAS f16x8*)(rp + 32 * s), a1 = *(const LAS f16x8*)(rp + 32 * RLP + 32 * s);
                    OT0 = MF16(a0, qf[8 + s], OT0); OT1 = MF16(a1, qf[8 + s], OT1); if ((s & 3) == 3) __builtin_amdgcn_sched_barrier(0); }
            }
            const float qd = __builtin_amdgcn_exp2f(lg2 * (float)(32 * wi + r32 + 1));
#pragma unroll
            for (int r = 0; r < 16; ++r) { OT0[r] *= qd; OT1[r] *= qd; }
        }
        __builtin_amdgcn_sched_barrier(0);

        if (act_s) {
#pragma unroll
            for (int jt = 0; jt < 2; ++jt)
#pragma unroll
                for (int s2 = 0; s2 < 2; ++s2) {
                    const int jb = 64 * wj + 32 * jt + 16 * s2 + 4 * hi + trq;
                    const LAS char* vp = (const LAS char*)(lds + OFF_VL + jb * VLP + (16 * trg + 4 * trp) * 2);
                    const f16x8 v0 = mk8(vtr(vp), vtr(vp + 8 * VLP)), v1 = mk8(vtr(vp + 64), vtr(vp + 64 + 8 * VLP));
                    OT0 = MF16(v0, sf[jt][s2], OT0); OT1 = MF16(v1, sf[jt][s2], OT1); }
        }
        __builtin_amdgcn_sched_barrier(0);
        if (n == 8) PROBE_MARK(74);
#pragma unroll
        for (int r = 0; r < 16; ++r) { R0[r] *= cd; R1[r] *= cd; }
#pragma unroll
        for (int s = 0; s < 8; ++s) {
            const int jb = 16 * s + 8 * hi + trq;
            const LAS char* kp = (const LAS char*)(lds + OFF_KL + jb * KLP + (32 * wid + 16 * trg + 4 * trp) * 2);
            const LAS char* vp = (const LAS char*)(lds + OFF_VD + jb * VLP + (16 * trg + 4 * trp) * 2);
            const f16x8 ka = mk8(vtr(kp), vtr(kp + 4 * KLP));
            const f16x8 v0 = mk8(vtr(vp), vtr(vp + 4 * VLP)), v1 = mk8(vtr(vp + 64), vtr(vp + 64 + 4 * VLP));
            R0 = MF16(ka, v0, R0); R1 = MF16(ka, v1, R1); if ((s & 1) == 1) __builtin_amdgcn_sched_barrier(0); }
        if (n == 8) PROBE_MARK(75);
        __syncthreads();
        if (n == 8) PROBE_MARK(76);
        {
#pragma unroll
            for (int g4 = 0; g4 < 4; ++g4) {
                u32x2 w; w.x = pk2h(R0[4 * g4], R0[4 * g4 + 1]); w.y = pk2h(R0[4 * g4 + 2], R0[4 * g4 + 3]);
                *(LAS u32x2*)(lds + OFF_RL + r32 * RLP + (32 * wid + 8 * g4 + 4 * hi) * 2) = w;
                w.x = pk2h(R1[4 * g4], R1[4 * g4 + 1]); w.y = pk2h(R1[4 * g4 + 2], R1[4 * g4 + 3]);
                *(LAS u32x2*)(lds + OFF_RL + (32 + r32) * RLP + (32 * wid + 8 * g4 + 4 * hi) * 2) = w; }
            LAS float* os = (LAS float*)(lds + OFF_OS) + wid * 1024 + lane;
#pragma unroll
            for (int r = 0; r < 16; ++r) os[64 * r] = wj ? OT0[r] : OT1[r];
        }
        __syncthreads();
        {
            const LAS float* os = (const LAS float*)(lds + OFF_OS) + (wid ^ 4) * 1024 + lane;
            h16* op = O + (t0 + 32 * wi + r32) * 2048 + h * 512 + sl * 64 + 32 * wj + 4 * hi;
#pragma unroll
            for (int g4 = 0; g4 < 4; ++g4) { float f[4];
#pragma unroll
                for (int q = 0; q < 4; ++q) f[q] = (wj ? OT1[4 * g4 + q] : OT0[4 * g4 + q]) + os[64 * (4 * g4 + q)];
                u32x2 w; w.x = pk2h(f[0], f[1]); w.y = pk2h(f[2], f[3]); *(u32x2*)(op + 8 * g4) = w; }
        }
        if (n == 8) PROBE_MARK(77);
        __syncthreads();
        if (n == 8) PROBE_MARK(78);
    }
}
#undef MF16
}

template <bool GATHER_> struct MoeOrderT {
    static constexpr bool GATHER = GATHER_;
    const volatile LAS unsigned* cnt; const volatile LAS unsigned* tstart; int G, c, K; const char* A; const char* Bt; size_t bstride; const int* list;
    __device__ bool next(int i, pg8::Unit& u) const {
        const int NTt = __builtin_amdgcn_readfirstlane((int)tstart[NE]); const long L = (long)i * G + c; if (L >= (long)NTt * 4) return false;
        const int mtg = (int)(L >> 2); int e = 0;
        while (e < NE - 1 && mtg >= __builtin_amdgcn_readfirstlane((int)tstart[e + 1])) ++e;
        u.pm = mtg; u.pn = (int)(L & 3); u.e = e; u.mt = mtg - __builtin_amdgcn_readfirstlane((int)tstart[e]); return true;
    }
    __device__ __forceinline__ const char* abase() const { return A; }
    __device__ __forceinline__ void aoff(const pg8::Unit& u, const int (&R)[2], const int (&C)[2], unsigned (&ao)[2][2]) const {
        const int cn = (int)cnt[u.e];
#pragma unroll
        for (int h = 0; h < 2; ++h)
#pragma unroll
            for (int i = 0; i < 2; ++i) { const int rank = u.mt * 256 + h * 128 + R[i]; int row = T; if (rank < cn) row = list[u.e * LISTCAP + rank] >> 1;
                ao[h][i] = (unsigned)(((size_t)row * K + C[i]) * 2); }
    }
    __device__ __forceinline__ const char* bbase(const pg8::Unit& u) const { return Bt + (size_t)u.e * bstride + (size_t)u.pn * 256 * K * 2; }
};
__device__ __forceinline__ void moe_setup(volatile LAS unsigned* MISC, const unsigned* counts, const int tid) {
    __syncthreads();
    if (tid < NE) MISC[16 + tid] = __hip_atomic_load(counts + tid, RLX_AGENT);
    __syncthreads();
    if (tid == 0) { unsigned a = 0; for (int e = 0; e < NE; ++e) { MISC[48 + e] = a; MISC[96 + e] = a * 256u; a += (MISC[16 + e] + 255u) >> 8; } MISC[48 + NE] = a; }
    __syncthreads();
}

__global__ void __launch_bounds__(NWAVES * 64, 2) mk_fwd(Args args) {
    extern __shared__ __attribute__((aligned(16))) unsigned char lds_raw[];
    LAS unsigned char* lds = (LAS unsigned char*)lds_raw;
    volatile LAS unsigned* MISC = (volatile LAS unsigned*)(lds + MISC_OFF);
    const int G = gridDim.x; const int bx = blockIdx.x; const int vcu = (G % 8 == 0) ? (bx % 8) * (G / 8) + bx / 8 : bx;
    { gu32* ctl0 = (gu32*)(args.ws + WS_CTL);
      for (int u = threadIdx.x; u < (LDS_BYTES - LDSCTL_OFF) / 4; u += NWAVES * 64) ((LAS unsigned*)(lds + LDSCTL_OFF))[u] = 0u;
      __syncthreads();
      (void)ctl0; }
    XcdBarrier bar; bar.bar = (unsigned*)((gu32*)(args.ws + WS_CTL) + CW_BAR) + args.li * XCD_BAR_WORDS; bar.x = 0; bar.st = nullptr;
    const bool use_bar = (args.ph_hi - args.ph_lo) > 1;
    const int wave_sgpr = __builtin_amdgcn_readfirstlane(threadIdx.x >> 6);
    if (use_bar) bar = xcd_barrier_post((unsigned*)((gu32*)(args.ws + WS_CTL) + CW_BAR) + args.li * XCD_BAR_WORDS, MISC + 8, wave_sgpr);
#ifndef PROBE_DUP
#define PROBE_DUP -1
#endif
#ifdef PROBE_T
#ifndef PROBE_AMP
#define PROBE_AMP 8
#endif
    unsigned long long probe_t0 = __builtin_amdgcn_s_memrealtime(), probe_t1 = probe_t0;
#endif
    for (int pi = args.ph_lo; pi < args.ph_hi; ++pi) {
        const int ph = (PROBE_DUP >= 0 && pi > PROBE_DUP) ? pi - 1 : pi;
        bool did = true; const bool dummy = (PROBE_DUP >= 0 && pi == PROBE_DUP + 1);
        int z32 = 0; asm volatile("" : "+s"(z32));
        int tid = ((wave_sgpr + z32) << 6) | (int)__builtin_amdgcn_mbcnt_hi(~0u, __builtin_amdgcn_mbcnt_lo(~0u, (unsigned)z32)); asm volatile("" : "+v"(tid));
        size_t zoff = 0; asm volatile("" : "+s"(zoff));
        unsigned char* ws = (unsigned char*)(GAS unsigned char*)(*(unsigned char* const __attribute__((address_space(4)))*)((const __attribute__((address_space(4))) char*)__builtin_amdgcn_kernarg_segment_ptr() + zoff + 136));
        const int lane = tid & 63, wave = __builtin_amdgcn_readfirstlane(tid >> 6);
        gu32* ctl = (gu32*)(ws + WS_CTL);
        const __attribute__((address_space(4))) char* ka = (const __attribute__((address_space(4))) char*)__builtin_amdgcn_kernarg_segment_ptr() + zoff;
#define ARG_IN(i) ((const float*)(const GAS float*)(*(const float* const __attribute__((address_space(4)))*)(ka + 8 * (i))))
        const float* x = ARG_IN(0); const float* fox_w_in = ARG_IN(1); const float* fox_b_f = ARG_IN(2); const float* fox_w_out = ARG_IN(3);
        const float* ret_w_in = ARG_IN(4); const float* ret_gn = ARG_IN(5); const float* ret_w_out = ARG_IN(6);
        const float* norm_mix = ARG_IN(7); const float* norm_ffn = ARG_IN(8);
        const float* rg_w = ARG_IN(9); const float* rg_b = ARG_IN(10); const float* re_w = ARG_IN(11); const float* re_b = ARG_IN(12);
        const float* w_gu = ARG_IN(13); const float* w_down = ARG_IN(14); const float* norm_final = ARG_IN(15);
        float* const outp = (float*)(GAS float*)(*(float* const __attribute__((address_space(4)))*)(ka + 128));
        h16* WfoxT = (h16*)(ws + WS_WFOX); h16* WfoT = (h16*)(ws + WS_WFO); h16* WretT = (h16*)(ws + WS_WRET); h16* WroT = (h16*)(ws + WS_WRO); h16* WguT = (h16*)(ws + WS_WGU); h16* WdT = (h16*)(ws + WS_WD);
        h16* RW = (h16*)(ws + WS_RW); h16* FW = (h16*)(ws + WS_FW); float* ctab = (float*)(ws + WS_ROPE); float* stab = ctab + SEQ * 128;
        float* H = (float*)(ws + WS_H); h16* HN = (h16*)(ws + WS_HN); float* RSTD = (float*)(ws + WS_RSTD); float* FLOG = (float*)(ws + WS_FLOG); float* CUM = (float*)(ws + WS_CUM);
        int* EID = (int*)(ws + WS_EID); int* RANK = (int*)(ws + WS_RANK); float* GATE = (float*)(ws + WS_GATE); int* LIST = (int*)(ws + WS_LIST);
        h16* QKVG = (h16*)(ws + WS_QKVG); h16* OG = (h16*)(ws + WS_OG); h16* RO = (h16*)(ws + WS_RO); h16* Y = (h16*)(ws + WS_Y); h16* ACT = (h16*)(ws + WS_ACT);
        unsigned* COUNTS = (unsigned*)(ctl + CW_CNT);
        const int gw = vcu * NWAVES + wave, NGW = G * NWAVES;

        if (ph == 0) {
            LAS float* scr = (LAS float*)(lds + wave * 16640);
            constexpr int I_FOX = 2 * 16 * 64, I_FO = 2 * 16 * 16, I_RET = 2 * 16 * 96, I_RO = 2 * 32 * 16, I_GU = DEPTH * NE * 16 * 16, I_D = DEPTH * NE * 8 * 16;
            constexpr int NITEMS = I_FOX + I_FO + I_RET + I_RO + I_GU + I_D;
            _Pragma("unroll 1") for (int it = gw; it < NITEMS; it += NGW) {
                int r = it;
                if (r < I_FOX) { const int j = r / (16 * 64), q = r % (16 * 64); transpose_item<false>(fox_w_in + (size_t)j * DM * FOX_IN, DM, FOX_IN, WfoxT + (size_t)j * 4096 * 1024, scr, q / 64, q % 64, lane); continue; } r -= I_FOX;
                if (r < I_FO) { const int j = r / 256, q = r % 256; transpose_item<false>(fox_w_out + (size_t)j * DM * DM, DM, DM, WfoT + (size_t)j * 1024 * 1024, scr, q / 16, q % 16, lane); continue; } r -= I_FO;
                if (r < I_RET) { const int j = r / (16 * 96), q = r % (16 * 96); transpose_item<false>(ret_w_in + (size_t)j * DM * RET_IN, DM, RET_IN, WretT + (size_t)j * 6144 * 1024, scr, q / 96, q % 96, lane); continue; } r -= I_RET;
                if (r < I_RO) { const int j = r / 512, q = r % 512; transpose_item<false>(ret_w_out + (size_t)j * 2048 * DM, 2048, DM, WroT + (size_t)j * 1024 * 2048, scr, q / 16, q % 16, lane); continue; } r -= I_RO;
                if (r < I_GU) { const int m = r / 256, q = r % 256; transpose_item<true>(w_gu + (size_t)m * DM * 1024, DM, 1024, WguT + (size_t)m * 1024 * 1024, scr, q / 16, q % 16, lane); continue; } r -= I_GU;
                { const int m = r / 128, q = r % 128; transpose_item<false>(w_down + (size_t)m * EFF * DM, EFF, DM, WdT + (size_t)m * 1024 * 512, scr, q / 16, q % 16, lane); }
            }
            const int gt = vcu * NWAVES * 64 + tid, NGT = G * NWAVES * 64;
            _Pragma("unroll 1") for (int idx = gt; idx < DEPTH * 32 * 64 * 24; idx += NGT) { const int v = idx % 24, ln = (idx / 24) % 64, it = (idx / (24 * 64)) % 32, L = idx / (24 * 64 * 32);
                const int tl = v >> 3, i = v & 7, k = 32 * it + 8 * (ln >> 4) + i, c = ln & 15;
                float val = 0.f; if (tl < 2) val = re_w[((size_t)L * DM + k) * NE + 16 * tl + c]; else if (c < 4) val = rg_w[((size_t)L * DM + k) * NG + c];
                RW[idx] = (h16)val; }
            _Pragma("unroll 1") for (int idx = gt; idx < 2 * 32 * 64 * 8; idx += NGT) { const int i = idx % 8, ln = (idx / 8) % 64, it = (idx / 512) % 32, j = idx / (512 * 32);
                const int k = 32 * it + 8 * (ln >> 4) + i, c = ln & 15; FW[idx] = (h16)fox_w_in[((size_t)j * DM + k) * FOX_IN + 4096 + c]; }
            _Pragma("unroll 1") for (int idx = gt; idx < SEQ * 128; idx += NGT) { const int pos = idx / 128, m = idx % 128;
                float c_, s_; rope_cs(pos, m, c_, s_); ctab[idx] = c_; stab[idx] = s_; }
            _Pragma("unroll 1") for (int idx = gt; idx < DM / 2; idx += NGT) ((unsigned*)(HN + (size_t)T * DM))[idx] = 0u;
        } else if (ph == 1) {
            { RowArgs A{}; A.src = x; A.h = H; A.hn = HN; A.rstd = RSTD; A.gnorm = norm_mix; A.tabh = FW; A.bias0 = fox_b_f; A.flog = FLOG;
                row_pass_all<false, true, 1>(A, vcu, G, wave, lane, lds, nullptr); }
        } else {
            const int L = (ph - 2) >> 3, sub = (ph - 2) & 7, j = L >> 1; const bool fox = (L & 1) == 0;
            if (sub == 0) {
                if (fox) {
                    if (vcu < BATCH * FOX_H) {
                        const int bh = vcu, b = bh / FOX_H, hh = bh % FOX_H; float v[4]; float run = 0.f;
#pragma unroll
                        for (int i = 0; i < 4; ++i) { const float f = FLOG[((size_t)b * SEQ + 4 * tid + i) * 16 + hh]; run += fminf(f, 0.f) - log1pf(__expf(-fabsf(f))); v[i] = run; }
                        float incl = run;
#pragma unroll
                        for (int o = 1; o < 64; o <<= 1) { const float u = shfl_idx(incl, lane >= o ? lane - o : lane); if (lane >= o) incl += u; }
                        LAS float* wt = (LAS float*)lds;
                        if (lane == 63) wt[wave] = incl;
                        __syncthreads();
                        float base = incl - run;
                        for (int w = 0; w < wave; ++w) base += wt[w];
                        f32x4 o4 = {v[0] + base, v[1] + base, v[2] + base, v[3] + base};
                        *(f32x4*)(CUM + (size_t)bh * SEQ + 4 * tid) = o4;
                        __syncthreads();
                    }
                    pg8::StaticOrder S; S.init(HN, WfoxT + (size_t)j * 4096 * 1024, T, 4096, DM, G, bx);
                    pg8::EpiH16 E{QKVG, 1024, 1024, (size_t)T * 1024, RSTD, attn_body::C2, 1.f, 0, nullptr, nullptr};
                    pg8::gemm_phase<pg8::EpiH16, pg8::StaticOrder, true>(lds, DM, S, E, tid);
                } else {
                    pg8::StaticOrder S; S.init(HN, WretT + (size_t)j * 6144 * 1024, T, 6144, DM, G, bx);
                    pg8::EpiH16 E{QKVG, 1024, 1024, (size_t)T * 1024, RSTD, 1.f, 0.0625f, 1, ctab, stab};
                    pg8::gemm_phase<pg8::EpiH16, pg8::StaticOrder, true>(lds, DM, S, E, tid);
                }
            } else if (sub == 1) {
                if (fox) {
                    const h16* Q = QKVG; const h16* K = QKVG + (size_t)T * 1024; const h16* V = QKVG + (size_t)2 * T * 1024; const h16* Gt = QKVG + (size_t)3 * T * 1024;
                    for (int bh = vcu >> 1; bh < BATCH * FOX_H; bh += (G >> 1)) {
                        const int s = vcu & 1;
#pragma unroll 1
                        for (int i = 0; i < 4; ++i) { const int qb = (i == 0) ? s : (i == 1) ? 7 - s : (i == 2) ? 3 - s : 4 + s;
                            int tu = tid; asm volatile("" : "+v"(tu));
                            attn_body::attn_unit<8>(bh / FOX_H, bh % FOX_H, qb, Q, K, V, Gt, CUM, OG, (char*)lds_raw, tu); }
                    }
                } else {
                    for (int item = vcu; item < BATCH * RET_H * 8; item += G) { const int bh = item >> 3, sl = item & 7, b = bh >> 2, hh = bh & 3;
                        const h16* Vb = QKVG + (size_t)(2 + (hh >> 1)) * T * 1024 + (hh & 1) * 512 + sl * 64;
                        ret_body::ret_item(b, hh, sl, QKVG, QKVG + (size_t)T * 1024, Vb, RO, lds, tid); }
                }
            } else if (sub == 2) {
                if (fox) did = false;
                else { _Pragma("unroll 1") for (int w = gw; w < T * RET_H; w += NGW) ret_gn_item(RO, QKVG + (size_t)4 * T * 1024, ret_gn + (size_t)j * 2048, OG, w, lane); }
            } else if (sub == 3) {
                const int Kd = fox ? 1024 : 2048;
                pg8::StaticOrder S; S.init(OG, fox ? (const void*)(WfoT + (size_t)j * 1024 * 1024) : (const void*)(WroT + (size_t)j * 1024 * 2048), T, DM, Kd, G, bx);
                pg8::EpiResid E{dummy ? (float*)(ws + WS_DUMMY) : H, DM};
                pg8::gemm_phase<pg8::EpiResid, pg8::StaticOrder, false>(lds, Kd, S, E, tid);
            } else if (sub == 4) {
                { RowArgs A{}; A.src = H; A.h = H; A.hn = HN; A.rstd = RSTD; A.gnorm = norm_ffn + (size_t)L * DM; A.tabh = RW + (size_t)L * 32 * 64 * 24; A.bias0 = rg_b + L * NG; A.bias1 = re_b + L * NE;
                    A.eid = EID; A.rank = RANK; A.gate = GATE; A.counts = COUNTS + L * NE; A.list = LIST;
                    if (dummy) { unsigned char* dz = ws + WS_DUMMY; A.hn = (h16*)(dz + 64 * MiB); A.rstd = (float*)(dz + 100 * MiB); A.eid = (int*)(dz + 101 * MiB); A.rank = (int*)(dz + 102 * MiB); A.gate = (float*)(dz + 103 * MiB); A.list = (int*)(dz + 104 * MiB); A.counts = (unsigned*)(ctl + CW_CNT2); }
                    row_pass_all<false, false, 3>(A, vcu, G, wave, lane, lds, nullptr); }
            } else if (sub == 5) {
                moe_setup(MISC, COUNTS + L * NE, tid);
                MoeOrderT<true> S{MISC + 16, MISC + 48, G, vcu, DM, (const char*)HN, (const char*)(WguT + (size_t)L * NE * 1024 * 1024), SZ_WGU, LIST};
                pg8::EpiSwiGLU E{ACT, RSTD, LIST, (const int*)(COUNTS + L * NE)};
                pg8::gemm_phase<pg8::EpiSwiGLU, MoeOrderT<true>, true>(lds, DM, S, E, tid);
            } else if (sub == 6) {
                moe_setup(MISC, COUNTS + L * NE, tid);
                MoeOrderT<false> S{MISC + 16, MISC + 48, G, vcu, EFF, (const char*)ACT, (const char*)(WdT + (size_t)L * NE * 1024 * 512), SZ_WD, LIST};
                pg8::EpiStoreH16 E{Y, DM};
                pg8::gemm_phase<pg8::EpiStoreH16, MoeOrderT<false>, true>(lds, EFF, S, E, tid);
            } else {
                moe_setup(MISC, COUNTS + L * NE, tid);
                if (L == DEPTH - 1) {
                    _Pragma("unroll 1") for (int t = gw; t < T; t += NGW) final_row(H, Y, EID, RANK, GATE, MISC + 96, norm_final, dummy ? (float*)(ws + WS_DUMMY) : outp, t, lane);
                } else {
                    const bool nfox = ((L + 1) & 1) == 0;
                    RowArgs A{}; A.src = H; A.h = H; A.hn = HN; A.rstd = RSTD; A.gnorm = norm_mix + (size_t)(L + 1) * DM; A.y = Y; A.eidp = EID; A.rankp = RANK; A.gatep = GATE;
                    if (dummy) { unsigned char* dz = ws + WS_DUMMY; A.h = (float*)dz; A.hn = (h16*)(dz + 64 * MiB); A.rstd = (float*)(dz + 100 * MiB); }
                    if (nfox) { A.tabh = FW + (size_t)((L + 1) >> 1) * 32 * 64 * 8; A.bias0 = fox_b_f + ((L + 1) >> 1) * FOX_H; A.flog = dummy ? (float*)(ws + WS_DUMMY + 106 * MiB) : FLOG;
                        row_pass_all<true, true, 1>(A, vcu, G, wave, lane, lds, MISC + 96); }
                    else { row_pass_all<true, true, 0>(A, vcu, G, wave, lane, lds, MISC + 96); }
                }
            }
        }
        if (did && pi + 1 < args.ph_hi) xcd_barrier(bar, tid == 0);
#ifdef PROBE_T
        if (ph == PROBE_T - 1 || (PROBE_T == 0 && pi == args.ph_lo)) { if (PROBE_T == 0) {} else probe_t0 = __builtin_amdgcn_s_memrealtime(); }
        if (ph == PROBE_T) probe_t1 = __builtin_amdgcn_s_memrealtime();
#endif
    }
#if defined(PROBE_A) && defined(PROBE_B)
    if (blockIdx.x == 0 && TID0()) { volatile LAS unsigned* pm_ = (volatile LAS unsigned*)(size_t)(MISC_OFF + 800); const unsigned long long d = (unsigned long long)(pm_[1] - pm_[0]) * (unsigned long long)PROBE_AMP2; const unsigned long long s0 = __builtin_amdgcn_s_memrealtime();
        while (__builtin_amdgcn_s_memrealtime() - s0 < d) __builtin_amdgcn_s_sleep(8); }
#endif
#ifdef PROBE_T
    if (blockIdx.x == 0 && TID0()) { const unsigned long long d = (probe_t1 - probe_t0) * PROBE_AMP; const unsigned long long s0 = __builtin_amdgcn_s_memrealtime();
        while (__builtin_amdgcn_s_memrealtime() - s0 < d) __builtin_amdgcn_s_sleep(8); }
#endif
}

extern "C" void kernel_launch(void* const* d_in, const int* in_sizes, int n_in, void* d_out, int out_size, void* d_ws, size_t ws_size, hipStream_t stream) {
    static int grid = 0;
    if (grid == 0) {
        if (n_in != 16 || out_size != T * DM || ws_size < WS_END) { fprintf(stderr, "kernel_launch: unexpected problem (n_in %d out %d ws %zu need %zu)\n", n_in, out_size, ws_size, (size_t)WS_END); grid = -1; return; }
        int dev = 0, cus = 0;
        if (hipGetDevice(&dev) != hipSuccess || hipDeviceGetAttribute(&cus, hipDeviceAttributeMultiprocessorCount, dev) != hipSuccess) { grid = -1; return; }
        if (hipFuncSetAttribute((const void*)mk_fwd, hipFuncAttributeMaxDynamicSharedMemorySize, LDS_BYTES) != hipSuccess) { fprintf(stderr, "kernel_launch: hipFuncSetAttribute failed\n"); grid = -1; return; }
        (void)hipGetLastError();
        grid = cus;
    }
    if (grid < 0) return;
    if (hipMemsetAsync((char*)d_ws + WS_CTL, 0, CTL_ZERO_BYTES, stream) != hipSuccess) return;
    Args a{};
    for (int i = 0; i < 16; ++i) a.in[i] = (const float*)d_in[i];
    a.out = (float*)d_out; a.ws = (unsigned char*)d_ws;
#if MK_N_LAUNCHES == 1
    a.ph_lo = 0; a.ph_hi = NPHASE + (PROBE_DUP >= 0 ? 1 : 0); a.li = 0;
    hipLaunchKernelGGL(mk_fwd, dim3(grid), dim3(NWAVES * 64), LDS_BYTES, stream, a);
#else
    for (int p = 0; p < NPHASE; ++p) {
        if (p >= 2 && ((p - 2) & 7) == 2 && (((p - 2) >> 3) & 1) == 0) continue;
        a.ph_lo = p; a.ph_hi = p + 1; a.li = 0;
        hipLaunchKernelGGL(mk_fwd, dim3(grid), dim3(NWAVES * 64), LDS_BYTES, stream, a);
    }
#endif
}
```

```cpp
#include <hip/hip_runtime.h>
#include <cstdio>
#include <cstdint>
#include <cmath>
#define LAS __attribute__((address_space(3)))
#define GAS __attribute__((address_space(1)))
typedef _Float16 h16;
typedef _Float16 f16x8 __attribute__((ext_vector_type(8)));
typedef _Float16 f16x4 __attribute__((ext_vector_type(4)));
typedef _Float16 f16x2 __attribute__((ext_vector_type(2)));
typedef float f32x2 __attribute__((ext_vector_type(2)));
typedef float f32x4 __attribute__((ext_vector_type(4)));
typedef float f32x16 __attribute__((ext_vector_type(16)));
typedef unsigned u32x2 __attribute__((ext_vector_type(2)));
typedef unsigned u32x4 __attribute__((ext_vector_type(4)));
typedef short s16x4 __attribute__((ext_vector_type(4)));
__device__ __forceinline__ unsigned pk2h(float lo, float hi) { f32x2 v = {lo, hi}; f16x2 b = __builtin_convertvector(v, f16x2); return __builtin_bit_cast(unsigned, b); }

constexpr int DM = 1024, BATCH = 8, SEQ = 2048, DEPTH = 4, T = BATCH * SEQ;
constexpr int FOX_H = 16, FOX_D = 64, FOX_IN = 4 * DM + FOX_H;
constexpr int RET_H = 4, RET_DK = 256, RET_DV = 512, RET_IN = 6144;
constexpr int NG = 4, EPG = 8, NE = 32, EFF = 512;
constexpr int PAIRS = T * 2;
constexpr int LISTCAP = 16384;
constexpr int PROWS = PAIRS + NE * 256;
constexpr float EPS = 1e-6f;
constexpr float LOG2E = 1.4426950408889634f;

namespace pg8 {
constexpr int BM = 256, BK = 64, HALF = 128, HTB = HALF * BK * 2, STAGE_BYTES = 8 * HTB, NXCD = 8, WGM = 8;
__host__ __device__ __forceinline__ int lds_byte(int r, int c) { const int st = (r >> 4) * 2 + (c >> 5), rr = r & 15, cc = c & 31, ob = rr * 64 + cc * 2; return st * 1024 + (ob ^ (((ob >> 9) & 1) << 5)); }
__host__ __device__ __forceinline__ void stage_rc(int b, int& R, int& C) { const int st = b / 1024, sb = b % 1024, swz = sb ^ (((sb >> 9) & 1) << 5); R = (st >> 1) * 16 + swz / 64; C = (st & 1) * 32 + (swz % 64) / 2; }
__host__ __device__ __forceinline__ int perm32(int rho) { const int n = rho >> 4, i = rho & 15; return 8 * (i >> 2) + 4 * n + (i & 3); }

struct Unit { int pm, pn, e, mt; };

struct StaticOrder {
    static constexpr bool GATHER = false;
    int nM, nN, nwg, G, c, K; const char* A; const char* Bt;
    __device__ void init(const void* A_, const void* Bt_, int M, int N, int K_, int G_, int c_) { A = (const char*)A_; Bt = (const char*)Bt_; K = K_; nM = M / BM; nN = N / BM; nwg = nM * nN; G = G_; c = c_; }
    __device__ bool next(int i, Unit& u) const {
        const long L = (long)i * G + c; if (L >= nwg) return false;
        int wgid = (int)L; { const int q = nwg / NXCD, r = nwg % NXCD, xcd = wgid % NXCD, off = wgid / NXCD; wgid = (xcd < r ? xcd * (q + 1) : r * (q + 1) + (xcd - r) * q) + off; }
        const int nig = WGM * nN, gid = wgid / nig, fm = gid * WGM, gsz = (nM - fm) < WGM ? (nM - fm) : WGM;
        u.pm = fm + ((wgid % nig) % gsz); u.pn = (wgid % nig) / gsz; u.e = 0; u.mt = 0; return true;
    }
    __device__ __forceinline__ const char* abase() const { return A; }
    __device__ __forceinline__ void aoff(const Unit& u, const int (&R)[2], const int (&C)[2], unsigned (&ao)[2][2]) const {
#pragma unroll
        for (int h = 0; h < 2; ++h)
#pragma unroll
            for (int i = 0; i < 2; ++i) ao[h][i] = (unsigned)(((size_t)(u.pm * BM + h * HALF + R[i]) * K + C[i]) * 2);
    }
    __device__ __forceinline__ const char* bbase(const Unit& u) const { return Bt + (size_t)u.pn * BM * K * 2; }
};

#define PG8_WAIT_V(n) asm volatile("s_waitcnt vmcnt(" #n ")" ::: "memory")
#define PG8_WAIT_L(n) asm volatile("s_waitcnt lgkmcnt(" #n ")" ::: "memory")
#define PG8_BAR __builtin_amdgcn_s_barrier()
#define PG8_SCHED __builtin_amdgcn_sched_barrier(0)

template <class Epi, class Sched, bool ALIGN_EPI>
__device__ __forceinline__ void gemm_phase(LAS unsigned char* lds, const int K, const Sched& S, const Epi& E, const int tid) {
    constexpr bool GATHER = Sched::GATHER;
    const int wid = __builtin_amdgcn_readfirstlane(tid >> 6), lane = tid & 63, wr = wid >> 2, wc = wid & 3, fr = lane & 15, fq = lane >> 4;
    const int nt = K / BK;
    int Rr[2], Cc[2]; unsigned voffB[2], voffA[2];
#pragma unroll
    for (int i = 0; i < 2; ++i) { int R, C; stage_rc(tid * 16 + i * 8192, R, C); Rr[i] = R; Cc[i] = C; const int Rb = Epi::PERM ? ((R & ~31) + perm32(R & 31)) : R; voffB[i] = (unsigned)(Rb * K + C) * 2u; voffA[i] = (unsigned)(R * K + C) * 2u; }
    const size_t kstep = (size_t)(BK * 2);
    const size_t hstep = (size_t)HALF * K * 2;
    const size_t tstep = 2 * hstep;
    const unsigned ldsw = (unsigned)wid * 1024u;
    const int aoff_l = lds_byte(wr * 64 + fr, fq * 8), boff_l = lds_byte(wc * 32 + fr, fq * 8);
    const char* const gA = S.abase();
    LAS u32x4* const park = (LAS u32x4*)(lds + STAGE_BYTES) + tid;
#define PG8_SA(b, h) (((b) * 2 + (h)) * HTB)
#define PG8_SB(b, h) ((4 + (b) * 2 + (h)) * HTB)
#define PG8_STAGE(bufoff, gbase, voff) do { _Pragma("unroll") for (int _i = 0; _i < 2; ++_i) \
        __builtin_amdgcn_global_load_lds((const unsigned*)((const char*)(gbase) + (voff)[_i]), (LAS unsigned*)(lds + (bufoff) + ldsw + _i * 8192), 16, 0, 0); } while (0)
#define PG8_STAGEA(bufoff, ubase, h, kb) do { if constexpr (GATHER) { \
        __builtin_amdgcn_global_load_lds((const unsigned*)((gA + (kb)) + aoC[h][0]), (LAS unsigned*)(lds + (bufoff) + ldsw), 16, 0, 0); \
        __builtin_amdgcn_global_load_lds((const unsigned*)((gA + (kb)) + aoC[h][1]), (LAS unsigned*)(lds + (bufoff) + ldsw + 8192), 16, 0, 0); \
      } else { PG8_STAGE(bufoff, (ubase) + (size_t)(h) * hstep + (kb), voffA); } } while (0)
#define PG8_LDA(dst, b, h) do { _Pragma("unroll") for (int m = 0; m < 4; ++m) _Pragma("unroll") for (int k = 0; k < 2; ++k) dst[m][k] = *(const LAS f16x8*)(lds + PG8_SA(b, h) + aoff_l + m * 2048 + k * 1024); } while (0)
#define PG8_LDB(dst, b, h) do { _Pragma("unroll") for (int n = 0; n < 2; ++n) _Pragma("unroll") for (int k = 0; k < 2; ++k) dst[n][k] = *(const LAS f16x8*)(lds + PG8_SB(b, h) + boff_l + n * 2048 + k * 1024); } while (0)
#define PG8_MMA(ai, bj, At, Bt) do { __builtin_amdgcn_s_setprio(1); _Pragma("unroll") for (int m = 0; m < 4; ++m) _Pragma("unroll") for (int n = 0; n < 2; ++n) _Pragma("unroll") for (int k = 0; k < 2; ++k) \
        acc[ai][bj][m][n] = __builtin_amdgcn_mfma_f32_16x16x32_f16(Bt[n][k], At[m][k], acc[ai][bj][m][n], 0, 0, 0); __builtin_amdgcn_s_setprio(0); } while (0)
    Unit cur, nxt; int ui = 0;
    if (!S.next(0, cur)) return;
    f32x4 acc[2][2][4][2];
#pragma unroll
    for (int a = 0; a < 2; ++a)
#pragma unroll
        for (int b = 0; b < 2; ++b)
#pragma unroll
            for (int m = 0; m < 4; ++m)
#pragma unroll
                for (int n = 0; n < 2; ++n) acc[a][b][m][n] = (f32x4){0.f, 0.f, 0.f, 0.f};
    f16x8 At[4][2], B0[2][2], B1[2][2];
    unsigned aoC[2][2] = {{0u, 0u}, {0u, 0u}};
    if constexpr (GATHER) S.aoff(cur, Rr, Cc, aoC);
    const char* cA = gA + (size_t)cur.pm * tstep;
    const char* cB = S.bbase(cur);
    PG8_STAGE(PG8_SB(0, 0), cB, voffB); PG8_STAGE(PG8_SB(0, 1), cB + hstep, voffB); PG8_STAGEA(PG8_SA(0, 0), cA, 0, 0); PG8_STAGEA(PG8_SA(0, 1), cA, 1, 0);
    if (wr == 1) PG8_BAR;
    PG8_WAIT_V(2); PG8_BAR;
    PG8_STAGE(PG8_SB(1, 0), cB + kstep, voffB); PG8_STAGEA(PG8_SA(1, 0), cA, 0, kstep); PG8_STAGE(PG8_SB(1, 1), cB + hstep + kstep, voffB);
    PG8_WAIT_V(6); PG8_BAR;
    for (;;) {
        const bool has_next = S.next(ui + 1, nxt);
        const char* nB = cB; const char* nA = cA;
        if (has_next) { nB = S.bbase(nxt); nA = gA + (size_t)nxt.pm * tstep; }
        if constexpr (GATHER) { unsigned aoN[2][2];
            if (has_next) S.aoff(nxt, Rr, Cc, aoN); else { aoN[0][0] = aoC[0][0]; aoN[0][1] = aoC[0][1]; aoN[1][0] = aoC[1][0]; aoN[1][1] = aoC[1][1]; }
            *park = (u32x4){aoN[0][0], aoN[0][1], aoN[1][0], aoN[1][1]}; }
        for (int t = 0; t < nt; t += 2) {
            const bool last = (t == nt - 2);
            const size_t k1 = (size_t)(t + 1) * kstep;
            const size_t k2 = last ? 0 : (size_t)(t + 2) * kstep, k3 = k2 + kstep;
            const char* a2 = last ? nA : cA;
            const char* b2 = (last ? nB : cB) + k2; const char* b3 = b2 + kstep;
            PG8_LDB(B0, 0, 0); PG8_LDB(B1, 0, 1); PG8_SCHED; PG8_LDA(At, 0, 0); PG8_STAGEA(PG8_SA(1, 1), cA, 1, k1);
            if constexpr (GATHER) { if (last) { const u32x4 p = *park; aoC[0][0] = p.x; aoC[0][1] = p.y; aoC[1][0] = p.z; aoC[1][1] = p.w; } }
            PG8_WAIT_V(8); PG8_WAIT_L(0); PG8_BAR; PG8_MMA(0, 0, At, B0); PG8_MMA(0, 1, At, B1); PG8_BAR; PG8_SCHED;
            PG8_LDA(At, 0, 1); PG8_STAGE(PG8_SB(0, 0), b2, voffB); PG8_STAGE(PG8_SB(0, 1), b2 + hstep, voffB); PG8_STAGEA(PG8_SA(0, 0), a2, 0, k2);
            PG8_WAIT_V(8); PG8_WAIT_L(0); PG8_BAR; PG8_MMA(1, 0, At, B0); PG8_MMA(1, 1, At, B1); PG8_BAR; PG8_SCHED;
            PG8_LDB(B0, 1, 0); PG8_LDB(B1, 1, 1); PG8_SCHED; PG8_LDA(At, 1, 0); PG8_STAGEA(PG8_SA(0, 1), a2, 1, k2);
            PG8_WAIT_V(8); PG8_WAIT_L(0); PG8_BAR; PG8_MMA(0, 0, At, B0); PG8_MMA(0, 1, At, B1); PG8_BAR; PG8_SCHED;
            PG8_LDA(At, 1, 1); PG8_STAGE(PG8_SB(1, 0), b3, voffB); PG8_STAGE(PG8_SB(1, 1), b3 + hstep, voffB); PG8_STAGEA(PG8_SA(1, 0), a2, 0, k3);
            PG8_WAIT_V(8); PG8_WAIT_L(0); PG8_BAR; PG8_MMA(1, 0, At, B0); PG8_MMA(1, 1, At, B1); PG8_BAR; PG8_SCHED;
        }
        if constexpr (ALIGN_EPI) { if (wr == 0) PG8_BAR; }
        E(acc, cur, wr, wc, fr, fq);
        if (!has_next) break;
#pragma unroll
        for (int a = 0; a < 2; ++a)
#pragma unroll
            for (int b = 0; b < 2; ++b)
#pragma unroll
                for (int m = 0; m < 4; ++m)
#pragma unroll
                    for (int n = 0; n < 2; ++n) acc[a][b][m][n] = (f32x4){0.f, 0.f, 0.f, 0.f};
        cur = nxt; cB = nB; cA = nA; ++ui;
        if constexpr (ALIGN_EPI) { if (wr == 1) PG8_BAR; }
    }
    PG8_WAIT_V(0);
    if constexpr (!ALIGN_EPI) { if (wr == 0) PG8_BAR; }
    PG8_BAR;
#undef PG8_SA
#undef PG8_SB
#undef PG8_STAGE
#undef PG8_STAGEA
#undef PG8_LDA
#undef PG8_LDB
#undef PG8_MMA
}

struct EpiH16 {
    static constexpr bool PERM = true;
    h16* O; int ldc; int split_cols; size_t split_stride; const float* rstd; float scale0, scale1; int rot; const float* ct; const float* st;
    __device__ __forceinline__ void operator()(const f32x4 (&acc)[2][2][4][2], const Unit& u, int wr, int wc, int fr, int fq) const {
        const int row0 = u.pm * BM + wr * 64 + fr; int colt = u.pn * BM; h16* base = O;
        const int t = colt / split_cols; base += (size_t)t * split_stride; colt -= t * split_cols;
        const float sc = (t == 0) ? scale0 : ((t == 1) ? scale1 : 1.f);
        const int col0 = colt + wc * 32 + 8 * fq;
        const bool dorot = rot && (t < 2);
#pragma unroll
        for (int ai = 0; ai < 2; ++ai)
#pragma unroll
            for (int m = 0; m < 4; ++m) {
                const int row = row0 + ai * HALF + m * 16; const float rs = rstd[row] * sc;
                h16* rowp = base + (size_t)row * ldc + col0;
                if (dorot) {
                    const int pos = row & (SEQ - 1); const int d0 = wc * 32 + 8 * fq;
                    const f32x4 c0 = *(const f32x4*)(ct + pos * 128 + d0), c1 = *(const f32x4*)(ct + pos * 128 + d0 + 4);
                    const f32x4 s0 = *(const f32x4*)(st + pos * 128 + d0), s1 = *(const f32x4*)(st + pos * 128 + d0 + 4);
                    const f32x4 a0 = acc[ai][0][m][0] * rs, a1 = acc[ai][0][m][1] * rs, b0 = acc[ai][1][m][0] * rs, b1 = acc[ai][1][m][1] * rs;
                    const f32x4 o10 = a0 * c0 - b0 * s0, o11 = a1 * c1 - b1 * s1, o20 = a0 * s0 + b0 * c0, o21 = a1 * s1 + b1 * c1;
                    u32x4 w; w.x = pk2h(o10[0], o10[1]); w.y = pk2h(o10[2], o10[3]); w.z = pk2h(o11[0], o11[1]); w.w = pk2h(o11[2], o11[3]);
                    *(u32x4*)(rowp) = w;
                    w.x = pk2h(o20[0], o20[1]); w.y = pk2h(o20[2], o20[3]); w.z = pk2h(o21[0], o21[1]); w.w = pk2h(o21[2], o21[3]);
                    *(u32x4*)(rowp + HALF) = w;
                } else {
#pragma unroll
                    for (int bj = 0; bj < 2; ++bj) { const f32x4 v0 = acc[ai][bj][m][0] * rs, v1 = acc[ai][bj][m][1] * rs;
                        u32x4 w; w.x = pk2h(v0[0], v0[1]); w.y = pk2h(v0[2], v0[3]); w.z = pk2h(v1[0], v1[1]); w.w = pk2h(v1[2], v1[3]);
                        *(u32x4*)(rowp + bj * HALF) = w; }
                }
            }
    }
};
struct EpiResid {
    static constexpr bool PERM = false;
    float* H; int ldc;
    __device__ __forceinline__ void operator()(const f32x4 (&acc)[2][2][4][2], const Unit& u, int wr, int wc, int fr, int fq) const {
        const int col0 = u.pn * BM + wc * 32 + 4 * fq, row0 = u.pm * BM + wr * 64 + fr;
#pragma unroll
        for (int ai = 0; ai < 2; ++ai)
#pragma unroll
            for (int m = 0; m < 4; ++m) { float* rp = H + (size_t)(row0 + ai * HALF + m * 16) * ldc + col0;
#pragma unroll
                for (int bj = 0; bj < 2; ++bj)
#pragma unroll
                    for (int n = 0; n < 2; ++n) { f32x4* p = (f32x4*)(rp + bj * HALF + n * 16); *p = *p + acc[ai][bj][m][n]; } }
    }
};
struct EpiStoreF32 {
    static constexpr bool PERM = false;
    float* Y; int ldc;
    __device__ __forceinline__ void operator()(const f32x4 (&acc)[2][2][4][2], const Unit& u, int wr, int wc, int fr, int fq) const {
        const int col0 = u.pn * BM + wc * 32 + 4 * fq, row0 = u.pm * BM + wr * 64 + fr;
#pragma unroll
        for (int ai = 0; ai < 2; ++ai)
#pragma unroll
            for (int m = 0; m < 4; ++m) { float* rp = Y + (size_t)(row0 + ai * HALF + m * 16) * ldc + col0;
#pragma unroll
                for (int bj = 0; bj < 2; ++bj)
#pragma unroll
                    for (int n = 0; n < 2; ++n) *(f32x4*)(rp + bj * HALF + n * 16) = acc[ai][bj][m][n]; }
    }
};
struct EpiStoreH16 {
    static constexpr bool PERM = true;
    h16* Y; int ldc;
    __device__ __forceinline__ void operator()(const f32x4 (&acc)[2][2][4][2], const Unit& u, int wr, int wc, int fr, int fq) const {
        const int col0 = u.pn * BM + wc * 32 + 8 * fq, row0 = u.pm * BM + wr * 64 + fr;
#pragma unroll
        for (int ai = 0; ai < 2; ++ai)
#pragma unroll
            for (int m = 0; m < 4; ++m) { h16* rp = Y + (size_t)(row0 + ai * HALF + m * 16) * ldc + col0;
#pragma unroll
                for (int bj = 0; bj < 2; ++bj) { const f32x4 v0 = acc[ai][bj][m][0], v1 = acc[ai][bj][m][1];
                    u32x4 w; w.x = pk2h(v0[0], v0[1]); w.y = pk2h(v0[2], v0[3]); w.z = pk2h(v1[0], v1[1]); w.w = pk2h(v1[2], v1[3]);
                    *(u32x4*)(rp + bj * HALF) = w; } }
    }
};
struct EpiSwiGLU {
    static constexpr bool PERM = true;
    h16* ACT; const float* rstd; const int* list; const int* cnt;
    __device__ __forceinline__ void operator()(const f32x4 (&acc)[2][2][4][2], const Unit& u, int wr, int wc, int fr, int fq) const {
        const int row0 = u.pm * BM + wr * 64 + fr, rank0 = u.mt * BM + wr * 64 + fr; const int c = cnt[u.e];
        const int col0 = u.pn * 128 + wc * 16 + 4 * fq;
#pragma unroll
        for (int ai = 0; ai < 2; ++ai)
#pragma unroll
            for (int m = 0; m < 4; ++m) {
                const int rank = rank0 + ai * HALF + m * 16; float rs = 0.f;
                if (rank < c) rs = rstd[list[u.e * LISTCAP + rank] >> 1];
                h16* rowp = ACT + (size_t)(row0 + ai * HALF + m * 16) * EFF + col0;
#pragma unroll
                for (int bj = 0; bj < 2; ++bj) { const f32x4 a = acc[ai][bj][m][0] * rs, b = acc[ai][bj][m][1] * rs; f32x4 o;
#pragma unroll
                    for (int q = 0; q < 4; ++q) o[q] = a[q] * __builtin_amdgcn_rcpf(1.0f + __builtin_amdgcn_exp2f(-a[q] * LOG2E)) * b[q];
                    u32x2 w; w.x = pk2h(o[0], o[1]); w.y = pk2h(o[2], o[3]); *(u32x2*)(rowp + bj * 64) = w; }
            }
    }
};
}
namespace attn_body {
constexpr int D = 64, DMP = 1024;
constexpr int NW = 8, QBLK = 32, QB = QBLK * NW, KVBLK = 64, NQB = SEQ / QB;
__device__ __forceinline__ int crow(int r, int hi) { return (r & 3) + 8 * (r >> 2) + 4 * hi; }
#define SBAR() __builtin_amdgcn_sched_barrier(0)
__device__ __forceinline__ void cmask(f32x16& p0, f32x16& p1, int jb, int qrel, int hi) {
    const float NEG = -INFINITY; int kb = 64 * jb + 4 * hi;
#pragma unroll
    for (int r = 0; r < 16; ++r) { int kv = kb + (r & 3) + 8 * (r >> 2); if (kv > qrel) p0[r] = NEG; if (kv + 32 > qrel) p1[r] = NEG; }
}
constexpr int NSLOT = 3, SLOTB = 8192;
constexpr int LDS_K = 0, LDS_V = NSLOT * SLOTB, LDS_WS = 2 * NSLOT * SLOTB, LDS_OST = LDS_WS + NW * 64 * 4, LDS_BIAS = LDS_OST + NW * 4096, LDS_BYTES = LDS_BIAS + SEQ * 4;
constexpr float C2 = 0.125f * LOG2E;
__device__ __forceinline__ void glds16(const void* gsrc, unsigned lds_dst) { unsigned keep;
    asm volatile("s_mov_b32 %0, m0\n\ts_mov_b32 m0, %2\n\ts_nop 0\n\tglobal_load_lds_dwordx4 %1, off\n\ts_mov_b32 m0, %0" : "=&s"(keep) : "v"(gsrc), "s"(lds_dst) : "memory"); }
__device__ __forceinline__ float max3f(float a, float b, float c) { float r; asm("v_max3_f32 %0, %1, %2, %3" : "=v"(r) : "v"(a), "v"(b), "v"(c)); return r; }
__device__ __forceinline__ float max2f(float a, float b) { float r; asm("v_max_f32_e32 %0, %1, %2" : "=v"(r) : "v"(a), "v"(b)); return r; }
__device__ __forceinline__ float fadd_s(float a, float b) { float r; asm("v_add_f32_e32 %0, %1, %2" : "=v"(r) : "v"(a), "v"(b)); return r; }
__device__ __forceinline__ float fsub_s(float a, float b) { float r; asm("v_sub_f32_e32 %0, %1, %2" : "=v"(r) : "v"(a), "v"(b)); return r; }
__device__ __forceinline__ unsigned split_hl(float v) { const h16 hi = (h16)v; const h16 lo = (h16)(v - (float)hi); return (unsigned)__builtin_bit_cast(unsigned short, hi) | ((unsigned)__builtin_bit_cast(unsigned short, lo) << 16); }
#define WAIT_BAR(N) asm volatile("s_waitcnt vmcnt(" #N ") lgkmcnt(0)\n\ts_barrier" ::: "memory")
#define MF16(a, b, c) __builtin_amdgcn_mfma_f32_32x32x16_f16(a, b, c, 0, 0, 0)
typedef LAS const char* lds_cptr;
typedef short v4i16_t __attribute__((ext_vector_type(4)));
__device__ __forceinline__ void kload8(f16x8* kf, lds_cptr kp) {
    kf[0] = *(const LAS f16x8*)(kp);        kf[1] = *(const LAS f16x8*)(kp + 512);
    kf[2] = *(const LAS f16x8*)(kp + 2048); kf[3] = *(const LAS f16x8*)(kp + 2560);
    kf[4] = *(const LAS f16x8*)(kp + 4096); kf[5] = *(const LAS f16x8*)(kp + 4608);
    kf[6] = *(const LAS f16x8*)(kp + 6144); kf[7] = *(const LAS f16x8*)(kp + 6656);
}
__device__ __forceinline__ void kload2(f16x8* kf, lds_cptr kp, int j) { kf[2 * j] = *(const LAS f16x8*)(kp + j * 2048); kf[2 * j + 1] = *(const LAS f16x8*)(kp + j * 2048 + 512); }
__device__ __forceinline__ s16x4 vtr(lds_cptr p) { return __builtin_bit_cast(s16x4, __builtin_amdgcn_ds_read_tr16_b64_v4i16((LAS v4i16_t*)p)); }
__device__ __forceinline__ f16x8 mk8(s16x4 lo, s16x4 hi) { typedef short s16x8 __attribute__((ext_vector_type(8))); s16x8 t = {lo[0], lo[1], lo[2], lo[3], hi[0], hi[1], hi[2], hi[3]}; return __builtin_bit_cast(f16x8, t); }
__device__ __forceinline__ f16x4 ext_frag(unsigned w0, unsigned w1) { u32x2 t = {w0, w1}; return __builtin_bit_cast(f16x4, t); }
#define MF8(a, b, c) __builtin_amdgcn_mfma_f32_32x32x8f16(a, b, c, 0, 0, 0)
__device__ __forceinline__ float rowmax(const f32x16& p0, const f32x16& p1) {
    float a = max3f(p0[0], p0[1], p1[0]), b = max3f(p0[2], p0[3], p1[1]); a = max3f(a, p1[2], p1[3]);
#pragma unroll
    for (int r = 4; r < 16; r += 4) { a = max3f(a, p0[r], p0[r + 1]); b = max3f(b, p0[r + 2], p0[r + 3]); a = max3f(a, p1[r], p1[r + 1]); b = max3f(b, p1[r + 2], p1[r + 3]); }
    const float m = max2f(a, b);
    auto rr = __builtin_amdgcn_permlane32_swap(__float_as_uint(m), __float_as_uint(m), false, false);
    return max2f(__uint_as_float(rr[0]), __uint_as_float(rr[1]));
}
__device__ __forceinline__ void qkt(f32x16& p0, f32x16& p1, const char* Kslot, const f16x8* qr, f16x4 kb0, f16x4 kb1, f16x4 qe, int r32, int hi) {
    const char* kb = Kslot + hi * 1024 + r32 * 16;
    const f32x16 z = {};
    p0 = MF8(kb0, qe, z); p1 = MF8(kb1, qe, z);
#pragma unroll
    for (int d0 = 0; d0 < 4; ++d0) {
        const f16x8 b0 = *reinterpret_cast<const f16x8*>(kb + d0 * 2048);
        const f16x8 b1 = *reinterpret_cast<const f16x8*>(kb + d0 * 2048 + 512);
        p0 = MF16(b0, qr[d0], p0); p1 = MF16(b1, qr[d0], p1); }
}
__device__ __forceinline__ void pv(f32x16* o, int vb, f16x8 pa0, f16x8 pa1, f16x8 pa2, f16x8 pa3) {
#pragma unroll
    for (int d0 = 0; d0 < 2; ++d0) { s16x4 lo[4], hi[4];
#pragma unroll
        for (int ks = 0; ks < 4; ++ks) {
            asm volatile("ds_read_b64_tr_b16 %0,%1 offset:%c2" : "=&v"(lo[ks]) : "v"(vb), "i"(d0 * 4096 + ks * 1024) : "memory");
            asm volatile("ds_read_b64_tr_b16 %0,%1 offset:%c2" : "=&v"(hi[ks]) : "v"(vb), "i"(d0 * 4096 + ks * 1024 + 512) : "memory"); }
        asm volatile("s_waitcnt lgkmcnt(0)" ::: "memory"); SBAR();
        o[d0] = MF16(pa0, mk8(lo[0], hi[0]), o[d0]);
        o[d0] = MF16(pa1, mk8(lo[1], hi[1]), o[d0]);
        o[d0] = MF16(pa2, mk8(lo[2], hi[2]), o[d0]);
        o[d0] = MF16(pa3, mk8(lo[3], hi[3]), o[d0]);
    }
}
#define ATTN_ONES 0x3C003C00u
template <int THRL> __device__ __forceinline__ void attn_unit(int b, int h, int qb, const h16* Q, const h16* __restrict__ K, const h16* __restrict__ V, const h16* __restrict__ G, const float* __restrict__ cum, h16* O, char* shm, const int tid) {
    const int lane = tid & 63, r32 = lane & 31, hi = lane >> 5; const int wid = __builtin_amdgcn_readfirstlane(tid >> 6);
    const long rowbase = (long)b * SEQ; const int q0 = qb * QB;
    const h16* Qw = Q + (rowbase + q0 + wid * QBLK) * DMP + h * D;
    const h16* Kh = K + rowbase * DMP + h * D, *Vh = V + rowbase * DMP + h * D;
    const unsigned lds0 = (unsigned)(uintptr_t)shm;
    float* wsf = (float*)(shm + LDS_WS) + wid * 64;
    const h16* ksrc = Kh + (long)lane * DMP + wid * 8;
    const h16* vsrc = Vh + (long)(16 * (wid & 3) + (lane >> 2)) * DMP + (wid >> 2) * 32 + (lane & 3) * 8;
    const unsigned kdst = lds0 + LDS_K + wid * 1024, vdst = lds0 + LDS_V + wid * 1024;
#define DMA_K(t, slot) glds16(ksrc + (long)(t) * KVBLK * DMP, (unsigned)__builtin_amdgcn_readfirstlane(kdst + (slot)))
#define DMA_V(t, slot) glds16(vsrc + (long)(t) * KVBLK * DMP, (unsigned)__builtin_amdgcn_readfirstlane(vdst + (slot)))
    const int vb0 = (int)(lds0 + LDS_V) + ((lane >> 4) & 1) * 32 + (lane & 3) * 8 + (4 * hi + ((lane & 15) >> 2)) * 64;
    const char* Kbase = shm + LDS_K; f16x8 kf[8];
    const lds_cptr shm3 = (lds_cptr)shm; const lds_cptr kp0 = shm3 + LDS_K + hi * 1024 + r32 * 16; const lds_cptr vp0 = shm3 + LDS_V + ((lane >> 4) & 1) * 32 + (lane & 3) * 8 + (4 * hi + ((lane & 15) >> 2)) * 64;
    const LAS unsigned* biasw = (const LAS unsigned*)(shm3 + LDS_BIAS);
    const int NT = (q0 + QB) / KVBLK;
    DMA_K(0, 0); DMA_V(0, 0); DMA_K(1, SLOTB);
    { const float* cb = cum + (long)(b * FOX_H + h) * SEQ; const float cref = cb[q0];
      LAS unsigned* bw = (LAS unsigned*)(shm3 + LDS_BIAS);
      for (int j = tid; j < q0 + QB; j += NW * 64) bw[j] = split_hl(fmaxf((cref - cb[j]) * LOG2E, -30000.f)); }
    f16x8 qr[4];
#pragma unroll
    for (int d0 = 0; d0 < 4; ++d0) qr[d0] = *reinterpret_cast<const f16x8*>(&Qw[(long)r32 * DMP + d0 * 16 + hi * 8]);
    float mhat = 0.f, l_reg = 0.f; f32x16 o[2]; o[0] = f32x16{}; o[1] = f32x16{};
    unsigned qew1 = 0u;
    const unsigned qew0 = hi ? 0u : ATTN_ONES, kew1 = hi ? 0u : ATTN_ONES;
#define QE() ext_frag(qew0, qew1)
#define KE(w) ext_frag(hi ? 0u : (w), kew1)
#define SETM() do { qew1 = hi ? 0u : split_hl(-mhat); } while (0)
    const int qrel = wid * QBLK + r32;
#define CMASK(P0, P1, t) do { int jb_ = (t) - (NT - 4); if (jb_ >= 0) cmask(P0, P1, jb_, qrel, hi); } while (0)
    bool resc = false;
#define START(P0, P1) do { const float rm = rowmax(P0, P1); resc = false; \
    { const float dl = rm; mhat = fadd_s(mhat, dl); \
      _Pragma("unroll") for (int r = 0; r < 16; ++r) { P0[r] = fsub_s(P0[r], dl); P1[r] = fsub_s(P1[r], dl); } \
      SETM(); } \
    _Pragma("unroll") for (int r = 0; r < 16; ++r) P0[r] = __builtin_amdgcn_exp2f(P0[r]); } while (0)
#define RESC() do { if (resc) { asm volatile("s_waitcnt lgkmcnt(0)" ::: "memory"); \
      _Pragma("unroll") for (int d_ = 0; d_ < 2; ++d_) _Pragma("unroll") for (int r = 0; r < 16; ++r) o[d_][r] *= wsf[crow(r, hi)]; } } while (0)
    f32x16 pA0, pA1, pB0, pB1;
    int sl_prev = 0, sl_cur = 0, sl_next = SLOTB;
#define ROT() do { sl_prev = sl_cur; sl_cur = sl_next; sl_next = (sl_next == (NSLOT - 1) * SLOTB) ? 0 : sl_next + SLOTB; } while (0)
    DMA_K(2, 2 * SLOTB);
    WAIT_BAR(3);
    unsigned bw0 = biasw[r32], bw1 = biasw[32 + r32];
    qkt(pA0, pA1, Kbase, qr, KE(bw0), KE(bw1), QE(), r32, hi); asm volatile("s_nop 15\n\ts_nop 7" : "+v"(pA0), "+v"(pA1)); CMASK(pA0, pA1, 0);
    START(pA0, pA1);
    _Pragma("unroll") for (int r = 0; r < 16; ++r) pA1[r] = __builtin_amdgcn_exp2f(pA1[r]);
    WAIT_BAR(0);
    DMA_K(3, 0); DMA_V(1, SLOTB);
    ROT();
    kload8(kf, kp0 + sl_cur);
    bw0 = biasw[64 + r32]; bw1 = biasw[96 + r32];
    WAIT_BAR(2);
    s16x4 vlo[8], vhi[8]; u32x4 pw0, pw1, pw2, pw3;
#define PKW(P, B) pk2h(P[B], P[B + 1])
#define PAF(k) __builtin_bit_cast(f16x8, pw##k)
#define VFR(i) mk8(vlo[i], vhi[i])
#define PIN(x) asm volatile("" : "+v"(x))
#define MX3(a, b, c) __builtin_fmaxf(__builtin_fmaxf((a), (b)), (c))
#define GAPA(MF, A0, A1, A2, A3, W0, W1, PW) do { MF; sacc += A0; sacc += A1; sacc += A2; sacc += A3; PIN(sacc); W0; W1; PIN(PW); SBAR(); } while (0)
#define EX(v) __builtin_amdgcn_exp2f(v)
#define GAPB(MF, X, B) do { MF; X[B] = EX(X[B]); X[B + 1] = EX(X[B + 1]); X[B + 2] = EX(X[B + 2]); X[B + 3] = EX(X[B + 3]); PIN(X); SBAR(); } while (0)
#define VRD(i) do { vlo[i] = vtr(vp_ + (((i) >> 2) * 4096 + ((i) & 3) * 1024)); vhi[i] = vtr(vp_ + (((i) >> 2) * 4096 + ((i) & 3) * 1024 + 512)); } while (0)
#define KRD(G_, j) do { if (G_) { kload2(kf, kp0 + sl_next, j); SBAR(); } } while (0)
#define STEP(C0, C1, P0, P1, t, GK, GV, GL) do { SBAR(); \
    const lds_cptr vp_ = vp0 + sl_prev; const f32x16 z_ = {}; \
    C0 = MF8(KE(bw0), QE(), z_); C1 = MF8(KE(bw1), QE(), z_); SBAR(); \
    VRD(0); SBAR(); float sacc = (P0[0] + P0[1]); \
    GAPA(C0 = MF16(kf[0], qr[0], C0), P0[2], P0[3], P0[4], P0[5],     pw0[0] = PKW(P0, 0), pw0[1] = PKW(P0, 2), pw0); \
    VRD(4); SBAR(); GAPA(C1 = MF16(kf[1], qr[0], C1), P0[6], P0[7], P0[8], P0[9],     pw0[2] = PKW(P0, 4), pw0[3] = PKW(P0, 6), pw0); \
    VRD(1); SBAR(); GAPA(C0 = MF16(kf[2], qr[1], C0),   P0[10], P0[11], P0[12], P0[13], pw1[0] = PKW(P0, 8), pw1[1] = PKW(P0, 10), pw1); \
    VRD(5); SBAR(); GAPA(C1 = MF16(kf[3], qr[1], C1),   P0[14], P0[15], P1[0], P1[1],   pw1[2] = PKW(P0, 12), pw1[3] = PKW(P0, 14), pw1); \
    VRD(2); SBAR(); GAPA(C0 = MF16(kf[4], qr[2], C0),   P1[2], P1[3], P1[4], P1[5],     pw2[0] = PKW(P1, 0), pw2[1] = PKW(P1, 2), pw2); \
    VRD(6); SBAR(); GAPA(C1 = MF16(kf[5], qr[2], C1),   P1[6], P1[7], P1[8], P1[9],     pw2[2] = PKW(P1, 4), pw2[3] = PKW(P1, 6), pw2); \
    VRD(3); SBAR(); GAPA(C0 = MF16(kf[6], qr[3], C0),   P1[10], P1[11], P1[12], P1[13], pw3[0] = PKW(P1, 8), pw3[1] = PKW(P1, 10), pw3); \
    VRD(7); SBAR(); GAPA(C1 = MF16(kf[7], qr[3], C1),   P1[14], P1[15], 0.f, 0.f,       pw3[2] = PKW(P1, 12), pw3[3] = PKW(P1, 14), pw3); \
    l_reg += sacc; \
    if (GK) { DMA_K((t) + 3, sl_cur); } if (GV) { DMA_V((t) + 1, sl_next); } \
    CMASK(C0, C1, t); \
    { float a = MX3(C0[0], C0[1], C1[0]), b_ = MX3(C0[2], C0[3], C1[1]); a = MX3(a, C1[2], C1[3]); \
      _Pragma("unroll") for (int r = 4; r < 16; r += 4) { a = MX3(a, C0[r], C0[r + 1]); b_ = MX3(b_, C0[r + 2], C0[r + 3]); a = MX3(a, C1[r], C1[r + 1]); b_ = MX3(b_, C1[r + 2], C1[r + 3]); } \
      float rm = __builtin_fmaxf(a, b_); { auto rr = __builtin_amdgcn_permlane32_swap(__float_as_uint(rm), __float_as_uint(rm), false, false); rm = __builtin_fmaxf(__uint_as_float(rr[0]), __uint_as_float(rr[1])); } \
      resc = false; \
      if (__builtin_expect(__any(rm > (float)THRL), 0)) { const float dl = __builtin_fmaxf(rm, 0.f); mhat += dl; \
        _Pragma("unroll") for (int r = 0; r < 16; ++r) { C0[r] -= dl; C1[r] -= dl; } \
        SETM(); \
        const float f = __builtin_amdgcn_exp2f(-dl); l_reg *= f; if (hi == 0) wsf[r32] = f; resc = true; } } \
    SBAR(); \
    if (GL) { bw0 = biasw[((t) + 1) * 64 + r32]; bw1 = biasw[((t) + 1) * 64 + 32 + r32]; } \
    GAPB(o[0] = MF16(PAF(0), VFR(0), o[0]), C0, 0); \
    GAPB(o[1] = MF16(PAF(0), VFR(4), o[1]), C0, 4); \
    KRD(GL, 0); GAPB(o[0] = MF16(PAF(1), VFR(1), o[0]), C0, 8); \
    KRD(GL, 1); GAPB(o[1] = MF16(PAF(1), VFR(5), o[1]), C0, 12); \
    KRD(GL, 2); GAPB(o[0] = MF16(PAF(2), VFR(2), o[0]), C1, 0); \
    KRD(GL, 3); GAPB(o[1] = MF16(PAF(2), VFR(6), o[1]), C1, 4); \
    GAPB(o[0] = MF16(PAF(3), VFR(3), o[0]), C1, 8); \
    GAPB(o[1] = MF16(PAF(3), VFR(7), o[1]), C1, 12); \
    } while (0)
    int t = 1;
#undef CMASK
#define CMASK(P0, P1, t) do {} while (0)
    for (; t + 5 < NT; t += 2) {
        STEP(pB0, pB1, pA0, pA1, t, true, true, true);     WAIT_BAR(2); RESC(); ROT();
        STEP(pA0, pA1, pB0, pB1, t + 1, true, true, true); WAIT_BAR(2); RESC(); ROT();
    }
#undef CMASK
#define CMASK(P0, P1, t) do { int jb_ = (t) - (NT - 4); if (jb_ >= 0) cmask(P0, P1, jb_, qrel, hi); } while (0)
#define ENDW(tt) do { if ((tt) + 3 < NT) { WAIT_BAR(2); } else if ((tt) + 2 < NT) { WAIT_BAR(1); } else { WAIT_BAR(0); } } while (0)
    for (; t + 1 < NT; t += 2) {
        STEP(pB0, pB1, pA0, pA1, t, (t + 3 < NT), (t + 1 < NT), (t + 1 < NT));         ENDW(t);     RESC(); ROT();
        STEP(pA0, pA1, pB0, pB1, t + 1, (t + 4 < NT), (t + 2 < NT), (t + 2 < NT));     ENDW(t + 1); RESC(); ROT();
    }
    STEP(pB0, pB1, pA0, pA1, NT - 1, false, false, false); RESC();
    { float sacc = pB0[0] + pB0[1]; _Pragma("unroll") for (int r = 2; r < 16; ++r) sacc += pB0[r]; _Pragma("unroll") for (int r = 0; r < 16; ++r) sacc += pB1[r]; l_reg += sacc;
      pw0 = (u32x4){PKW(pB0, 0), PKW(pB0, 2), PKW(pB0, 4), PKW(pB0, 6)}; pw1 = (u32x4){PKW(pB0, 8), PKW(pB0, 10), PKW(pB0, 12), PKW(pB0, 14)}; pw2 = (u32x4){PKW(pB1, 0), PKW(pB1, 2), PKW(pB1, 4), PKW(pB1, 6)}; pw3 = (u32x4){PKW(pB1, 8), PKW(pB1, 10), PKW(pB1, 12), PKW(pB1, 14)};
      SBAR(); pv(o, vb0 + sl_cur, PAF(0), PAF(1), PAF(2), PAF(3)); }
#undef PKW
#undef PAF
#undef VFR
#undef PIN
#undef MX3
#undef GAPA
#undef GAPB
#undef EX
#undef VRD
#undef KRD
#undef STEP
#undef ENDW
    { auto rr = __builtin_amdgcn_permlane32_swap(__float_as_uint(l_reg), __float_as_uint(l_reg), false, false); l_reg = __uint_as_float(rr[0]) + __uint_as_float(rr[1]); }
    if (hi == 0) wsf[32 + r32] = l_reg; asm volatile("s_waitcnt lgkmcnt(0)" ::: "memory");
    float rli[16];
#pragma unroll
    for (int r = 0; r < 16; ++r) rli[r] = __builtin_amdgcn_rcpf(wsf[32 + crow(r, hi)]);
    h16* Ow = O + (rowbase + q0 + wid * QBLK) * DMP + h * D;
    const h16* Gw = G + (rowbase + q0 + wid * QBLK) * DMP + h * D;
    { h16* stg = (h16*)(shm + LDS_OST) + wid * 2048;
#pragma unroll
      for (int r = 0; r < 16; ++r) { const int orow = crow(r, hi);
#pragma unroll
        for (int d0 = 0; d0 < 2; ++d0) stg[orow * 64 + d0 * 32 + r32] = (h16)(o[d0][r] * rli[r]); }
      asm volatile("s_waitcnt lgkmcnt(0)" ::: "memory");
#pragma unroll
      for (int i = 0; i < 4; ++i) { const int row = i * 8 + (lane >> 3), ch = lane & 7; const f16x8 v = *(const f16x8*)(stg + row * 64 + ch * 8); const f16x8 g = *(const f16x8*)(Gw + (long)row * DMP + ch * 8);
        float r8[8];
#pragma unroll
        for (int e = 0; e < 8; ++e) { const float gg = (float)g[e]; r8[e] = (float)v[e] * __builtin_amdgcn_rcpf(1.0f + __builtin_amdgcn_exp2f(-gg * LOG2E)); }
        u32x4 w; w.x = pk2h(r8[0], r8[1]); w.y = pk2h(r8[2], r8[3]); w.z = pk2h(r8[4], r8[5]); w.w = pk2h(r8[6], r8[7]);
        *(u32x4*)(Ow + (long)row * DMP + ch * 8) = w; } }
    asm volatile("s_waitcnt lgkmcnt(0)\n\ts_barrier" ::: "memory");
#undef DMA_K
#undef DMA_V
#undef CMASK
#undef START
#undef RESC
#undef ROT
#undef QE
#undef KE
#undef SETM
}
#undef SBAR
#undef WAIT_BAR
#undef MF16
#undef MF8
}
constexpr int NWAVES = 8;
#ifndef MK_N_LAUNCHES
#define MK_N_LAUNCHES 1
#endif
constexpr int NSUB = 9;
constexpr int NPHASE = 2 + NSUB * DEPTH;
constexpr size_t MiB = 1u << 20;
constexpr size_t WS_CTL = 0, CTL_ZERO_BYTES = 1 * MiB;
constexpr size_t SZ_WFOX = (size_t)4096 * 1024 * 2, SZ_WFO = (size_t)1024 * 1024 * 2, SZ_WRET = (size_t)6144 * 1024 * 2, SZ_WRO = (size_t)1024 * 2048 * 2;
constexpr size_t SZ_WGU = (size_t)1024 * 1024 * 2, SZ_WD = (size_t)1024 * 512 * 2;
constexpr size_t WS_WFOX = 1 * MiB, WS_WFO = WS_WFOX + 2 * SZ_WFOX, WS_WRET = WS_WFO + 2 * SZ_WFO, WS_WRO = WS_WRET + 2 * SZ_WRET;
constexpr size_t WS_WGU = WS_WRO + 2 * SZ_WRO, WS_WD = WS_WGU + (size_t)DEPTH * NE * SZ_WGU, WS_WEND = WS_WD + (size_t)DEPTH * NE * SZ_WD;
constexpr size_t SZ_RW = (size_t)32 * 64 * 24 * 2, SZ_FW = (size_t)32 * 64 * 8 * 2;
constexpr size_t WS_RW = WS_WEND, WS_FW = WS_RW + DEPTH * SZ_RW, WS_ROPE = WS_FW + 2 * SZ_FW;
constexpr size_t WS_H = WS_ROPE + 2 * (size_t)SEQ * 128 * 4;
constexpr size_t WS_HN = WS_H + (size_t)T * DM * 4;
constexpr size_t WS_RSTD = WS_HN + (size_t)(T + 8) * DM * 2;
constexpr size_t WS_FLOG = WS_RSTD + (size_t)T * 4, WS_CUM = WS_FLOG + (size_t)T * 16 * 4;
constexpr size_t WS_EID = WS_CUM + (size_t)BATCH * FOX_H * SEQ * 4, WS_RANK = WS_EID + PAIRS * 4, WS_GATE = WS_RANK + PAIRS * 4, WS_LIST = WS_GATE + PAIRS * 4;
constexpr size_t WS_QKVG = (WS_LIST + (size_t)NE * LISTCAP * 4 + 255) & ~(size_t)255;
constexpr size_t SZ_T1K = (size_t)T * 1024 * 2;
constexpr size_t WS_OG = WS_QKVG + 6 * SZ_T1K;
constexpr size_t WS_RO = WS_OG + 2 * SZ_T1K;
constexpr size_t WS_END0 = WS_RO + 2 * SZ_T1K;
constexpr size_t WS_DUMMY = WS_END0;
constexpr size_t WS_END = WS_DUMMY + 160 * MiB;
constexpr size_t WS_Y = WS_QKVG;
constexpr size_t WS_ACT = WS_RO;
static_assert((size_t)PROWS * 1024 * 2 <= 6 * SZ_T1K && (size_t)PROWS * 512 * 2 <= 2 * SZ_T1K, "overlays");
constexpr int CW_TMO = 0, CW_BAR = 4096, CW_CNT = 16384, CW_CNT2 = 16384 + 1024;
constexpr int RING_BYTES = 147456;
constexpr int LDSCTL_OFF = RING_BYTES, MISC_OFF = LDSCTL_OFF;
constexpr int LDS_BYTES = RING_BYTES + 1024;

typedef GAS unsigned gu32;
__device__ __forceinline__ int lane_id_() { return (int)__builtin_amdgcn_mbcnt_hi(~0u, __builtin_amdgcn_mbcnt_lo(~0u, 0u)); }
#define TID0() (wave_sgpr == 0 && lane_id_() == 0)
#define RLX_AGENT __ATOMIC_RELAXED, __HIP_MEMORY_SCOPE_AGENT
#define LDS_WAIT() asm volatile("s_waitcnt lgkmcnt(0)" ::: "memory")

#define XB_TMO      128
#define XB_XCNT(j)  (256  + 64 * (j))
#define XB_XSUB(j)  (1280 + 64 * (j))
#define XB_XGEN(j)  (2304 + 64 * (j))
#define XB_TOP      3328
#define XB_TOPGEN   3392
#define XCD_BAR_WORDS 3456
#define XB_SPIN_CAP (1u << 18)
__device__ __forceinline__ unsigned xb_ld(unsigned* p)              { return __hip_atomic_load(p, __ATOMIC_RELAXED, __HIP_MEMORY_SCOPE_AGENT); }
__device__ __forceinline__ unsigned xb_add(unsigned* p, unsigned v) { return __hip_atomic_fetch_add(p, v, __ATOMIC_RELAXED, __HIP_MEMORY_SCOPE_AGENT); }
__device__ __forceinline__ unsigned xb_xcc_id() { return (unsigned)__builtin_amdgcn_s_getreg((3 << 11) | 20) & 0xFu; }
#define XB_SPIN(cond, bar) do { unsigned _sp = 0; while (cond) { __builtin_amdgcn_s_sleep(1); \
    if ((++_sp & 255u) == 0u) { if (xb_ld(&(bar)[XB_TMO])) break; if (_sp > XB_SPIN_CAP) { atomicAdd(&(bar)[XB_TMO], 1u); break; } } } } while (0)
struct XcdBarrier { unsigned* bar; unsigned x; volatile LAS unsigned* st; };
__device__ __forceinline__ XcdBarrier xcd_barrier_post(unsigned* bar, volatile LAS unsigned* st, const int wave_sgpr) {
    XcdBarrier b; b.bar = bar; b.x = xb_xcc_id(); b.st = st;
    if (TID0()) (void)xb_add(&bar[XB_XCNT(b.x)], 1u);
    return b;
}
__device__ __forceinline__ void xcd_barrier_complete(unsigned* bar, unsigned x, unsigned& nloc, unsigned& nx) {
    const unsigned G = gridDim.x * gridDim.y * gridDim.z;
    unsigned sum, cnt, mine, sp = 0u;
    for (;;) {
        sum = 0u; cnt = 0u; mine = 0u;
#pragma unroll
        for (unsigned j = 0; j < 16; ++j) { const unsigned c = xb_ld(&bar[XB_XCNT(j)]); sum += c; cnt += (c > 0u) ? 1u : 0u; mine = (j == x) ? c : mine; }
        if (sum == G) break;
        __builtin_amdgcn_s_sleep(1);
        if ((++sp & 255u) == 0u) { if (xb_ld(&bar[XB_TMO])) break; if (sp > XB_SPIN_CAP) { atomicAdd(&bar[XB_TMO], 1u); break; } }
    }
    nloc = mine > 0u ? mine : 1u; nx = cnt > 0u ? cnt : 1u;
}
__device__ __forceinline__ void xcd_barrier(const XcdBarrier& b, const bool leader) {
    asm volatile("s_waitcnt vmcnt(0)" ::: "memory");
    __syncthreads();
    if (leader) {
        unsigned* bar = b.bar;
        __builtin_amdgcn_s_waitcnt(0);
        unsigned nloc = b.st[0], nx = b.st[1];
        if (nloc == 0u) { xcd_barrier_complete(bar, b.x, nloc, nx); b.st[0] = nloc; b.st[1] = nx; }
        const unsigned old = xb_add(&bar[XB_XSUB(b.x)], 1u);
        const unsigned gen = old / nloc;
        if (old + 1u == (gen + 1u) * nloc) {
            __builtin_amdgcn_fence(__ATOMIC_RELEASE, "agent");
            asm volatile("s_waitcnt vmcnt(0)" ::: "memory");
            const unsigned og = xb_add(&bar[XB_TOP], 1u);
            const unsigned tg = og / nx;
            if (og + 1u == (tg + 1u) * nx) xb_add(&bar[XB_TOPGEN], 1u);
            else XB_SPIN(xb_ld(&bar[XB_TOPGEN]) == tg, bar);
            __builtin_amdgcn_fence(__ATOMIC_ACQUIRE, "agent");
            xb_add(&bar[XB_XGEN(b.x)], 1u);
            asm volatile("s_waitcnt vmcnt(0)" ::: "memory");
        } else {
            XB_SPIN(xb_ld(&bar[XB_XGEN(b.x)]) == gen, bar);
            __builtin_amdgcn_fence(__ATOMIC_ACQUIRE, "agent");
            asm volatile("s_waitcnt vmcnt(0)" ::: "memory");
        }
    }
    __syncthreads();
}

struct Args { const float* in[16]; float* out; unsigned char* ws; int ph_lo, ph_hi, li, pad; };

template <bool GU>
__device__ __forceinline__ void transpose_item(const float* W, int K, int ld, h16* WT, LAS float* scr, int kb, int nb, int lane) {
    const int k0 = 64 * kb, n0 = 64 * nb;
    const int lc = (lane & 15) * 4;
    const int srccol = GU ? ((lc < 32) ? (n0 / 2 + lc) : (512 + n0 / 2 + (lc - 32))) : (n0 + lc);
#pragma unroll 4
    for (int it = 0; it < 16; ++it) { const int kk = 4 * it + (lane >> 4);
        const f32x4 v = *(const f32x4*)(W + (size_t)(k0 + kk) * ld + srccol);
        scr[kk * 65 + lc + 0] = v[0]; scr[kk * 65 + lc + 1] = v[1]; scr[kk * 65 + lc + 2] = v[2]; scr[kk * 65 + lc + 3] = v[3]; }
    LDS_WAIT(); asm volatile("" ::: "memory");
    const int c = lane & 7;
#pragma unroll
    for (int j = 0; j < 8; ++j) { const int nn = 8 * j + (lane >> 3);
        const int cc = GU ? (((nn & 7) < 4) ? (4 * (nn >> 3) + (nn & 7)) : (32 + 4 * (nn >> 3) + ((nn & 7) - 4))) : nn;
        const LAS float* s = scr + (8 * c) * 65 + cc;
        u32x4 o; o.x = pk2h(s[0 * 65], s[1 * 65]); o.y = pk2h(s[2 * 65], s[3 * 65]); o.z = pk2h(s[4 * 65], s[5 * 65]); o.w = pk2h(s[6 * 65], s[7 * 65]);
        *(GAS u32x4*)(WT + (size_t)(n0 + nn) * K + k0 + 8 * c) = o; }
    LDS_WAIT(); asm volatile("" ::: "memory");
}

__device__ __forceinline__ float shfl_idx(float v, int src) { return __int_as_float(__builtin_amdgcn_ds_bpermute(src << 2, __float_as_int(v))); }
__device__ __forceinline__ float wave_sum(float v, int lane) {
#pragma unroll
    for (int o = 1; o < 64; o <<= 1) v += shfl_idx(v, lane ^ o);
    return v;
}
__device__ __forceinline__ void rope_cs(int pos, int m, float& c, float& s) {
    const float e = -(float)m * (13.287712379549449f / 127.0f);
    const float inv = exp2f(e);
    const float ang = (float)pos * inv;
    const float k = rintf(ang * 0.6366197723675814f);
    float r = fmaf(-k, 1.5703125f, ang); r = fmaf(-k, 4.837512969970703125e-4f, r); r = fmaf(-k, 7.54978995489188216e-8f, r);
    const float z = r * r;
    const float sp = fmaf(r * z, fmaf(z, fmaf(z, -1.9515295891e-4f, 8.3321608736e-3f), -1.6666654611e-1f), r);
    const float cp = fmaf(z * z, fmaf(z, fmaf(z, 2.443315711809948e-5f, -1.388731625493765e-3f), 4.166664568298827e-2f), fmaf(z, -0.5f, 1.0f));
    const int q = ((int)k) & 3;
    c = (q == 0) ? cp : (q == 1) ? -sp : (q == 2) ? -cp : sp;
    s = (q == 0) ? sp : (q == 1) ? cp : (q == 2) ? -sp : -cp;
}
#ifndef PROBE_AMP2
#define PROBE_AMP2 8
#endif
#if defined(PROBE_A) && defined(PROBE_B)
#define PROBE_MARK(id) do { if ((id) == PROBE_A || (id) == PROBE_B) { if (blockIdx.x == 0 && __builtin_amdgcn_readfirstlane(threadIdx.x) == 0 && lane_id_() == 0) { \
    volatile LAS unsigned* pm_ = (volatile LAS unsigned*)(size_t)(MISC_OFF + 800); if ((id) == PROBE_A) pm_[0] = (unsigned)__builtin_amdgcn_s_memrealtime(); if ((id) == PROBE_B) pm_[1] = (unsigned)__builtin_amdgcn_s_memrealtime(); } } } while (0)
#else
#define PROBE_MARK(id) do {} while (0)
#endif
struct RowArgs {
    const float* src; float* h; h16* hn; float* rstd; const float* gnorm;
    const h16* y; const int* eidp; const int* rankp; const float* gatep;
    const h16* tabh; const float* bias0; const float* bias1; float* flog;
    int* eid; int* rank; float* gate; unsigned* counts; int* list;
};
template <bool COMBINE, bool STORE_H, int NT_>
__device__ __forceinline__ void row_pass(const RowArgs& A, int g, bool valid, int lane, int ch, int wave, LAS float* xch, LAS float* scr, LAS unsigned* blk, const volatile LAS unsigned* padstart) {
    const int r = lane & 15, kq = lane >> 4; const int t = 16 * g + r;
    constexpr int NA = NT_ > 0 ? NT_ : 1;
    f32x4 acc[NA];
#pragma unroll
    for (int i = 0; i < NA; ++i) acc[i] = (f32x4){0.f, 0.f, 0.f, 0.f};
    float ss = 0.f; float bia[NA];
#pragma unroll
    for (int i = 0; i < NA; ++i) bia[i] = 0.f;
    if (NT_ == 3) { if (wave == 0) blk[lane] = 0u; }
    if (NT_ == 3) PROBE_MARK(61);
    if (valid) {
        if (NT_ == 1) bia[0] = A.bias0[r];
        if (NT_ == 3) { bia[0] = A.bias1[r]; bia[1] = A.bias1[16 + r]; bia[2] = A.bias0[r & 3]; }
        const float* srow = A.src + (size_t)t * DM + 8 * kq + 512 * ch; float* hrow = A.h + (size_t)t * DM + 8 * kq + 512 * ch; h16* nrow = A.hn + (size_t)t * DM + 8 * kq + 512 * ch;
        const h16* y0 = nullptr; const h16* y1 = nullptr; float g0 = 0.f, g1 = 0.f;
        if (COMBINE) { const int e0 = A.eidp[2 * t], e1 = A.eidp[2 * t + 1]; const int p0 = (int)padstart[e0] + A.rankp[2 * t], p1 = (int)padstart[e1] + A.rankp[2 * t + 1];
            g0 = A.gatep[2 * t]; g1 = A.gatep[2 * t + 1]; y0 = A.y + (size_t)p0 * DM + 8 * kq + 512 * ch; y1 = A.y + (size_t)p1 * DM + 8 * kq + 512 * ch; }
        const float* gnp = A.gnorm + 8 * kq + 512 * ch;
        const h16* tabp = A.tabh + ((size_t)(16 * ch) * 64 + lane) * (8 * NA);
#pragma unroll 4
        for (int it = 0; it < 16; ++it) {
            f32x4 v0 = *(const f32x4*)(srow + 32 * it), v1 = *(const f32x4*)(srow + 32 * it + 4);
            if (COMBINE) { const f16x8 a = *(const f16x8*)(y0 + 32 * it), b = *(const f16x8*)(y1 + 32 * it);
#pragma unroll
                for (int q = 0; q < 4; ++q) { v0[q] += (float)a[q] * g0 + (float)b[q] * g1; v1[q] += (float)a[4 + q] * g0 + (float)b[4 + q] * g1; } }
            if (STORE_H) { *(f32x4*)(hrow + 32 * it) = v0; *(f32x4*)(hrow + 32 * it + 4) = v1; }
            ss += (v0[0] * v0[0] + v0[1] * v0[1]) + (v0[2] * v0[2] + v0[3] * v0[3]) + (v1[0] * v1[0] + v1[1] * v1[1]) + (v1[2] * v1[2] + v1[3] * v1[3]);
            const f32x4 gn0 = *(const f32x4*)(gnp + 32 * it), gn1 = *(const f32x4*)(gnp + 32 * it + 4);
            const f32x4 a0 = v0 * gn0, a1 = v1 * gn1;
            u32x4 w; w.x = pk2h(a0[0], a0[1]); w.y = pk2h(a0[2], a0[3]); w.z = pk2h(a1[0], a1[1]); w.w = pk2h(a1[2], a1[3]);
            *(u32x4*)(nrow + 32 * it) = w;
            if (NT_ > 0) {
                const h16* tp = tabp + (size_t)it * 64 * 8 * NA;
                const f16x8 af = __builtin_bit_cast(f16x8, w);
#pragma unroll
                for (int tl = 0; tl < NT_; ++tl) acc[tl] = __builtin_amdgcn_mfma_f32_16x16x32_f16(af, *(const f16x8*)(tp + 8 * tl), acc[tl], 0, 0, 0);
            }
        }
        ss += shfl_idx(ss, lane ^ 16); ss += shfl_idx(ss, lane ^ 32);
        if (NT_ == 3) PROBE_MARK(62);
        if (ch == 1) { xch[lane] = ss;
#pragma unroll
            for (int tl = 0; tl < NT_; ++tl)
#pragma unroll
                for (int q = 0; q < 4; ++q) xch[64 * (1 + 4 * tl + q) + lane] = acc[tl][q]; }
    }
    __syncthreads();
    if (NT_ == 3) PROBE_MARK(63);
    int e0 = 0, e1 = 0, lr0 = 0, lr1 = 0; float ga = 0.f, gb = 0.f;
    if (valid && ch == 0) {
        ss += xch[lane];
#pragma unroll
        for (int tl = 0; tl < NT_; ++tl)
#pragma unroll
            for (int q = 0; q < 4; ++q) acc[tl][q] += xch[64 * (1 + 4 * tl + q) + lane];
        const float rs = 1.0f / sqrtf(ss * (1.0f / DM) + EPS);
        if (kq == 0) A.rstd[t] = rs;
        if (NT_ > 0) {
            float rst[4];
#pragma unroll
            for (int q = 0; q < 4; ++q) rst[q] = shfl_idx(rs, 4 * kq + q);
            if (NT_ == 1) {
#pragma unroll
                for (int q = 0; q < 4; ++q) A.flog[(size_t)(16 * g + 4 * kq + q) * 16 + r] = acc[0][q] * rst[q] + bia[0];
            } else {
#pragma unroll
                for (int tl = 0; tl < NT_; ++tl)
#pragma unroll
                    for (int q = 0; q < 4; ++q) scr[(4 * kq + q) * 48 + 16 * tl + r] = acc[tl][q] * rst[q] + bia[tl];
                LDS_WAIT(); asm volatile("" ::: "memory");
                if (lane < 16) {
                    const LAS float* sr = scr + r * 48;
                    float gl[4];
#pragma unroll
                    for (int q = 0; q < 4; ++q) gl[q] = sr[32 + q];
                    int gi = 0; float gmax = gl[0];
#pragma unroll
                    for (int q = 1; q < 4; ++q) if (gl[q] > gmax) { gmax = gl[q]; gi = q; }
                    float gs = 0.f;
#pragma unroll
                    for (int q = 0; q < 4; ++q) gs += __expf(gl[q] - gmax);
                    const float pg = 1.0f / gs;
                    float el[8];
#pragma unroll
                    for (int e = 0; e < 8; ++e) el[e] = sr[gi * 8 + e];
                    int i0 = 0; float emax = el[0];
#pragma unroll
                    for (int e = 1; e < 8; ++e) if (el[e] > emax) { emax = el[e]; i0 = e; }
                    int i1 = -1; float b1 = -3.0e38f;
#pragma unroll
                    for (int e = 0; e < 8; ++e) if (e != i0 && el[e] > b1) { b1 = el[e]; i1 = e; }
                    const float p1 = __expf(b1 - emax);
                    ga = pg / (1.0f + p1); gb = pg * p1 / (1.0f + p1);
                    e0 = gi * 8 + i0; e1 = gi * 8 + i1;
                    lr0 = (int)__hip_atomic_fetch_add(blk + e0, 1u, __ATOMIC_RELAXED, __HIP_MEMORY_SCOPE_WORKGROUP);
                    lr1 = (int)__hip_atomic_fetch_add(blk + e1, 1u, __ATOMIC_RELAXED, __HIP_MEMORY_SCOPE_WORKGROUP);
                }
            }
        }
    }
    if (NT_ == 3) {
        __syncthreads();
        if (wave == 0 && lane < NE) { const unsigned c = blk[lane]; unsigned base = 0u; if (c) base = atomicAdd(A.counts + lane, c); blk[32 + lane] = base; }
        __syncthreads();
        if (valid && ch == 0 && lane < 16) {
            const int r0 = (int)blk[32 + e0] + lr0, r1 = (int)blk[32 + e1] + lr1;
            A.list[e0 * LISTCAP + r0] = 2 * t; A.list[e1 * LISTCAP + r1] = 2 * t + 1;
            A.eid[2 * t] = e0; A.eid[2 * t + 1] = e1; A.rank[2 * t] = r0; A.rank[2 * t + 1] = r1; A.gate[2 * t] = ga; A.gate[2 * t + 1] = gb;
        }
    }
    if (NT_ == 3) PROBE_MARK(64);
    __syncthreads();
    if (NT_ == 3) PROBE_MARK(65);
}
template <bool COMBINE, bool STORE_H, int NT_>
__device__ __forceinline__ void row_pass_all(const RowArgs& A, int vcu, int G, int wave, int lane, LAS unsigned char* lds, const volatile LAS unsigned* padstart) {
    const int pr = wave & 3, ch = wave >> 2;
    LAS float* xch = (LAS float*)(lds + pr * 4096); LAS float* scr = (LAS float*)(lds + 16384 + pr * 4096); LAS unsigned* blk = (LAS unsigned*)(lds + 32768);
    for (int base = 0; base < T / 16; base += 4 * G) { const int g = base + pr * G + vcu; row_pass<COMBINE, STORE_H, NT_>(A, g, g < T / 16, lane, ch, wave, xch, scr, blk, padstart); }
}
__device__ __forceinline__ void final_row(const float* h, const h16* y, const int* eidp, const int* rankp, const float* gatep, const volatile LAS unsigned* padstart, const float* gf, float* out, int t, int lane) {
    const int e0 = eidp[2 * t], e1 = eidp[2 * t + 1]; const int p0 = (int)padstart[e0] + rankp[2 * t], p1 = (int)padstart[e1] + rankp[2 * t + 1];
    const float g0 = gatep[2 * t], g1 = gatep[2 * t + 1];
    const f32x4* hr = (const f32x4*)(h + (size_t)t * DM) + lane; const f16x4* ya = (const f16x4*)(y + (size_t)p0 * DM) + lane; const f16x4* yb = (const f16x4*)(y + (size_t)p1 * DM) + lane;
    f32x4 v[4]; float s = 0.f;
#pragma unroll
    for (int j = 0; j < 4; ++j) { const f16x4 a = ya[64 * j], b = yb[64 * j]; v[j] = hr[64 * j];
#pragma unroll
        for (int q = 0; q < 4; ++q) v[j][q] += (float)a[q] * g0 + (float)b[q] * g1;
        s += (v[j][0] * v[j][0] + v[j][1] * v[j][1]) + (v[j][2] * v[j][2] + v[j][3] * v[j][3]); }
    const float rs = 1.0f / sqrtf(wave_sum(s, lane) * (1.0f / DM) + EPS);
    f32x4* o = (f32x4*)(out + (size_t)t * DM) + lane;
#pragma unroll
    for (int j = 0; j < 4; ++j) o[64 * j] = v[j] * rs * ((const f32x4*)gf)[lane + 64 * j];
}
__device__ __forceinline__ void ret_gn_item(const h16* ro, const h16* gate, const float* gain, h16* og, int w, int lane) {
    const int t = w >> 2, h = w & 3;
    const f16x8 ov = *(const f16x8*)(ro + (size_t)t * 2048 + h * 512 + lane * 8);
    const f16x8 gv = *(const f16x8*)(gate + (size_t)(h >> 1) * T * 1024 + (size_t)t * 1024 + (h & 1) * 512 + lane * 8);
    float v[8]; float s = 0.f;
#pragma unroll
    for (int j = 0; j < 8; ++j) { v[j] = (float)ov[j]; s += v[j]; }
    const float mu = wave_sum(s, lane) * (1.0f / RET_DV); float q = 0.f;
#pragma unroll
    for (int j = 0; j < 8; ++j) { v[j] -= mu; q += v[j] * v[j]; }
    const float rs = 1.0f / sqrtf(wave_sum(q, lane) * (1.0f / RET_DV) + EPS);
    const f32x4 ga = *(const f32x4*)(gain + h * 512 + lane * 8), gb = *(const f32x4*)(gain + h * 512 + lane * 8 + 4);
    float o[8];
#pragma unroll
    for (int j = 0; j < 8; ++j) { const float gg = (float)gv[j]; const float gn = (j < 4) ? ga[j & 3] : gb[j & 3];
        o[j] = v[j] * rs * gn * gg * __builtin_amdgcn_rcpf(1.0f + __builtin_amdgcn_exp2f(-gg * LOG2E)); }
    u32x4 wv; wv.x = pk2h(o[0], o[1]); wv.y = pk2h(o[2], o[3]); wv.z = pk2h(o[4], o[5]); wv.w = pk2h(o[6], o[7]);
    *(u32x4*)(og + (size_t)t * 2048 + h * 512 + lane * 8) = wv;
}

namespace ret_body {
constexpr int KLP = 528, VLP = 144, RLP = 528;
constexpr int OFF_KL = 0, OFF_VL = 128 * KLP, OFF_VD = OFF_VL + 128 * VLP, OFF_RL = OFF_VD + 128 * VLP, END = OFF_RL + 64 * RLP, OFF_OS = 0;
static_assert(END <= RING_BYTES, "retention LDS");
#define MF16(a, b, c) __builtin_amdgcn_mfma_f32_32x32x16_f16(a, b, c, 0, 0, 0)
__device__ __forceinline__ int crow(int r, int hi) { return (r & 3) + 8 * (r >> 2) + 4 * hi; }
typedef short v4i16_t __attribute__((ext_vector_type(4)));
__device__ __forceinline__ s16x4 vtr(LAS const char* p) { return __builtin_bit_cast(s16x4, __builtin_amdgcn_ds_read_tr16_b64_v4i16((LAS v4i16_t*)p)); }
__device__ __forceinline__ f16x8 mk8(s16x4 lo, s16x4 hi) { typedef short s16x8 __attribute__((ext_vector_type(8))); s16x8 t = {lo[0], lo[1], lo[2], lo[3], hi[0], hi[1], hi[2], hi[3]}; return __builtin_bit_cast(f16x8, t); }
__device__ __forceinline__ f16x8 pack8(const f32x16& S, int b) { u32x4 w; w.x = pk2h(S[b], S[b + 1]); w.y = pk2h(S[b + 2], S[b + 3]); w.z = pk2h(S[b + 4], S[b + 5]); w.w = pk2h(S[b + 6], S[b + 7]); return __builtin_bit_cast(f16x8, w); }
__device__ __forceinline__ void s_item(int b, int h, int n, const h16* __restrict__ Qr, const h16* __restrict__ Kr, u32x4* __restrict__ SF, const int tid) {
    const int lane = tid & 63, r32 = lane & 31, hi = lane >> 5; const int wid = __builtin_amdgcn_readfirstlane(tid >> 6);
    const int wi = wid & 3, wj = wid >> 2;
    if (wj == 1 && wi < 2) return;
    const float lg2 = log2f(1.0f - exp2f(-5.0f - (float)h));
    const size_t t0 = (size_t)b * SEQ + (size_t)n * 128;
    const h16* qp = Qr + (t0 + 32 * wi + r32) * 1024 + h * 256 + 8 * hi;
    const h16* kp = Kr + (t0 + 64 * wj + r32) * 1024 + h * 256 + 8 * hi;
    f32x16 S0 = {}, S1 = {};
#pragma unroll 4
    for (int s = 0; s < 16; ++s) { const f16x8 qf = *(const f16x8*)(qp + 16 * s), a0 = *(const f16x8*)(kp + 16 * s), a1 = *(const f16x8*)(kp + 32 * 1024 + 16 * s);
        S0 = MF16(a0, qf, S0); S1 = MF16(a1, qf, S1); }
    const int ig = 32 * wi + r32;
#pragma unroll
    for (int r = 0; r < 16; ++r) { const int j0 = 64 * wj + crow(r, hi), j1 = j0 + 32;
        S0[r] = (ig >= j0) ? S0[r] * __builtin_amdgcn_exp2f(lg2 * (float)(ig - j0)) : 0.f;
        S1[r] = (ig >= j1) ? S1[r] * __builtin_amdgcn_exp2f(lg2 * (float)(ig - j1)) : 0.f; }
    u32x4* o = SF + ((size_t)((b * RET_H + h) * (SEQ / 128) + n) * 8 + wid) * 4 * 64 + lane;
    o[0] = __builtin_bit_cast(u32x4, pack8(S0, 0)); o[64] = __builtin_bit_cast(u32x4, pack8(S0, 8)); o[128] = __builtin_bit_cast(u32x4, pack8(S1, 0)); o[192] = __builtin_bit_cast(u32x4, pack8(S1, 8));
}
__device__ __forceinline__ void ret_item(int b, int h, int sl, const h16* __restrict__ Qr, const h16* __restrict__ Kr, const h16* __restrict__ Vb, const u32x4* __restrict__ SF, h16* __restrict__ O, LAS unsigned char* lds, const int tid_arg) {
    int tid_in = tid_arg; asm volatile("" : "+v"(tid_in));
    const float lg2 = log2f(1.0f - exp2f(-5.0f - (float)h));
    const float cd = exp2f(128.0f * lg2);
    f32x16 R0 = {}, R1 = {};
    u32x4 kreg[8]; f16x8 vreg[2];
    { const size_t t0 = (size_t)b * SEQ;
#pragma unroll
      for (int i = 0; i < 8; ++i) { const int p = tid_in + 512 * i, j = p >> 5, c16 = p & 31; kreg[i] = *(const u32x4*)(Kr + (t0 + j) * 1024 + h * 256 + c16 * 8); }
#pragma unroll
      for (int i = 0; i < 2; ++i) { const int p = tid_in + 512 * i, j = p >> 3, c16 = p & 7; vreg[i] = *(const f16x8*)(Vb + (t0 + j) * 1024 + c16 * 8); } }
    for (int n = 0; n < SEQ / 128; ++n) {
        int tid = tid_in; asm volatile("" : "+v"(tid));
        const int lane = tid & 63, r32 = lane & 31, hi = lane >> 5; const int wid = __builtin_amdgcn_readfirstlane(tid >> 6);
        const int wi = wid & 3, wj = wid >> 2;
        const bool act_s = !(wj == 1 && wi < 2);
        const int trq = (lane & 15) >> 2, trp = lane & 3, trg = (lane >> 4) & 1;
        const size_t t0 = (size_t)b * SEQ + (size_t)n * 128;
        if (n == 8) PROBE_MARK(71);
        f16x8 qh[8]; u32x4 sfr[4];
        if (n > 0) { const h16* qp = Qr + (t0 + 32 * wi + r32) * 1024 + h * 256 + 8 * hi + 128 * wj;
#pragma unroll
            for (int s = 0; s < 8; ++s) qh[s] = *(const f16x8*)(qp + 16 * s); }
        if (act_s) { const u32x4* sp = SF + ((size_t)((b * RET_H + h) * (SEQ / 128) + n) * 8 + wid) * 4 * 64 + lane;
#pragma unroll
            for (int f = 0; f < 4; ++f) sfr[f] = sp[64 * f]; }
#pragma unroll
        for (int i = 0; i < 8; ++i) { const int p = tid + 512 * i, j = p >> 5, c16 = p & 31; *(LAS u32x4*)(lds + OFF_KL + j * KLP + c16 * 16) = kreg[i]; }
#pragma unroll
        for (int i = 0; i < 2; ++i) { const int p = tid + 512 * i, j = p >> 3, c16 = p & 7; const f16x8 v = vreg[i];
            *(LAS f16x8*)(lds + OFF_VL + j * VLP + c16 * 16) = v;
            const float kd = __builtin_amdgcn_exp2f(lg2 * (float)(127 - j));
            u32x4 w; w.x = pk2h((float)v[0] * kd, (float)v[1] * kd); w.y = pk2h((float)v[2] * kd, (float)v[3] * kd); w.z = pk2h((float)v[4] * kd, (float)v[5] * kd); w.w = pk2h((float)v[6] * kd, (float)v[7] * kd);
            *(LAS u32x4*)(lds + OFF_VD + j * VLP + c16 * 16) = w; }
        __syncthreads();
        if (n + 1 < SEQ / 128) {
            const size_t t1 = t0 + 128;
#pragma unroll
            for (int i = 0; i < 8; ++i) { const int p = tid + 512 * i, j = p >> 5, c16 = p & 31; kreg[i] = *(const u32x4*)(Kr + (t1 + j) * 1024 + h * 256 + c16 * 8); }
#pragma unroll
            for (int i = 0; i < 2; ++i) { const int p = tid + 512 * i, j = p >> 3, c16 = p & 7; vreg[i] = *(const f16x8*)(Vb + (t1 + j) * 1024 + c16 * 8); }
        }
        __builtin_amdgcn_sched_barrier(0);
        if (n == 8) PROBE_MARK(72);
        f32x16 OT0 = {}, OT1 = {};
        if (n > 0) {
            const LAS unsigned char* rp = lds + OFF_RL + r32 * RLP + 16 * hi + 256 * wj;
#pragma unroll
            for (int s = 0; s < 8; ++s) { const f16x8 a0 = *(const LAS f16x8*)(rp + 32 * s), a1 = *(const LAS f16x8*)(rp + 32 * RLP + 32 * s);
                OT0 = MF16(a0, qh[s], OT0); OT1 = MF16(a1, qh[s], OT1); if ((s & 3) == 3) __builtin_amdgcn_sched_barrier(0); }
            const float qd = __builtin_amdgcn_exp2f(lg2 * (float)(32 * wi + r32 + 1));
#pragma unroll
            for (int r = 0; r < 16; ++r) { OT0[r] *= qd; OT1[r] *= qd; }
        }
        __builtin_amdgcn_sched_barrier(0);
        if (n == 8) PROBE_MARK(73);
        if (act_s) {
#pragma unroll
            for (int jt = 0; jt < 2; ++jt)
#pragma unroll
                for (int s2 = 0; s2 < 2; ++s2) {
                    const int jb = 64 * wj + 32 * jt + 16 * s2 + 4 * hi + trq;
                    const LAS char* vp = (const LAS char*)(lds + OFF_VL + jb * VLP + (16 * trg + 4 * trp) * 2);
                    const f16x8 v0 = mk8(vtr(vp), vtr(vp + 8 * VLP)), v1 = mk8(vtr(vp + 64), vtr(vp + 64 + 8 * VLP));
                    const f16x8 sfv = __builtin_bit_cast(f16x8, sfr[2 * jt + s2]);
                    OT0 = MF16(v0, sfv, OT0); OT1 = MF16(v1, sfv, OT1); }
        }
        __builtin_amdgcn_sched_barrier(0);
        if (n == 8) PROBE_MARK(74);
#pragma unroll
        for (int r = 0; r < 16; ++r) { R0[r] *= cd; R1[r] *= cd; }
#pragma unroll
        for (int s = 0; s < 8; ++s) {
            const int jb = 16 * s + 8 * hi + trq;
            const LAS char* kp = (const LAS char*)(lds + OFF_KL + jb * KLP + (32 * wid + 16 * trg + 4 * trp) * 2);
            const LAS char* vp = (const LAS char*)(lds + OFF_VD + jb * VLP + (16 * trg + 4 * trp) * 2);
            const f16x8 ka = mk8(vtr(kp), vtr(kp + 4 * KLP));
            const f16x8 v0 = mk8(vtr(vp), vtr(vp + 4 * VLP)), v1 = mk8(vtr(vp + 64), vtr(vp + 64 + 4 * VLP));
            R0 = MF16(ka, v0, R0); R1 = MF16(ka, v1, R1); if ((s & 1) == 1) __builtin_amdgcn_sched_barrier(0); }
        if (n == 8) PROBE_MARK(75);
        __syncthreads();
        if (n == 8) PROBE_MARK(76);
        {
#pragma unroll
            for (int g4 = 0; g4 < 4; ++g4) {
                u32x2 w; w.x = pk2h(R0[4 * g4], R0[4 * g4 + 1]); w.y = pk2h(R0[4 * g4 + 2], R0[4 * g4 + 3]);
                *(LAS u32x2*)(lds + OFF_RL + r32 * RLP + (32 * wid + 8 * g4 + 4 * hi) * 2) = w;
                w.x = pk2h(R1[4 * g4], R1[4 * g4 + 1]); w.y = pk2h(R1[4 * g4 + 2], R1[4 * g4 + 3]);
                *(LAS u32x2*)(lds + OFF_RL + (32 + r32) * RLP + (32 * wid + 8 * g4 + 4 * hi) * 2) = w; }
            LAS float* os = (LAS float*)(lds + OFF_OS) + wid * 1024 + lane;
#pragma unroll
            for (int r = 0; r < 16; ++r) os[64 * r] = wj ? OT0[r] : OT1[r];
        }
        __syncthreads();
        {
            const LAS float* os = (const LAS float*)(lds + OFF_OS) + (wid ^ 4) * 1024 + lane;
            h16* op = O + (t0 + 32 * wi + r32) * 2048 + h * 512 + sl * 64 + 32 * wj + 4 * hi;
#pragma unroll
            for (int g4 = 0; g4 < 4; ++g4) { float f[4];
#pragma unroll
                for (int q = 0; q < 4; ++q) f[q] = (wj ? OT1[4 * g4 + q] : OT0[4 * g4 + q]) + os[64 * (4 * g4 + q)];
                u32x2 w; w.x = pk2h(f[0], f[1]); w.y = pk2h(f[2], f[3]); *(u32x2*)(op + 8 * g4) = w; }
        }
        if (n == 8) PROBE_MARK(77);
        __syncthreads();
        if (n == 8) PROBE_MARK(78);
    }
}
#undef MF16
}

template <bool GATHER_> struct MoeOrderT {
    static constexpr bool GATHER = GATHER_;
    const volatile LAS unsigned* cnt; const volatile LAS unsigned* tstart; int G, c, K; const char* A; const char* Bt; size_t bstride; const int* list;
    __device__ bool next(int i, pg8::Unit& u) const {
        const int NTt = __builtin_amdgcn_readfirstlane((int)tstart[NE]); const long L = (long)i * G + c; if (L >= (long)NTt * 4) return false;
        const int mtg = (int)(L >> 2); int e = 0;
        while (e < NE - 1 && mtg >= __builtin_amdgcn_readfirstlane((int)tstart[e + 1])) ++e;
        u.pm = mtg; u.pn = (int)(L & 3); u.e = e; u.mt = mtg - __builtin_amdgcn_readfirstlane((int)tstart[e]); return true;
    }
    __device__ __forceinline__ const char* abase() const { return A; }
    __device__ __forceinline__ void aoff(const pg8::Unit& u, const int (&R)[2], const int (&C)[2], unsigned (&ao)[2][2]) const {
        const int cn = (int)cnt[u.e];
#pragma unroll
        for (int h = 0; h < 2; ++h)
#pragma unroll
            for (int i = 0; i < 2; ++i) { const int rank = u.mt * 256 + h * 128 + R[i]; int row = T; if (rank < cn) row = list[u.e * LISTCAP + rank] >> 1;
                ao[h][i] = (unsigned)(((size_t)row * K + C[i]) * 2); }
    }
    __device__ __forceinline__ const char* bbase(const pg8::Unit& u) const { return Bt + (size_t)u.e * bstride + (size_t)u.pn * 256 * K * 2; }
};
__device__ __forceinline__ void moe_setup(volatile LAS unsigned* MISC, const unsigned* counts, const int tid) {
    __syncthreads();
    if (tid < NE) MISC[16 + tid] = __hip_atomic_load(counts + tid, RLX_AGENT);
    __syncthreads();
    if (tid == 0) { unsigned a = 0; for (int e = 0; e < NE; ++e) { MISC[48 + e] = a; MISC[96 + e] = a * 256u; a += (MISC[16 + e] + 255u) >> 8; } MISC[48 + NE] = a; }
    __syncthreads();
}

__global__ void __launch_bounds__(NWAVES * 64, 2) mk_fwd(Args args) {
    extern __shared__ __attribute__((aligned(16))) unsigned char lds_raw[];
    LAS unsigned char* lds = (LAS unsigned char*)lds_raw;
    volatile LAS unsigned* MISC = (volatile LAS unsigned*)(lds + MISC_OFF);
    const int G = gridDim.x; const int bx = blockIdx.x; const int vcu = (G % 8 == 0) ? (bx % 8) * (G / 8) + bx / 8 : bx;
    { gu32* ctl0 = (gu32*)(args.ws + WS_CTL);
      for (int u = threadIdx.x; u < (LDS_BYTES - LDSCTL_OFF) / 4; u += NWAVES * 64) ((LAS unsigned*)(lds + LDSCTL_OFF))[u] = 0u;
      __syncthreads();
      (void)ctl0; }
    XcdBarrier bar; bar.bar = (unsigned*)((gu32*)(args.ws + WS_CTL) + CW_BAR) + args.li * XCD_BAR_WORDS; bar.x = 0; bar.st = nullptr;
    const bool use_bar = (args.ph_hi - args.ph_lo) > 1;
    const int wave_sgpr = __builtin_amdgcn_readfirstlane(threadIdx.x >> 6);
    if (use_bar) bar = xcd_barrier_post((unsigned*)((gu32*)(args.ws + WS_CTL) + CW_BAR) + args.li * XCD_BAR_WORDS, MISC + 8, wave_sgpr);
#ifndef PROBE_DUP
#define PROBE_DUP -1
#endif
#ifdef PROBE_T
#ifndef PROBE_AMP
#define PROBE_AMP 8
#endif
    unsigned long long probe_t0 = __builtin_amdgcn_s_memrealtime(), probe_t1 = probe_t0;
#endif
    for (int pi = args.ph_lo; pi < args.ph_hi; ++pi) {
        const int ph = (PROBE_DUP >= 0 && pi > PROBE_DUP) ? pi - 1 : pi;
        bool did = true; const bool dummy = (PROBE_DUP >= 0 && pi == PROBE_DUP + 1);
        int z32 = 0; asm volatile("" : "+s"(z32));
        int tid = ((wave_sgpr + z32) << 6) | (int)__builtin_amdgcn_mbcnt_hi(~0u, __builtin_amdgcn_mbcnt_lo(~0u, (unsigned)z32)); asm volatile("" : "+v"(tid));
        size_t zoff = 0; asm volatile("" : "+s"(zoff));
        unsigned char* ws = (unsigned char*)(GAS unsigned char*)(*(unsigned char* const __attribute__((address_space(4)))*)((const __attribute__((address_space(4))) char*)__builtin_amdgcn_kernarg_segment_ptr() + zoff + 136));
        const int lane = tid & 63, wave = __builtin_amdgcn_readfirstlane(tid >> 6);
        gu32* ctl = (gu32*)(ws + WS_CTL);
        const __attribute__((address_space(4))) char* ka = (const __attribute__((address_space(4))) char*)__builtin_amdgcn_kernarg_segment_ptr() + zoff;
#define ARG_IN(i) ((const float*)(const GAS float*)(*(const float* const __attribute__((address_space(4)))*)(ka + 8 * (i))))
        const float* x = ARG_IN(0); const float* fox_w_in = ARG_IN(1); const float* fox_b_f = ARG_IN(2); const float* fox_w_out = ARG_IN(3);
        const float* ret_w_in = ARG_IN(4); const float* ret_gn = ARG_IN(5); const float* ret_w_out = ARG_IN(6);
        const float* norm_mix = ARG_IN(7); const float* norm_ffn = ARG_IN(8);
        const float* rg_w = ARG_IN(9); const float* rg_b = ARG_IN(10); const float* re_w = ARG_IN(11); const float* re_b = ARG_IN(12);
        const float* w_gu = ARG_IN(13); const float* w_down = ARG_IN(14); const float* norm_final = ARG_IN(15);
        float* const outp = (float*)(GAS float*)(*(float* const __attribute__((address_space(4)))*)(ka + 128));
        h16* WfoxT = (h16*)(ws + WS_WFOX); h16* WfoT = (h16*)(ws + WS_WFO); h16* WretT = (h16*)(ws + WS_WRET); h16* WroT = (h16*)(ws + WS_WRO); h16* WguT = (h16*)(ws + WS_WGU); h16* WdT = (h16*)(ws + WS_WD);
        h16* RW = (h16*)(ws + WS_RW); h16* FW = (h16*)(ws + WS_FW); float* ctab = (float*)(ws + WS_ROPE); float* stab = ctab + SEQ * 128;
        float* H = (float*)(ws + WS_H); h16* HN = (h16*)(ws + WS_HN); float* RSTD = (float*)(ws + WS_RSTD); float* FLOG = (float*)(ws + WS_FLOG); float* CUM = (float*)(ws + WS_CUM);
        int* EID = (int*)(ws + WS_EID); int* RANK = (int*)(ws + WS_RANK); float* GATE = (float*)(ws + WS_GATE); int* LIST = (int*)(ws + WS_LIST);
        h16* QKVG = (h16*)(ws + WS_QKVG); h16* OG = (h16*)(ws + WS_OG); h16* RO = (h16*)(ws + WS_RO); h16* Y = (h16*)(ws + WS_Y); h16* ACT = (h16*)(ws + WS_ACT);
        unsigned* COUNTS = (unsigned*)(ctl + CW_CNT);
        const int gw = vcu * NWAVES + wave, NGW = G * NWAVES;

        if (ph == 0) {
            LAS float* scr = (LAS float*)(lds + wave * 16640);
            constexpr int I_FOX = 2 * 16 * 64, I_FO = 2 * 16 * 16, I_RET = 2 * 16 * 96, I_RO = 2 * 32 * 16, I_GU = DEPTH * NE * 16 * 16, I_D = DEPTH * NE * 8 * 16;
            constexpr int NITEMS = I_FOX + I_FO + I_RET + I_RO + I_GU + I_D;
            _Pragma("unroll 1") for (int it = gw; it < NITEMS; it += NGW) {
                int r = it;
                if (r < I_FOX) { const int j = r / (16 * 64), q = r % (16 * 64); transpose_item<false>(fox_w_in + (size_t)j * DM * FOX_IN, DM, FOX_IN, WfoxT + (size_t)j * 4096 * 1024, scr, q / 64, q % 64, lane); continue; } r -= I_FOX;
                if (r < I_FO) { const int j = r / 256, q = r % 256; transpose_item<false>(fox_w_out + (size_t)j * DM * DM, DM, DM, WfoT + (size_t)j * 1024 * 1024, scr, q / 16, q % 16, lane); continue; } r -= I_FO;
                if (r < I_RET) { const int j = r / (16 * 96), q = r % (16 * 96); transpose_item<false>(ret_w_in + (size_t)j * DM * RET_IN, DM, RET_IN, WretT + (size_t)j * 6144 * 1024, scr, q / 96, q % 96, lane); continue; } r -= I_RET;
                if (r < I_RO) { const int j = r / 512, q = r % 512; transpose_item<false>(ret_w_out + (size_t)j * 2048 * DM, 2048, DM, WroT + (size_t)j * 1024 * 2048, scr, q / 16, q % 16, lane); continue; } r -= I_RO;
                if (r < I_GU) { const int m = r / 256, q = r % 256; transpose_item<true>(w_gu + (size_t)m * DM * 1024, DM, 1024, WguT + (size_t)m * 1024 * 1024, scr, q / 16, q % 16, lane); continue; } r -= I_GU;
                { const int m = r / 128, q = r % 128; transpose_item<false>(w_down + (size_t)m * EFF * DM, EFF, DM, WdT + (size_t)m * 1024 * 512, scr, q / 16, q % 16, lane); }
            }
            const int gt = vcu * NWAVES * 64 + tid, NGT = G * NWAVES * 64;
            _Pragma("unroll 1") for (int idx = gt; idx < DEPTH * 32 * 64 * 24; idx += NGT) { const int v = idx % 24, ln = (idx / 24) % 64, it = (idx / (24 * 64)) % 32, L = idx / (24 * 64 * 32);
                const int tl = v >> 3, i = v & 7, k = 32 * it + 8 * (ln >> 4) + i, c = ln & 15;
                float val = 0.f; if (tl < 2) val = re_w[((size_t)L * DM + k) * NE + 16 * tl + c]; else if (c < 4) val = rg_w[((size_t)L * DM + k) * NG + c];
                RW[idx] = (h16)val; }
            _Pragma("unroll 1") for (int idx = gt; idx < 2 * 32 * 64 * 8; idx += NGT) { const int i = idx % 8, ln = (idx / 8) % 64, it = (idx / 512) % 32, j = idx / (512 * 32);
                const int k = 32 * it + 8 * (ln >> 4) + i, c = ln & 15; FW[idx] = (h16)fox_w_in[((size_t)j * DM + k) * FOX_IN + 4096 + c]; }
            _Pragma("unroll 1") for (int idx = gt; idx < SEQ * 128; idx += NGT) { const int pos = idx / 128, m = idx % 128;
                float c_, s_; rope_cs(pos, m, c_, s_); ctab[idx] = c_; stab[idx] = s_; }
            _Pragma("unroll 1") for (int idx = gt; idx < DM / 2; idx += NGT) ((unsigned*)(HN + (size_t)T * DM))[idx] = 0u;
        } else if (ph == 1) {
            { RowArgs A{}; A.src = x; A.h = H; A.hn = HN; A.rstd = RSTD; A.gnorm = norm_mix; A.tabh = FW; A.bias0 = fox_b_f; A.flog = FLOG;
                row_pass_all<false, true, 1>(A, vcu, G, wave, lane, lds, nullptr); }
        } else {
            const int L = (ph - 2) / NSUB, sub = (ph - 2) % NSUB, j = L >> 1; const bool fox = (L & 1) == 0;
            if (sub == 0) {
                if (fox) {
                    if (vcu < BATCH * FOX_H) {
                        const int bh = vcu, b = bh / FOX_H, hh = bh % FOX_H; float v[4]; float run = 0.f;
#pragma unroll
                        for (int i = 0; i < 4; ++i) { const float f = FLOG[((size_t)b * SEQ + 4 * tid + i) * 16 + hh]; run += fminf(f, 0.f) - log1pf(__expf(-fabsf(f))); v[i] = run; }
                        float incl = run;
#pragma unroll
                        for (int o = 1; o < 64; o <<= 1) { const float u = shfl_idx(incl, lane >= o ? lane - o : lane); if (lane >= o) incl += u; }
                        LAS float* wt = (LAS float*)lds;
                        if (lane == 63) wt[wave] = incl;
                        __syncthreads();
                        float base = incl - run;
                        for (int w = 0; w < wave; ++w) base += wt[w];
                        f32x4 o4 = {v[0] + base, v[1] + base, v[2] + base, v[3] + base};
                        *(f32x4*)(CUM + (size_t)bh * SEQ + 4 * tid) = o4;
                        __syncthreads();
                    }
                    pg8::StaticOrder S; S.init(HN, WfoxT + (size_t)j * 4096 * 1024, T, 4096, DM, G, bx);
                    pg8::EpiH16 E{QKVG, 1024, 1024, (size_t)T * 1024, RSTD, attn_body::C2, 1.f, 0, nullptr, nullptr};
                    pg8::gemm_phase<pg8::EpiH16, pg8::StaticOrder, true>(lds, DM, S, E, tid);
                } else {
                    pg8::StaticOrder S; S.init(HN, WretT + (size_t)j * 6144 * 1024, T, 6144, DM, G, bx);
                    pg8::EpiH16 E{QKVG, 1024, 1024, (size_t)T * 1024, RSTD, 1.f, 0.0625f, 1, ctab, stab};
                    pg8::gemm_phase<pg8::EpiH16, pg8::StaticOrder, true>(lds, DM, S, E, tid);
                }
            } else if (sub == 1) {
                if (fox) did = false;
                else { _Pragma("unroll 1") for (int item = vcu; item < BATCH * RET_H * (SEQ / 128); item += G) { int tu = tid; asm volatile("" : "+v"(tu));
                        ret_body::s_item(item >> 6, (item >> 4) & 3, item & 15, QKVG, QKVG + (size_t)T * 1024, (u32x4*)OG, tu); } }
            } else if (sub == 2) {
                if (fox) {
                    const h16* Q = QKVG; const h16* K = QKVG + (size_t)T * 1024; const h16* V = QKVG + (size_t)2 * T * 1024; const h16* Gt = QKVG + (size_t)3 * T * 1024;
                    for (int bh = vcu >> 1; bh < BATCH * FOX_H; bh += (G >> 1)) {
                        const int s = vcu & 1;
#pragma unroll 1
                        for (int i = 0; i < 4; ++i) { const int qb = (i == 0) ? s : (i == 1) ? 7 - s : (i == 2) ? 3 - s : 4 + s;
                            int tu = tid; asm volatile("" : "+v"(tu));
                            attn_body::attn_unit<8>(bh / FOX_H, bh % FOX_H, qb, Q, K, V, Gt, CUM, OG, (char*)lds_raw, tu); }
                    }
                } else {
                    for (int item = vcu; item < BATCH * RET_H * 8; item += G) { const int bh = item >> 3, sl = item & 7, b = bh >> 2, hh = bh & 3;
                        const h16* Vb = QKVG + (size_t)(2 + (hh >> 1)) * T * 1024 + (hh & 1) * 512 + sl * 64;
                        ret_body::ret_item(b, hh, sl, QKVG, QKVG + (size_t)T * 1024, Vb, (const u32x4*)OG, RO, lds, tid); }
                }
            } else if (sub == 3) {
                if (fox) did = false;
                else { _Pragma("unroll 1") for (int w = gw; w < T * RET_H; w += NGW) ret_gn_item(RO, QKVG + (size_t)4 * T * 1024, ret_gn + (size_t)j * 2048, OG, w, lane); }
            } else if (sub == 4) {
                const int Kd = fox ? 1024 : 2048;
                pg8::StaticOrder S; S.init(OG, fox ? (const void*)(WfoT + (size_t)j * 1024 * 1024) : (const void*)(WroT + (size_t)j * 1024 * 2048), T, DM, Kd, G, bx);
                pg8::EpiResid E{dummy ? (float*)(ws + WS_DUMMY) : H, DM};
                pg8::gemm_phase<pg8::EpiResid, pg8::StaticOrder, false>(lds, Kd, S, E, tid);
            } else if (sub == 5) {
                { RowArgs A{}; A.src = H; A.h = H; A.hn = HN; A.rstd = RSTD; A.gnorm = norm_ffn + (size_t)L * DM; A.tabh = RW + (size_t)L * 32 * 64 * 24; A.bias0 = rg_b + L * NG; A.bias1 = re_b + L * NE;
                    A.eid = EID; A.rank = RANK; A.gate = GATE; A.counts = COUNTS + L * NE; A.list = LIST;
                    if (dummy) { unsigned char* dz = ws + WS_DUMMY; A.hn = (h16*)(dz + 64 * MiB); A.rstd = (float*)(dz + 100 * MiB); A.eid = (int*)(dz + 101 * MiB); A.rank = (int*)(dz + 102 * MiB); A.gate = (float*)(dz + 103 * MiB); A.list = (int*)(dz + 104 * MiB); A.counts = (unsigned*)(ctl + CW_CNT2); }
                    row_pass_all<false, false, 3>(A, vcu, G, wave, lane, lds, nullptr); }
            } else if (sub == 6) {
                moe_setup(MISC, COUNTS + L * NE, tid);
                MoeOrderT<true> S{MISC + 16, MISC + 48, G, vcu, DM, (const char*)HN, (const char*)(WguT + (size_t)L * NE * 1024 * 1024), SZ_WGU, LIST};
                pg8::EpiSwiGLU E{ACT, RSTD, LIST, (const int*)(COUNTS + L * NE)};
                pg8::gemm_phase<pg8::EpiSwiGLU, MoeOrderT<true>, true>(lds, DM, S, E, tid);
            } else if (sub == 7) {
                moe_setup(MISC, COUNTS + L * NE, tid);
                MoeOrderT<false> S{MISC + 16, MISC + 48, G, vcu, EFF, (const char*)ACT, (const char*)(WdT + (size_t)L * NE * 1024 * 512), SZ_WD, LIST};
                pg8::EpiStoreH16 E{Y, DM};
                pg8::gemm_phase<pg8::EpiStoreH16, MoeOrderT<false>, true>(lds, EFF, S, E, tid);
            } else {
                moe_setup(MISC, COUNTS + L * NE, tid);
                if (L == DEPTH - 1) {
                    _Pragma("unroll 1") for (int t = gw; t < T; t += NGW) final_row(H, Y, EID, RANK, GATE, MISC + 96, norm_final, dummy ? (float*)(ws + WS_DUMMY) : outp, t, lane);
                } else {
                    const bool nfox = ((L + 1) & 1) == 0;
                    RowArgs A{}; A.src = H; A.h = H; A.hn = HN; A.rstd = RSTD; A.gnorm = norm_mix + (size_t)(L + 1) * DM; A.y = Y; A.eidp = EID; A.rankp = RANK; A.gatep = GATE;
                    if (dummy) { unsigned char* dz = ws + WS_DUMMY; A.h = (float*)dz; A.hn = (h16*)(dz + 64 * MiB); A.rstd = (float*)(dz + 100 * MiB); }
                    if (nfox) { A.tabh = FW + (size_t)((L + 1) >> 1) * 32 * 64 * 8; A.bias0 = fox_b_f + ((L + 1) >> 1) * FOX_H; A.flog = dummy ? (float*)(ws + WS_DUMMY + 106 * MiB) : FLOG;
                        row_pass_all<true, true, 1>(A, vcu, G, wave, lane, lds, MISC + 96); }
                    else { row_pass_all<true, true, 0>(A, vcu, G, wave, lane, lds, MISC + 96); }
                }
            }
        }
        if (did && pi + 1 < args.ph_hi) xcd_barrier(bar, tid == 0);
#ifdef PROBE_T
        if (ph == PROBE_T - 1 || (PROBE_T == 0 && pi == args.ph_lo)) { if (PROBE_T == 0) {} else probe_t0 = __builtin_amdgcn_s_memrealtime(); }
        if (ph == PROBE_T) probe_t1 = __builtin_amdgcn_s_memrealtime();
#endif
    }
#if defined(PROBE_A) && defined(PROBE_B)
    if (blockIdx.x == 0 && TID0()) { volatile LAS unsigned* pm_ = (volatile LAS unsigned*)(size_t)(MISC_OFF + 800); const unsigned long long d = (unsigned long long)(pm_[1] - pm_[0]) * (unsigned long long)PROBE_AMP2; const unsigned long long s0 = __builtin_amdgcn_s_memrealtime();
        while (__builtin_amdgcn_s_memrealtime() - s0 < d) __builtin_amdgcn_s_sleep(8); }
#endif
#ifdef PROBE_T
    if (blockIdx.x == 0 && TID0()) { const unsigned long long d = (probe_t1 - probe_t0) * PROBE_AMP; const unsigned long long s0 = __builtin_amdgcn_s_memrealtime();
        while (__builtin_amdgcn_s_memrealtime() - s0 < d) __builtin_amdgcn_s_sleep(8); }
#endif
}

extern "C" void kernel_launch(void* const* d_in, const int* in_sizes, int n_in, void* d_out, int out_size, void* d_ws, size_t ws_size, hipStream_t stream) {
    static int grid = 0;
    if (grid == 0) {
        if (n_in != 16 || out_size != T * DM || ws_size < WS_END) { fprintf(stderr, "kernel_launch: unexpected problem (n_in %d out %d ws %zu need %zu)\n", n_in, out_size, ws_size, (size_t)WS_END); grid = -1; return; }
        int dev = 0, cus = 0;
        if (hipGetDevice(&dev) != hipSuccess || hipDeviceGetAttribute(&cus, hipDeviceAttributeMultiprocessorCount, dev) != hipSuccess) { grid = -1; return; }
        if (hipFuncSetAttribute((const void*)mk_fwd, hipFuncAttributeMaxDynamicSharedMemorySize, LDS_BYTES) != hipSuccess) { fprintf(stderr, "kernel_launch: hipFuncSetAttribute failed\n"); grid = -1; return; }
        (void)hipGetLastError();
        grid = cus;
    }
    if (grid < 0) return;
    if (hipMemsetAsync((char*)d_ws + WS_CTL, 0, CTL_ZERO_BYTES, stream) != hipSuccess) return;
    Args a{};
    for (int i = 0; i < 16; ++i) a.in[i] = (const float*)d_in[i];
    a.out = (float*)d_out; a.ws = (unsigned char*)d_ws;
#if MK_N_LAUNCHES == 1
    a.ph_lo = 0; a.ph_hi = NPHASE + (PROBE_DUP >= 0 ? 1 : 0); a.li = 0;
    hipLaunchKernelGGL(mk_fwd, dim3(grid), dim3(NWAVES * 64), LDS_BYTES, stream, a);
#else
    for (int p = 0; p < NPHASE; ++p) {
        if (p >= 2 && ((((p - 2) % NSUB) == 1) || (((p - 2) % NSUB) == 3)) && ((((p - 2) / NSUB) & 1) == 0)) continue;
        a.ph_lo = p; a.ph_hi = p + 1; a.li = 0;
        hipLaunchKernelGGL(mk_fwd, dim3(grid), dim3(NWAVES * 64), LDS_BYTES, stream, a);
    }
#endif
}
```

```cpp
#include <hip/hip_runtime.h>
#include <cstdio>
#include <cstdint>
#include <cmath>
#define LAS __attribute__((address_space(3)))
#define GAS __attribute__((address_space(1)))
typedef _Float16 h16;
typedef _Float16 f16x8 __attribute__((ext_vector_type(8)));
typedef _Float16 f16x4 __attribute__((ext_vector_type(4)));
typedef _Float16 f16x2 __attribute__((ext_vector_type(2)));
typedef float f32x2 __attribute__((ext_vector_type(2)));
typedef float f32x4 __attribute__((ext_vector_type(4)));
typedef float f32x16 __attribute__((ext_vector_type(16)));
typedef unsigned u32x2 __attribute__((ext_vector_type(2)));
typedef unsigned u32x4 __attribute__((ext_vector_type(4)));
typedef short s16x4 __attribute__((ext_vector_type(4)));
__device__ __forceinline__ unsigned pk2h(float lo, float hi) { f32x2 v = {lo, hi}; f16x2 b = __builtin_convertvector(v, f16x2); return __builtin_bit_cast(unsigned, b); }

constexpr int DM = 1024, BATCH = 8, SEQ = 2048, DEPTH = 4, T = BATCH * SEQ;
constexpr int FOX_H = 16, FOX_D = 64, FOX_IN = 4 * DM + FOX_H;
constexpr int RET_H = 4, RET_DK = 256, RET_DV = 512, RET_IN = 6144;
constexpr int NG = 4, EPG = 8, NE = 32, EFF = 512;
constexpr int PAIRS = T * 2;
constexpr int LISTCAP = 16384;
constexpr int PROWS = PAIRS + NE * 256;
constexpr float EPS = 1e-6f;
constexpr float LOG2E = 1.4426950408889634f;

namespace pg8 {
constexpr int BM = 256, BK = 64, HALF = 128, HTB = HALF * BK * 2, STAGE_BYTES = 8 * HTB, NXCD = 8, WGM = 8;
__host__ __device__ __forceinline__ int lds_byte(int r, int c) { const int st = (r >> 4) * 2 + (c >> 5), rr = r & 15, cc = c & 31, ob = rr * 64 + cc * 2; return st * 1024 + (ob ^ (((ob >> 9) & 1) << 5)); }
__host__ __device__ __forceinline__ void stage_rc(int b, int& R, int& C) { const int st = b / 1024, sb = b % 1024, swz = sb ^ (((sb >> 9) & 1) << 5); R = (st >> 1) * 16 + swz / 64; C = (st & 1) * 32 + (swz % 64) / 2; }
__host__ __device__ __forceinline__ int perm32(int rho) { const int n = rho >> 4, i = rho & 15; return 8 * (i >> 2) + 4 * n + (i & 3); }

struct Unit { int pm, pn, e, mt; };

struct StaticOrder {
    static constexpr bool GATHER = false;
    int nM, nN, nwg, G, c, K; const char* A; const char* Bt;
    __device__ void init(const void* A_, const void* Bt_, int M, int N, int K_, int G_, int c_) { A = (const char*)A_; Bt = (const char*)Bt_; K = K_; nM = M / BM; nN = N / BM; nwg = nM * nN; G = G_; c = c_; }
    __device__ bool next(int i, Unit& u) const {
        const long L = (long)i * G + c; if (L >= nwg) return false;
        int wgid = (int)L; { const int q = nwg / NXCD, r = nwg % NXCD, xcd = wgid % NXCD, off = wgid / NXCD; wgid = (xcd < r ? xcd * (q + 1) : r * (q + 1) + (xcd - r) * q) + off; }
        const int nig = WGM * nN, gid = wgid / nig, fm = gid * WGM, gsz = (nM - fm) < WGM ? (nM - fm) : WGM;
        u.pm = fm + ((wgid % nig) % gsz); u.pn = (wgid % nig) / gsz; u.e = 0; u.mt = 0; return true;
    }
    __device__ __forceinline__ const char* abase() const { return A; }
    __device__ __forceinline__ void aoff(const Unit& u, const int (&R)[2], const int (&C)[2], unsigned (&ao)[2][2]) const {
#pragma unroll
        for (int h = 0; h < 2; ++h)
#pragma unroll
            for (int i = 0; i < 2; ++i) ao[h][i] = (unsigned)(((size_t)(u.pm * BM + h * HALF + R[i]) * K + C[i]) * 2);
    }
    __device__ __forceinline__ const char* bbase(const Unit& u) const { return Bt + (size_t)u.pn * BM * K * 2; }
};

#define PG8_WAIT_V(n) asm volatile("s_waitcnt vmcnt(" #n ")" ::: "memory")
#define PG8_WAIT_L(n) asm volatile("s_waitcnt lgkmcnt(" #n ")" ::: "memory")
#define PG8_BAR __builtin_amdgcn_s_barrier()
#define PG8_SCHED __builtin_amdgcn_sched_barrier(0)

template <class Epi, class Sched, bool ALIGN_EPI>
__device__ __forceinline__ void gemm_phase(LAS unsigned char* lds, const int K, const Sched& S, const Epi& E, const int tid) {
    constexpr bool GATHER = Sched::GATHER;
    const int wid = __builtin_amdgcn_readfirstlane(tid >> 6), lane = tid & 63, wr = wid >> 2, wc = wid & 3, fr = lane & 15, fq = lane >> 4;
    const int nt = K / BK;
    int Rr[2], Cc[2]; unsigned voffB[2], voffA[2];
#pragma unroll
    for (int i = 0; i < 2; ++i) { int R, C; stage_rc(tid * 16 + i * 8192, R, C); Rr[i] = R; Cc[i] = C; const int Rb = Epi::PERM ? ((R & ~31) + perm32(R & 31)) : R; voffB[i] = (unsigned)(Rb * K + C) * 2u; voffA[i] = (unsigned)(R * K + C) * 2u; }
    const size_t kstep = (size_t)(BK * 2);
    const size_t hstep = (size_t)HALF * K * 2;
    const size_t tstep = 2 * hstep;
    const unsigned ldsw = (unsigned)wid * 1024u;
    const int aoff_l = lds_byte(wr * 64 + fr, fq * 8), boff_l = lds_byte(wc * 32 + fr, fq * 8);
    const char* const gA = S.abase();
    LAS u32x4* const park = (LAS u32x4*)(lds + STAGE_BYTES) + tid;
#define PG8_SA(b, h) (((b) * 2 + (h)) * HTB)
#define PG8_SB(b, h) ((4 + (b) * 2 + (h)) * HTB)
#define PG8_STAGE(bufoff, gbase, voff) do { _Pragma("unroll") for (int _i = 0; _i < 2; ++_i) \
        __builtin_amdgcn_global_load_lds((const unsigned*)((const char*)(gbase) + (voff)[_i]), (LAS unsigned*)(lds + (bufoff) + ldsw + _i * 8192), 16, 0, 0); } while (0)
#define PG8_STAGEA(bufoff, ubase, h, kb) do { if constexpr (GATHER) { \
        __builtin_amdgcn_global_load_lds((const unsigned*)((gA + (kb)) + aoC[h][0]), (LAS unsigned*)(lds + (bufoff) + ldsw), 16, 0, 0); \
        __builtin_amdgcn_global_load_lds((const unsigned*)((gA + (kb)) + aoC[h][1]), (LAS unsigned*)(lds + (bufoff) + ldsw + 8192), 16, 0, 0); \
      } else { PG8_STAGE(bufoff, (ubase) + (size_t)(h) * hstep + (kb), voffA); } } while (0)
#define PG8_LDA(dst, b, h) do { _Pragma("unroll") for (int m = 0; m < 4; ++m) _Pragma("unroll") for (int k = 0; k < 2; ++k) dst[m][k] = *(const LAS f16x8*)(lds + PG8_SA(b, h) + aoff_l + m * 2048 + k * 1024); } while (0)
#define PG8_LDB(dst, b, h) do { _Pragma("unroll") for (int n = 0; n < 2; ++n) _Pragma("unroll") for (int k = 0; k < 2; ++k) dst[n][k] = *(const LAS f16x8*)(lds + PG8_SB(b, h) + boff_l + n * 2048 + k * 1024); } while (0)
#define PG8_MMA(ai, bj, At, Bt) do { __builtin_amdgcn_s_setprio(1); _Pragma("unroll") for (int m = 0; m < 4; ++m) _Pragma("unroll") for (int n = 0; n < 2; ++n) _Pragma("unroll") for (int k = 0; k < 2; ++k) \
        acc[ai][bj][m][n] = __builtin_amdgcn_mfma_f32_16x16x32_f16(Bt[n][k], At[m][k], acc[ai][bj][m][n], 0, 0, 0); __builtin_amdgcn_s_setprio(0); } while (0)
    Unit cur, nxt; int ui = 0;
    if (!S.next(0, cur)) return;
    f32x4 acc[2][2][4][2];
#pragma unroll
    for (int a = 0; a < 2; ++a)
#pragma unroll
        for (int b = 0; b < 2; ++b)
#pragma unroll
            for (int m = 0; m < 4; ++m)
#pragma unroll
                for (int n = 0; n < 2; ++n) acc[a][b][m][n] = (f32x4){0.f, 0.f, 0.f, 0.f};
    f16x8 At[4][2], B0[2][2], B1[2][2];
    unsigned aoC[2][2] = {{0u, 0u}, {0u, 0u}};
    if constexpr (GATHER) S.aoff(cur, Rr, Cc, aoC);
    const char* cA = gA + (size_t)cur.pm * tstep;
    const char* cB = S.bbase(cur);
    PG8_STAGE(PG8_SB(0, 0), cB, voffB); PG8_STAGE(PG8_SB(0, 1), cB + hstep, voffB); PG8_STAGEA(PG8_SA(0, 0), cA, 0, 0); PG8_STAGEA(PG8_SA(0, 1), cA, 1, 0);
    if (wr == 1) PG8_BAR;
    PG8_WAIT_V(2); PG8_BAR;
    PG8_STAGE(PG8_SB(1, 0), cB + kstep, voffB); PG8_STAGEA(PG8_SA(1, 0), cA, 0, kstep); PG8_STAGE(PG8_SB(1, 1), cB + hstep + kstep, voffB);
    PG8_WAIT_V(6); PG8_BAR;
    for (;;) {
        const bool has_next = S.next(ui + 1, nxt);
        const char* nB = cB; const char* nA = cA;
        if (has_next) { nB = S.bbase(nxt); nA = gA + (size_t)nxt.pm * tstep; }
        if constexpr (GATHER) { unsigned aoN[2][2];
            if (has_next) S.aoff(nxt, Rr, Cc, aoN); else { aoN[0][0] = aoC[0][0]; aoN[0][1] = aoC[0][1]; aoN[1][0] = aoC[1][0]; aoN[1][1] = aoC[1][1]; }
            *park = (u32x4){aoN[0][0], aoN[0][1], aoN[1][0], aoN[1][1]}; }
        for (int t = 0; t < nt; t += 2) {
            const bool last = (t == nt - 2);
            const size_t k1 = (size_t)(t + 1) * kstep;
            const size_t k2 = last ? 0 : (size_t)(t + 2) * kstep, k3 = k2 + kstep;
            const char* a2 = last ? nA : cA;
            const char* b2 = (last ? nB : cB) + k2; const char* b3 = b2 + kstep;
            PG8_LDB(B0, 0, 0); PG8_LDB(B1, 0, 1); PG8_SCHED; PG8_LDA(At, 0, 0); PG8_STAGEA(PG8_SA(1, 1), cA, 1, k1);
            if constexpr (GATHER) { if (last) { const u32x4 p = *park; aoC[0][0] = p.x; aoC[0][1] = p.y; aoC[1][0] = p.z; aoC[1][1] = p.w; } }
            PG8_WAIT_V(8); PG8_WAIT_L(0); PG8_BAR; PG8_MMA(0, 0, At, B0); PG8_MMA(0, 1, At, B1); PG8_BAR; PG8_SCHED;
            PG8_LDA(At, 0, 1); PG8_STAGE(PG8_SB(0, 0), b2, voffB); PG8_STAGE(PG8_SB(0, 1), b2 + hstep, voffB); PG8_STAGEA(PG8_SA(0, 0), a2, 0, k2);
            PG8_WAIT_V(8); PG8_WAIT_L(0); PG8_BAR; PG8_MMA(1, 0, At, B0); PG8_MMA(1, 1, At, B1); PG8_BAR; PG8_SCHED;
            PG8_LDB(B0, 1, 0); PG8_LDB(B1, 1, 1); PG8_SCHED; PG8_LDA(At, 1, 0); PG8_STAGEA(PG8_SA(0, 1), a2, 1, k2);
            PG8_WAIT_V(8); PG8_WAIT_L(0); PG8_BAR; PG8_MMA(0, 0, At, B0); PG8_MMA(0, 1, At, B1); PG8_BAR; PG8_SCHED;
            PG8_LDA(At, 1, 1); PG8_STAGE(PG8_SB(1, 0), b3, voffB); PG8_STAGE(PG8_SB(1, 1), b3 + hstep, voffB); PG8_STAGEA(PG8_SA(1, 0), a2, 0, k3);
            PG8_WAIT_V(8); PG8_WAIT_L(0); PG8_BAR; PG8_MMA(1, 0, At, B0); PG8_MMA(1, 1, At, B1); PG8_BAR; PG8_SCHED;
        }
        if constexpr (ALIGN_EPI) { if (wr == 0) PG8_BAR; }
        E(acc, cur, wr, wc, fr, fq);
        if (!has_next) break;
#pragma unroll
        for (int a = 0; a < 2; ++a)
#pragma unroll
            for (int b = 0; b < 2; ++b)
#pragma unroll
                for (int m = 0; m < 4; ++m)
#pragma unroll
                    for (int n = 0; n < 2; ++n) acc[a][b][m][n] = (f32x4){0.f, 0.f, 0.f, 0.f};
        cur = nxt; cB = nB; cA = nA; ++ui;
        if constexpr (ALIGN_EPI) { if (wr == 1) PG8_BAR; }
    }
    PG8_WAIT_V(0);
    if constexpr (!ALIGN_EPI) { if (wr == 0) PG8_BAR; }
    PG8_BAR;
#undef PG8_SA
#undef PG8_SB
#undef PG8_STAGE
#undef PG8_STAGEA
#undef PG8_LDA
#undef PG8_LDB
#undef PG8_MMA
}

struct EpiH16 {
    static constexpr bool PERM = true;
    h16* O; int ldc; int split_cols; size_t split_stride; const float* rstd; float scale0, scale1; int rot; const float* ct; const float* st;
    __device__ __forceinline__ void operator()(const f32x4 (&acc)[2][2][4][2], const Unit& u, int wr, int wc, int fr, int fq) const {
        const int row0 = u.pm * BM + wr * 64 + fr; int colt = u.pn * BM; h16* base = O;
        const int t = colt / split_cols; base += (size_t)t * split_stride; colt -= t * split_cols;
        const float sc = (t == 0) ? scale0 : ((t == 1) ? scale1 : 1.f);
        const int col0 = colt + wc * 32 + 8 * fq;
        const bool dorot = rot && (t < 2);
#pragma unroll
        for (int ai = 0; ai < 2; ++ai)
#pragma unroll
            for (int m = 0; m < 4; ++m) {
                const int row = row0 + ai * HALF + m * 16; const float rs = rstd[row] * sc;
                h16* rowp = base + (size_t)row * ldc + col0;
                if (dorot) {
                    const int pos = row & (SEQ - 1); const int d0 = wc * 32 + 8 * fq;
                    const f32x4 c0 = *(const f32x4*)(ct + pos * 128 + d0), c1 = *(const f32x4*)(ct + pos * 128 + d0 + 4);
                    const f32x4 s0 = *(const f32x4*)(st + pos * 128 + d0), s1 = *(const f32x4*)(st + pos * 128 + d0 + 4);
                    const f32x4 a0 = acc[ai][0][m][0] * rs, a1 = acc[ai][0][m][1] * rs, b0 = acc[ai][1][m][0] * rs, b1 = acc[ai][1][m][1] * rs;
                    const f32x4 o10 = a0 * c0 - b0 * s0, o11 = a1 * c1 - b1 * s1, o20 = a0 * s0 + b0 * c0, o21 = a1 * s1 + b1 * c1;
                    u32x4 w; w.x = pk2h(o10[0], o10[1]); w.y = pk2h(o10[2], o10[3]); w.z = pk2h(o11[0], o11[1]); w.w = pk2h(o11[2], o11[3]);
                    *(u32x4*)(rowp) = w;
                    w.x = pk2h(o20[0], o20[1]); w.y = pk2h(o20[2], o20[3]); w.z = pk2h(o21[0], o21[1]); w.w = pk2h(o21[2], o21[3]);
                    *(u32x4*)(rowp + HALF) = w;
                } else {
#pragma unroll
                    for (int bj = 0; bj < 2; ++bj) { const f32x4 v0 = acc[ai][bj][m][0] * rs, v1 = acc[ai][bj][m][1] * rs;
                        u32x4 w; w.x = pk2h(v0[0], v0[1]); w.y = pk2h(v0[2], v0[3]); w.z = pk2h(v1[0], v1[1]); w.w = pk2h(v1[2], v1[3]);
                        *(u32x4*)(rowp + bj * HALF) = w; }
                }
            }
    }
};
struct EpiResid {
    static constexpr bool PERM = false;
    float* H; int ldc;
    __device__ __forceinline__ void operator()(const f32x4 (&acc)[2][2][4][2], const Unit& u, int wr, int wc, int fr, int fq) const {
        const int col0 = u.pn * BM + wc * 32 + 4 * fq, row0 = u.pm * BM + wr * 64 + fr;
#pragma unroll
        for (int ai = 0; ai < 2; ++ai)
#pragma unroll
            for (int m = 0; m < 4; ++m) { float* rp = H + (size_t)(row0 + ai * HALF + m * 16) * ldc + col0;
#pragma unroll
                for (int bj = 0; bj < 2; ++bj)
#pragma unroll
                    for (int n = 0; n < 2; ++n) { f32x4* p = (f32x4*)(rp + bj * HALF + n * 16); *p = *p + acc[ai][bj][m][n]; } }
    }
};
struct EpiStoreF32 {
    static constexpr bool PERM = false;
    float* Y; int ldc;
    __device__ __forceinline__ void operator()(const f32x4 (&acc)[2][2][4][2], const Unit& u, int wr, int wc, int fr, int fq) const {
        const int col0 = u.pn * BM + wc * 32 + 4 * fq, row0 = u.pm * BM + wr * 64 + fr;
#pragma unroll
        for (int ai = 0; ai < 2; ++ai)
#pragma unroll
            for (int m = 0; m < 4; ++m) { float* rp = Y + (size_t)(row0 + ai * HALF + m * 16) * ldc + col0;
#pragma unroll
                for (int bj = 0; bj < 2; ++bj)
#pragma unroll
                    for (int n = 0; n < 2; ++n) *(f32x4*)(rp + bj * HALF + n * 16) = acc[ai][bj][m][n]; }
    }
};
struct EpiStoreH16 {
    static constexpr bool PERM = true;
    h16* Y; int ldc;
    __device__ __forceinline__ void operator()(const f32x4 (&acc)[2][2][4][2], const Unit& u, int wr, int wc, int fr, int fq) const {
        const int col0 = u.pn * BM + wc * 32 + 8 * fq, row0 = u.pm * BM + wr * 64 + fr;
#pragma unroll
        for (int ai = 0; ai < 2; ++ai)
#pragma unroll
            for (int m = 0; m < 4; ++m) { h16* rp = Y + (size_t)(row0 + ai * HALF + m * 16) * ldc + col0;
#pragma unroll
                for (int bj = 0; bj < 2; ++bj) { const f32x4 v0 = acc[ai][bj][m][0], v1 = acc[ai][bj][m][1];
                    u32x4 w; w.x = pk2h(v0[0], v0[1]); w.y = pk2h(v0[2], v0[3]); w.z = pk2h(v1[0], v1[1]); w.w = pk2h(v1[2], v1[3]);
                    *(u32x4*)(rp + bj * HALF) = w; } }
    }
};
struct EpiSwiGLU {
    static constexpr bool PERM = true;
    h16* ACT; const float* rstd; const int* list; const int* cnt;
    __device__ __forceinline__ void operator()(const f32x4 (&acc)[2][2][4][2], const Unit& u, int wr, int wc, int fr, int fq) const {
        const int row0 = u.pm * BM + wr * 64 + fr, rank0 = u.mt * BM + wr * 64 + fr; const int c = cnt[u.e];
        const int col0 = u.pn * 128 + wc * 16 + 4 * fq;
#pragma unroll
        for (int ai = 0; ai < 2; ++ai)
#pragma unroll
            for (int m = 0; m < 4; ++m) {
                const int rank = rank0 + ai * HALF + m * 16; float rs = 0.f;
                if (rank < c) rs = rstd[list[u.e * LISTCAP + rank] >> 1];
                h16* rowp = ACT + (size_t)(row0 + ai * HALF + m * 16) * EFF + col0;
#pragma unroll
                for (int bj = 0; bj < 2; ++bj) { const f32x4 a = acc[ai][bj][m][0] * rs, b = acc[ai][bj][m][1] * rs; f32x4 o;
#pragma unroll
                    for (int q = 0; q < 4; ++q) o[q] = a[q] * __builtin_amdgcn_rcpf(1.0f + __builtin_amdgcn_exp2f(-a[q] * LOG2E)) * b[q];
                    u32x2 w; w.x = pk2h(o[0], o[1]); w.y = pk2h(o[2], o[3]); *(u32x2*)(rowp + bj * 64) = w; }
            }
    }
};
}
namespace attn_body {
constexpr int D = 64, DMP = 1024;
constexpr int NW = 8, QBLK = 32, QB = QBLK * NW, KVBLK = 64, NQB = SEQ / QB;
__device__ __forceinline__ int crow(int r, int hi) { return (r & 3) + 8 * (r >> 2) + 4 * hi; }
#define SBAR() __builtin_amdgcn_sched_barrier(0)
__device__ __forceinline__ void cmask(f32x16& p0, f32x16& p1, int jb, int qrel, int hi) {
    const float NEG = -INFINITY; int kb = 64 * jb + 4 * hi;
#pragma unroll
    for (int r = 0; r < 16; ++r) { int kv = kb + (r & 3) + 8 * (r >> 2); if (kv > qrel) p0[r] = NEG; if (kv + 32 > qrel) p1[r] = NEG; }
}
constexpr int NSLOT = 3, SLOTB = 8192;
constexpr int LDS_K = 0, LDS_V = NSLOT * SLOTB, LDS_WS = 2 * NSLOT * SLOTB, LDS_OST = LDS_WS + NW * 64 * 4, LDS_BIAS = LDS_OST + NW * 4096, LDS_BYTES = LDS_BIAS + SEQ * 4;
constexpr float C2 = 0.125f * LOG2E;
__device__ __forceinline__ void glds16(const void* gsrc, unsigned lds_dst) { unsigned keep;
    asm volatile("s_mov_b32 %0, m0\n\ts_mov_b32 m0, %2\n\ts_nop 0\n\tglobal_load_lds_dwordx4 %1, off\n\ts_mov_b32 m0, %0" : "=&s"(keep) : "v"(gsrc), "s"(lds_dst) : "memory"); }
__device__ __forceinline__ float max3f(float a, float b, float c) { float r; asm("v_max3_f32 %0, %1, %2, %3" : "=v"(r) : "v"(a), "v"(b), "v"(c)); return r; }
__device__ __forceinline__ float max2f(float a, float b) { float r; asm("v_max_f32_e32 %0, %1, %2" : "=v"(r) : "v"(a), "v"(b)); return r; }
__device__ __forceinline__ float fadd_s(float a, float b) { float r; asm("v_add_f32_e32 %0, %1, %2" : "=v"(r) : "v"(a), "v"(b)); return r; }
__device__ __forceinline__ float fsub_s(float a, float b) { float r; asm("v_sub_f32_e32 %0, %1, %2" : "=v"(r) : "v"(a), "v"(b)); return r; }
__device__ __forceinline__ unsigned split_hl(float v) { const h16 hi = (h16)v; const h16 lo = (h16)(v - (float)hi); return (unsigned)__builtin_bit_cast(unsigned short, hi) | ((unsigned)__builtin_bit_cast(unsigned short, lo) << 16); }
#define WAIT_BAR(N) asm volatile("s_waitcnt vmcnt(" #N ") lgkmcnt(0)\n\ts_barrier" ::: "memory")
#define MF16(a, b, c) __builtin_amdgcn_mfma_f32_32x32x16_f16(a, b, c, 0, 0, 0)
typedef LAS const char* lds_cptr;
typedef short v4i16_t __attribute__((ext_vector_type(4)));
__device__ __forceinline__ void kload8(f16x8* kf, lds_cptr kp) {
    kf[0] = *(const LAS f16x8*)(kp);        kf[1] = *(const LAS f16x8*)(kp + 512);
    kf[2] = *(const LAS f16x8*)(kp + 2048); kf[3] = *(const LAS f16x8*)(kp + 2560);
    kf[4] = *(const LAS f16x8*)(kp + 4096); kf[5] = *(const LAS f16x8*)(kp + 4608);
    kf[6] = *(const LAS f16x8*)(kp + 6144); kf[7] = *(const LAS f16x8*)(kp + 6656);
}
__device__ __forceinline__ void kload2(f16x8* kf, lds_cptr kp, int j) { kf[2 * j] = *(const LAS f16x8*)(kp + j * 2048); kf[2 * j + 1] = *(const LAS f16x8*)(kp + j * 2048 + 512); }
__device__ __forceinline__ s16x4 vtr(lds_cptr p) { return __builtin_bit_cast(s16x4, __builtin_amdgcn_ds_read_tr16_b64_v4i16((LAS v4i16_t*)p)); }
__device__ __forceinline__ f16x8 mk8(s16x4 lo, s16x4 hi) { typedef short s16x8 __attribute__((ext_vector_type(8))); s16x8 t = {lo[0], lo[1], lo[2], lo[3], hi[0], hi[1], hi[2], hi[3]}; return __builtin_bit_cast(f16x8, t); }
__device__ __forceinline__ f16x4 ext_frag(unsigned w0, unsigned w1) { u32x2 t = {w0, w1}; return __builtin_bit_cast(f16x4, t); }
#define MF8(a, b, c) __builtin_amdgcn_mfma_f32_32x32x8f16(a, b, c, 0, 0, 0)
__device__ __forceinline__ float rowmax(const f32x16& p0, const f32x16& p1) {
    float a = max3f(p0[0], p0[1], p1[0]), b = max3f(p0[2], p0[3], p1[1]); a = max3f(a, p1[2], p1[3]);
#pragma unroll
    for (int r = 4; r < 16; r += 4) { a = max3f(a, p0[r], p0[r + 1]); b = max3f(b, p0[r + 2], p0[r + 3]); a = max3f(a, p1[r], p1[r + 1]); b = max3f(b, p1[r + 2], p1[r + 3]); }
    const float m = max2f(a, b);
    auto rr = __builtin_amdgcn_permlane32_swap(__float_as_uint(m), __float_as_uint(m), false, false);
    return max2f(__uint_as_float(rr[0]), __uint_as_float(rr[1]));
}
__device__ __forceinline__ void qkt(f32x16& p0, f32x16& p1, const char* Kslot, const f16x8* qr, f16x4 kb0, f16x4 kb1, f16x4 qe, int r32, int hi) {
    const char* kb = Kslot + hi * 1024 + r32 * 16;
    const f32x16 z = {};
    p0 = MF8(kb0, qe, z); p1 = MF8(kb1, qe, z);
#pragma unroll
    for (int d0 = 0; d0 < 4; ++d0) {
        const f16x8 b0 = *reinterpret_cast<const f16x8*>(kb + d0 * 2048);
        const f16x8 b1 = *reinterpret_cast<const f16x8*>(kb + d0 * 2048 + 512);
        p0 = MF16(b0, qr[d0], p0); p1 = MF16(b1, qr[d0], p1); }
}
__device__ __forceinline__ void pv(f32x16* o, int vb, f16x8 pa0, f16x8 pa1, f16x8 pa2, f16x8 pa3) {
#pragma unroll
    for (int d0 = 0; d0 < 2; ++d0) { s16x4 lo[4], hi[4];
#pragma unroll
        for (int ks = 0; ks < 4; ++ks) {
            asm volatile("ds_read_b64_tr_b16 %0,%1 offset:%c2" : "=&v"(lo[ks]) : "v"(vb), "i"(d0 * 4096 + ks * 1024) : "memory");
            asm volatile("ds_read_b64_tr_b16 %0,%1 offset:%c2" : "=&v"(hi[ks]) : "v"(vb), "i"(d0 * 4096 + ks * 1024 + 512) : "memory"); }
        asm volatile("s_waitcnt lgkmcnt(0)" ::: "memory"); SBAR();
        o[d0] = MF16(pa0, mk8(lo[0], hi[0]), o[d0]);
        o[d0] = MF16(pa1, mk8(lo[1], hi[1]), o[d0]);
        o[d0] = MF16(pa2, mk8(lo[2], hi[2]), o[d0]);
        o[d0] = MF16(pa3, mk8(lo[3], hi[3]), o[d0]);
    }
}
#define ATTN_ONES 0x3C003C00u
template <int THRL> __device__ __forceinline__ void attn_unit(int b, int h, int qb, const h16* Q, const h16* __restrict__ K, const h16* __restrict__ V, const h16* __restrict__ G, const float* __restrict__ cum, h16* O, char* shm, const int tid) {
    const int lane = tid & 63, r32 = lane & 31, hi = lane >> 5; const int wid = __builtin_amdgcn_readfirstlane(tid >> 6);
    const long rowbase = (long)b * SEQ; const int q0 = qb * QB;
    const h16* Qw = Q + (rowbase + q0 + wid * QBLK) * DMP + h * D;
    const h16* Kh = K + rowbase * DMP + h * D, *Vh = V + rowbase * DMP + h * D;
    const unsigned lds0 = (unsigned)(uintptr_t)shm;
    float* wsf = (float*)(shm + LDS_WS) + wid * 64;
    const h16* ksrc = Kh + (long)lane * DMP + wid * 8;
    const h16* vsrc = Vh + (long)(16 * (wid & 3) + (lane >> 2)) * DMP + (wid >> 2) * 32 + (lane & 3) * 8;
    const unsigned kdst = lds0 + LDS_K + wid * 1024, vdst = lds0 + LDS_V + wid * 1024;
#define DMA_K(t, slot) glds16(ksrc + (long)(t) * KVBLK * DMP, (unsigned)__builtin_amdgcn_readfirstlane(kdst + (slot)))
#define DMA_V(t, slot) glds16(vsrc + (long)(t) * KVBLK * DMP, (unsigned)__builtin_amdgcn_readfirstlane(vdst + (slot)))
    const int vb0 = (int)(lds0 + LDS_V) + ((lane >> 4) & 1) * 32 + (lane & 3) * 8 + (4 * hi + ((lane & 15) >> 2)) * 64;
    const char* Kbase = shm + LDS_K; f16x8 kf[8];
    const lds_cptr shm3 = (lds_cptr)shm; const lds_cptr kp0 = shm3 + LDS_K + hi * 1024 + r32 * 16; const lds_cptr vp0 = shm3 + LDS_V + ((lane >> 4) & 1) * 32 + (lane & 3) * 8 + (4 * hi + ((lane & 15) >> 2)) * 64;
    const LAS unsigned* biasw = (const LAS unsigned*)(shm3 + LDS_BIAS);
    const int NT = (q0 + QB) / KVBLK;
    DMA_K(0, 0); DMA_V(0, 0); DMA_K(1, SLOTB);
    { const float* cb = cum + (long)(b * FOX_H + h) * SEQ; const float cref = cb[q0];
      LAS unsigned* bw = (LAS unsigned*)(shm3 + LDS_BIAS);
      for (int j = tid; j < q0 + QB; j += NW * 64) bw[j] = split_hl(fmaxf((cref - cb[j]) * LOG2E, -30000.f)); }
    f16x8 qr[4];
#pragma unroll
    for (int d0 = 0; d0 < 4; ++d0) qr[d0] = *reinterpret_cast<const f16x8*>(&Qw[(long)r32 * DMP + d0 * 16 + hi * 8]);
    float mhat = 0.f, l_reg = 0.f; f32x16 o[2]; o[0] = f32x16{}; o[1] = f32x16{};
    unsigned qew1 = 0u;
    const unsigned qew0 = hi ? 0u : ATTN_ONES, kew1 = hi ? 0u : ATTN_ONES;
#define QE() ext_frag(qew0, qew1)
#define KE(w) ext_frag(hi ? 0u : (w), kew1)
#define SETM() do { qew1 = hi ? 0u : split_hl(-mhat); } while (0)
    const int qrel = wid * QBLK + r32;
#define CMASK(P0, P1, t) do { int jb_ = (t) - (NT - 4); if (jb_ >= 0) cmask(P0, P1, jb_, qrel, hi); } while (0)
    bool resc = false;
#define START(P0, P1) do { const float rm = rowmax(P0, P1); resc = false; \
    { const float dl = rm; mhat = fadd_s(mhat, dl); \
      _Pragma("unroll") for (int r = 0; r < 16; ++r) { P0[r] = fsub_s(P0[r], dl); P1[r] = fsub_s(P1[r], dl); } \
      SETM(); } \
    _Pragma("unroll") for (int r = 0; r < 16; ++r) P0[r] = __builtin_amdgcn_exp2f(P0[r]); } while (0)
#define RESC() do { if (resc) { asm volatile("s_waitcnt lgkmcnt(0)" ::: "memory"); \
      _Pragma("unroll") for (int d_ = 0; d_ < 2; ++d_) _Pragma("unroll") for (int r = 0; r < 16; ++r) o[d_][r] *= wsf[crow(r, hi)]; } } while (0)
    f32x16 pA0, pA1, pB0, pB1;
    int sl_prev = 0, sl_cur = 0, sl_next = SLOTB;
#define ROT() do { sl_prev = sl_cur; sl_cur = sl_next; sl_next = (sl_next == (NSLOT - 1) * SLOTB) ? 0 : sl_next + SLOTB; } while (0)
    DMA_K(2, 2 * SLOTB);
    WAIT_BAR(3);
    unsigned bw0 = biasw[r32], bw1 = biasw[32 + r32];
    qkt(pA0, pA1, Kbase, qr, KE(bw0), KE(bw1), QE(), r32, hi); asm volatile("s_nop 15\n\ts_nop 7" : "+v"(pA0), "+v"(pA1)); CMASK(pA0, pA1, 0);
    START(pA0, pA1);
    _Pragma("unroll") for (int r = 0; r < 16; ++r) pA1[r] = __builtin_amdgcn_exp2f(pA1[r]);
    WAIT_BAR(0);
    DMA_K(3, 0); DMA_V(1, SLOTB);
    ROT();
    kload8(kf, kp0 + sl_cur);
    bw0 = biasw[64 + r32]; bw1 = biasw[96 + r32];
    WAIT_BAR(2);
    s16x4 vlo[8], vhi[8]; u32x4 pw0, pw1, pw2, pw3;
#define PKW(P, B) pk2h(P[B], P[B + 1])
#define PAF(k) __builtin_bit_cast(f16x8, pw##k)
#define VFR(i) mk8(vlo[i], vhi[i])
#define PIN(x) asm volatile("" : "+v"(x))
#define MX3(a, b, c) __builtin_fmaxf(__builtin_fmaxf((a), (b)), (c))
#define GAPA(MF, A0, A1, A2, A3, W0, W1, PW) do { MF; sacc += A0; sacc += A1; sacc += A2; sacc += A3; PIN(sacc); W0; W1; PIN(PW); SBAR(); } while (0)
#define EX(v) __builtin_amdgcn_exp2f(v)
#define GAPB(MF, X, B) do { MF; X[B] = EX(X[B]); X[B + 1] = EX(X[B + 1]); X[B + 2] = EX(X[B + 2]); X[B + 3] = EX(X[B + 3]); PIN(X); SBAR(); } while (0)
#define VRD(i) do { vlo[i] = vtr(vp_ + (((i) >> 2) * 4096 + ((i) & 3) * 1024)); vhi[i] = vtr(vp_ + (((i) >> 2) * 4096 + ((i) & 3) * 1024 + 512)); } while (0)
#define KRD(G_, j) do { if (G_) { kload2(kf, kp0 + sl_next, j); SBAR(); } } while (0)
#define STEP(C0, C1, P0, P1, t, GK, GV, GL) do { SBAR(); \
    const lds_cptr vp_ = vp0 + sl_prev; const f32x16 z_ = {}; \
    C0 = MF8(KE(bw0), QE(), z_); C1 = MF8(KE(bw1), QE(), z_); SBAR(); \
    VRD(0); SBAR(); float sacc = (P0[0] + P0[1]); \
    GAPA(C0 = MF16(kf[0], qr[0], C0), P0[2], P0[3], P0[4], P0[5],     pw0[0] = PKW(P0, 0), pw0[1] = PKW(P0, 2), pw0); \
    VRD(4); SBAR(); GAPA(C1 = MF16(kf[1], qr[0], C1), P0[6], P0[7], P0[8], P0[9],     pw0[2] = PKW(P0, 4), pw0[3] = PKW(P0, 6), pw0); \
    VRD(1); SBAR(); GAPA(C0 = MF16(kf[2], qr[1], C0),   P0[10], P0[11], P0[12], P0[13], pw1[0] = PKW(P0, 8), pw1[1] = PKW(P0, 10), pw1); \
    VRD(5); SBAR(); GAPA(C1 = MF16(kf[3], qr[1], C1),   P0[14], P0[15], P1[0], P1[1],   pw1[2] = PKW(P0, 12), pw1[3] = PKW(P0, 14), pw1); \
    VRD(2); SBAR(); GAPA(C0 = MF16(kf[4], qr[2], C0),   P1[2], P1[3], P1[4], P1[5],     pw2[0] = PKW(P1, 0), pw2[1] = PKW(P1, 2), pw2); \
    VRD(6); SBAR(); GAPA(C1 = MF16(kf[5], qr[2], C1),   P1[6], P1[7], P1[8], P1[9],     pw2[2] = PKW(P1, 4), pw2[3] = PKW(P1, 6), pw2); \
    VRD(3); SBAR(); GAPA(C0 = MF16(kf[6], qr[3], C0),   P1[10], P1[11], P1[12], P1[13], pw3[0] = PKW(P1, 8), pw3[1] = PKW(P1, 10), pw3); \
    VRD(7); SBAR(); GAPA(C1 = MF16(kf[7], qr[3], C1),   P1[14], P1[15], 0.f, 0.f,       pw3[2] = PKW(P1, 12), pw3[3] = PKW(P1, 14), pw3); \
    l_reg += sacc; \
    if (GK) { DMA_K((t) + 3, sl_cur); } if (GV) { DMA_V((t) + 1, sl_next); } \
    CMASK(C0, C1, t); \
    { float a = MX3(C0[0], C0[1], C1[0]), b_ = MX3(C0[2], C0[3], C1[1]); a = MX3(a, C1[2], C1[3]); \
      _Pragma("unroll") for (int r = 4; r < 16; r += 4) { a = MX3(a, C0[r], C0[r + 1]); b_ = MX3(b_, C0[r + 2], C0[r + 3]); a = MX3(a, C1[r], C1[r + 1]); b_ = MX3(b_, C1[r + 2], C1[r + 3]); } \
      float rm = __builtin_fmaxf(a, b_); { auto rr = __builtin_amdgcn_permlane32_swap(__float_as_uint(rm), __float_as_uint(rm), false, false); rm = __builtin_fmaxf(__uint_as_float(rr[0]), __uint_as_float(rr[1])); } \
      resc = false; \
      if (__builtin_expect(__any(rm > (float)THRL), 0)) { const float dl = __builtin_fmaxf(rm, 0.f); mhat += dl; \
        _Pragma("unroll") for (int r = 0; r < 16; ++r) { C0[r] -= dl; C1[r] -= dl; } \
        SETM(); \
        const float f = __builtin_amdgcn_exp2f(-dl); l_reg *= f; if (hi == 0) wsf[r32] = f; resc = true; } } \
    SBAR(); \
    if (GL) { bw0 = biasw[((t) + 1) * 64 + r32]; bw1 = biasw[((t) + 1) * 64 + 32 + r32]; } \
    GAPB(o[0] = MF16(PAF(0), VFR(0), o[0]), C0, 0); \
    GAPB(o[1] = MF16(PAF(0), VFR(4), o[1]), C0, 4); \
    KRD(GL, 0); GAPB(o[0] = MF16(PAF(1), VFR(1), o[0]), C0, 8); \
    KRD(GL, 1); GAPB(o[1] = MF16(PAF(1), VFR(5), o[1]), C0, 12); \
    KRD(GL, 2); GAPB(o[0] = MF16(PAF(2), VFR(2), o[0]), C1, 0); \
    KRD(GL, 3); GAPB(o[1] = MF16(PAF(2), VFR(6), o[1]), C1, 4); \
    GAPB(o[0] = MF16(PAF(3), VFR(3), o[0]), C1, 8); \
    GAPB(o[1] = MF16(PAF(3), VFR(7), o[1]), C1, 12); \
    } while (0)
    int t = 1;
#undef CMASK
#define CMASK(P0, P1, t) do {} while (0)
    for (; t + 5 < NT; t += 2) {
        STEP(pB0, pB1, pA0, pA1, t, true, true, true);     WAIT_BAR(2); RESC(); ROT();
        STEP(pA0, pA1, pB0, pB1, t + 1, true, true, true); WAIT_BAR(2); RESC(); ROT();
    }
#undef CMASK
#define CMASK(P0, P1, t) do { int jb_ = (t) - (NT - 4); if (jb_ >= 0) cmask(P0, P1, jb_, qrel, hi); } while (0)
#define ENDW(tt) do { if ((tt) + 3 < NT) { WAIT_BAR(2); } else if ((tt) + 2 < NT) { WAIT_BAR(1); } else { WAIT_BAR(0); } } while (0)
    for (; t + 1 < NT; t += 2) {
        STEP(pB0, pB1, pA0, pA1, t, (t + 3 < NT), (t + 1 < NT), (t + 1 < NT));         ENDW(t);     RESC(); ROT();
        STEP(pA0, pA1, pB0, pB1, t + 1, (t + 4 < NT), (t + 2 < NT), (t + 2 < NT));     ENDW(t + 1); RESC(); ROT();
    }
    STEP(pB0, pB1, pA0, pA1, NT - 1, false, false, false); RESC();
    { float sacc = pB0[0] + pB0[1]; _Pragma("unroll") for (int r = 2; r < 16; ++r) sacc += pB0[r]; _Pragma("unroll") for (int r = 0; r < 16; ++r) sacc += pB1[r]; l_reg += sacc;
      pw0 = (u32x4){PKW(pB0, 0), PKW(pB0, 2), PKW(pB0, 4), PKW(pB0, 6)}; pw1 = (u32x4){PKW(pB0, 8), PKW(pB0, 10), PKW(pB0, 12), PKW(pB0, 14)}; pw2 = (u32x4){PKW(pB1, 0), PKW(pB1, 2), PKW(pB1, 4), PKW(pB1, 6)}; pw3 = (u32x4){PKW(pB1, 8), PKW(pB1, 10), PKW(pB1, 12), PKW(pB1, 14)};
      SBAR(); pv(o, vb0 + sl_cur, PAF(0), PAF(1), PAF(2), PAF(3)); }
#undef PKW
#undef PAF
#undef VFR
#undef PIN
#undef MX3
#undef GAPA
#undef GAPB
#undef EX
#undef VRD
#undef KRD
#undef STEP
#undef ENDW
    { auto rr = __builtin_amdgcn_permlane32_swap(__float_as_uint(l_reg), __float_as_uint(l_reg), false, false); l_reg = __uint_as_float(rr[0]) + __uint_as_float(rr[1]); }
    if (hi == 0) wsf[32 + r32] = l_reg; asm volatile("s_waitcnt lgkmcnt(0)" ::: "memory");
    float rli[16];
#pragma unroll
    for (int r = 0; r < 16; ++r) rli[r] = __builtin_amdgcn_rcpf(wsf[32 + crow(r, hi)]);
    h16* Ow = O + (rowbase + q0 + wid * QBLK) * DMP + h * D;
    const h16* Gw = G + (rowbase + q0 + wid * QBLK) * DMP + h * D;
    { h16* stg = (h16*)(shm + LDS_OST) + wid * 2048;
#pragma unroll
      for (int r = 0; r < 16; ++r) { const int orow = crow(r, hi);
#pragma unroll
        for (int d0 = 0; d0 < 2; ++d0) stg[orow * 64 + d0 * 32 + r32] = (h16)(o[d0][r] * rli[r]); }
      asm volatile("s_waitcnt lgkmcnt(0)" ::: "memory");
#pragma unroll
      for (int i = 0; i < 4; ++i) { const int row = i * 8 + (lane >> 3), ch = lane & 7; const f16x8 v = *(const f16x8*)(stg + row * 64 + ch * 8); const f16x8 g = *(const f16x8*)(Gw + (long)row * DMP + ch * 8);
        float r8[8];
#pragma unroll
        for (int e = 0; e < 8; ++e) { const float gg = (float)g[e]; r8[e] = (float)v[e] * __builtin_amdgcn_rcpf(1.0f + __builtin_amdgcn_exp2f(-gg * LOG2E)); }
        u32x4 w; w.x = pk2h(r8[0], r8[1]); w.y = pk2h(r8[2], r8[3]); w.z = pk2h(r8[4], r8[5]); w.w = pk2h(r8[6], r8[7]);
        *(u32x4*)(Ow + (long)row * DMP + ch * 8) = w; } }
    asm volatile("s_waitcnt lgkmcnt(0)\n\ts_barrier" ::: "memory");
#undef DMA_K
#undef DMA_V
#undef CMASK
#undef START
#undef RESC
#undef ROT
#undef QE
#undef KE
#undef SETM
}
#undef SBAR
#undef WAIT_BAR
#undef MF16
#undef MF8
}
constexpr int NWAVES = 8;
#ifndef MK_N_LAUNCHES
#define MK_N_LAUNCHES 1
#endif
constexpr int NSUB = 9;
constexpr int NPHASE = 2 + NSUB * DEPTH;
constexpr size_t MiB = 1u << 20;
constexpr size_t WS_CTL = 0, CTL_ZERO_BYTES = 1 * MiB;
constexpr size_t SZ_WFOX = (size_t)4096 * 1024 * 2, SZ_WFO = (size_t)1024 * 1024 * 2, SZ_WRET = (size_t)6144 * 1024 * 2, SZ_WRO = (size_t)1024 * 2048 * 2;
constexpr size_t SZ_WGU = (size_t)1024 * 1024 * 2, SZ_WD = (size_t)1024 * 512 * 2;
constexpr size_t WS_WFOX = 1 * MiB, WS_WFO = WS_WFOX + 2 * SZ_WFOX, WS_WRET = WS_WFO + 2 * SZ_WFO, WS_WRO = WS_WRET + 2 * SZ_WRET;
constexpr size_t WS_WGU = WS_WRO + 2 * SZ_WRO, WS_WD = WS_WGU + (size_t)DEPTH * NE * SZ_WGU, WS_WEND = WS_WD + (size_t)DEPTH * NE * SZ_WD;
constexpr size_t SZ_RW = (size_t)32 * 64 * 24 * 2, SZ_FW = (size_t)32 * 64 * 8 * 2;
constexpr size_t WS_RW = WS_WEND, WS_FW = WS_RW + DEPTH * SZ_RW, WS_ROPE = WS_FW + 2 * SZ_FW;
constexpr size_t WS_H = WS_ROPE + 2 * (size_t)SEQ * 128 * 4;
constexpr size_t WS_HN = WS_H + (size_t)T * DM * 4;
constexpr size_t WS_RSTD = WS_HN + (size_t)(T + 8) * DM * 2;
constexpr size_t WS_FLOG = WS_RSTD + (size_t)T * 4, WS_CUM = WS_FLOG + (size_t)T * 16 * 4;
constexpr size_t WS_EID = WS_CUM + (size_t)BATCH * FOX_H * SEQ * 4, WS_RANK = WS_EID + PAIRS * 4, WS_GATE = WS_RANK + PAIRS * 4, WS_LIST = WS_GATE + PAIRS * 4;
constexpr size_t WS_QKVG = (WS_LIST + (size_t)NE * LISTCAP * 4 + 255) & ~(size_t)255;
constexpr size_t SZ_T1K = (size_t)T * 1024 * 2;
constexpr size_t WS_OG = WS_QKVG + 6 * SZ_T1K;
constexpr size_t WS_RO = WS_OG + 2 * SZ_T1K;
constexpr size_t WS_END0 = WS_RO + 2 * SZ_T1K;
constexpr size_t WS_DUMMY = WS_END0;
constexpr size_t WS_END = WS_DUMMY + 160 * MiB;
constexpr size_t WS_Y = WS_QKVG;
constexpr size_t WS_ACT = WS_RO;
static_assert((size_t)PROWS * 1024 * 2 <= 6 * SZ_T1K && (size_t)PROWS * 512 * 2 <= 2 * SZ_T1K, "overlays");
constexpr int CW_TMO = 0, CW_BAR = 4096, CW_CNT = 16384, CW_CNT2 = 16384 + 1024;
constexpr int RING_BYTES = 147456;
constexpr int LDSCTL_OFF = RING_BYTES, MISC_OFF = LDSCTL_OFF;
constexpr int LDS_BYTES = RING_BYTES + 1024;

typedef GAS unsigned gu32;
__device__ __forceinline__ int lane_id_() { return (int)__builtin_amdgcn_mbcnt_hi(~0u, __builtin_amdgcn_mbcnt_lo(~0u, 0u)); }
#define TID0() (wave_sgpr == 0 && lane_id_() == 0)
#define RLX_AGENT __ATOMIC_RELAXED, __HIP_MEMORY_SCOPE_AGENT
#define LDS_WAIT() asm volatile("s_waitcnt lgkmcnt(0)" ::: "memory")

#define XB_TMO      128
#define XB_XCNT(j)  (256  + 64 * (j))
#define XB_XSUB(j)  (1280 + 64 * (j))
#define XB_XGEN(j)  (2304 + 64 * (j))
#define XB_TOP      3328
#define XB_TOPGEN   3392
#define XCD_BAR_WORDS 3456
#define XB_SPIN_CAP (1u << 18)
__device__ __forceinline__ unsigned xb_ld(unsigned* p)              { return __hip_atomic_load(p, __ATOMIC_RELAXED, __HIP_MEMORY_SCOPE_AGENT); }
__device__ __forceinline__ unsigned xb_add(unsigned* p, unsigned v) { return __hip_atomic_fetch_add(p, v, __ATOMIC_RELAXED, __HIP_MEMORY_SCOPE_AGENT); }
__device__ __forceinline__ unsigned xb_xcc_id() { return (unsigned)__builtin_amdgcn_s_getreg((3 << 11) | 20) & 0xFu; }
#define XB_SPIN(cond, bar) do { unsigned _sp = 0; while (cond) { __builtin_amdgcn_s_sleep(1); \
    if ((++_sp & 255u) == 0u) { if (xb_ld(&(bar)[XB_TMO])) break; if (_sp > XB_SPIN_CAP) { atomicAdd(&(bar)[XB_TMO], 1u); break; } } } } while (0)
struct XcdBarrier { unsigned* bar; unsigned x; volatile LAS unsigned* st; };
__device__ __forceinline__ XcdBarrier xcd_barrier_post(unsigned* bar, volatile LAS unsigned* st, const int wave_sgpr) {
    XcdBarrier b; b.bar = bar; b.x = xb_xcc_id(); b.st = st;
    if (TID0()) (void)xb_add(&bar[XB_XCNT(b.x)], 1u);
    return b;
}
__device__ __forceinline__ void xcd_barrier_complete(unsigned* bar, unsigned x, unsigned& nloc, unsigned& nx) {
    const unsigned G = gridDim.x * gridDim.y * gridDim.z;
    unsigned sum, cnt, mine, sp = 0u;
    for (;;) {
        sum = 0u; cnt = 0u; mine = 0u;
#pragma unroll
        for (unsigned j = 0; j < 16; ++j) { const unsigned c = xb_ld(&bar[XB_XCNT(j)]); sum += c; cnt += (c > 0u) ? 1u : 0u; mine = (j == x) ? c : mine; }
        if (sum == G) break;
        __builtin_amdgcn_s_sleep(1);
        if ((++sp & 255u) == 0u) { if (xb_ld(&bar[XB_TMO])) break; if (sp > XB_SPIN_CAP) { atomicAdd(&bar[XB_TMO], 1u); break; } }
    }
    nloc = mine > 0u ? mine : 1u; nx = cnt > 0u ? cnt : 1u;
}
__device__ __forceinline__ void xcd_barrier(const XcdBarrier& b, const bool leader) {
    asm volatile("s_waitcnt vmcnt(0)" ::: "memory");
    __syncthreads();
    if (leader) {
        unsigned* bar = b.bar;
        __builtin_amdgcn_s_waitcnt(0);
        unsigned nloc = b.st[0], nx = b.st[1];
        if (nloc == 0u) { xcd_barrier_complete(bar, b.x, nloc, nx); b.st[0] = nloc; b.st[1] = nx; }
        const unsigned old = xb_add(&bar[XB_XSUB(b.x)], 1u);
        const unsigned gen = old / nloc;
        if (old + 1u == (gen + 1u) * nloc) {
            __builtin_amdgcn_fence(__ATOMIC_RELEASE, "agent");
            asm volatile("s_waitcnt vmcnt(0)" ::: "memory");
            const unsigned og = xb_add(&bar[XB_TOP], 1u);
            const unsigned tg = og / nx;
            if (og + 1u == (tg + 1u) * nx) xb_add(&bar[XB_TOPGEN], 1u);
            else XB_SPIN(xb_ld(&bar[XB_TOPGEN]) == tg, bar);
            __builtin_amdgcn_fence(__ATOMIC_ACQUIRE, "agent");
            xb_add(&bar[XB_XGEN(b.x)], 1u);
            asm volatile("s_waitcnt vmcnt(0)" ::: "memory");
        } else {
            XB_SPIN(xb_ld(&bar[XB_XGEN(b.x)]) == gen, bar);
            __builtin_amdgcn_fence(__ATOMIC_ACQUIRE, "agent");
            asm volatile("s_waitcnt vmcnt(0)" ::: "memory");
        }
    }
    __syncthreads();
}

struct Args { const float* in[16]; float* out; unsigned char* ws; int ph_lo, ph_hi, li, pad; };

template <bool GU>
__device__ __forceinline__ void transpose_item(const float* W, int K, int ld, h16* WT, LAS float* scr, int kb, int nb, int lane) {
    const int k0 = 64 * kb, n0 = 64 * nb;
    const int lc = (lane & 15) * 4;
    const int srccol = GU ? ((lc < 32) ? (n0 / 2 + lc) : (512 + n0 / 2 + (lc - 32))) : (n0 + lc);
#pragma unroll 4
    for (int it = 0; it < 16; ++it) { const int kk = 4 * it + (lane >> 4);
        const f32x4 v = *(const f32x4*)(W + (size_t)(k0 + kk) * ld + srccol);
        scr[kk * 65 + lc + 0] = v[0]; scr[kk * 65 + lc + 1] = v[1]; scr[kk * 65 + lc + 2] = v[2]; scr[kk * 65 + lc + 3] = v[3]; }
    LDS_WAIT(); asm volatile("" ::: "memory");
    const int c = lane & 7;
#pragma unroll
    for (int j = 0; j < 8; ++j) { const int nn = 8 * j + (lane >> 3);
        const int cc = GU ? (((nn & 7) < 4) ? (4 * (nn >> 3) + (nn & 7)) : (32 + 4 * (nn >> 3) + ((nn & 7) - 4))) : nn;
        const LAS float* s = scr + (8 * c) * 65 + cc;
        u32x4 o; o.x = pk2h(s[0 * 65], s[1 * 65]); o.y = pk2h(s[2 * 65], s[3 * 65]); o.z = pk2h(s[4 * 65], s[5 * 65]); o.w = pk2h(s[6 * 65], s[7 * 65]);
        *(GAS u32x4*)(WT + (size_t)(n0 + nn) * K + k0 + 8 * c) = o; }
    LDS_WAIT(); asm volatile("" ::: "memory");
}

__device__ __forceinline__ float shfl_idx(float v, int src) { return __int_as_float(__builtin_amdgcn_ds_bpermute(src << 2, __float_as_int(v))); }
__device__ __forceinline__ float wave_sum(float v, int lane) {
#pragma unroll
    for (int o = 1; o < 64; o <<= 1) v += shfl_idx(v, lane ^ o);
    return v;
}
__device__ __forceinline__ void rope_cs(int pos, int m, float& c, float& s) {
    const float e = -(float)m * (13.287712379549449f / 127.0f);
    const float inv = exp2f(e);
    const float ang = (float)pos * inv;
    const float k = rintf(ang * 0.6366197723675814f);
    float r = fmaf(-k, 1.5703125f, ang); r = fmaf(-k, 4.837512969970703125e-4f, r); r = fmaf(-k, 7.54978995489188216e-8f, r);
    const float z = r * r;
    const float sp = fmaf(r * z, fmaf(z, fmaf(z, -1.9515295891e-4f, 8.3321608736e-3f), -1.6666654611e-1f), r);
    const float cp = fmaf(z * z, fmaf(z, fmaf(z, 2.443315711809948e-5f, -1.388731625493765e-3f), 4.166664568298827e-2f), fmaf(z, -0.5f, 1.0f));
    const int q = ((int)k) & 3;
    c = (q == 0) ? cp : (q == 1) ? -sp : (q == 2) ? -cp : sp;
    s = (q == 0) ? sp : (q == 1) ? cp : (q == 2) ? -sp : -cp;
}
#ifndef PROBE_AMP2
#define PROBE_AMP2 8
#endif
#if defined(PROBE_A) && defined(PROBE_B)
#define PROBE_MARK(id) do { if ((id) == PROBE_A || (id) == PROBE_B) { if (blockIdx.x == 0 && __builtin_amdgcn_readfirstlane(threadIdx.x) == 0 && lane_id_() == 0) { \
    volatile LAS unsigned* pm_ = (volatile LAS unsigned*)(size_t)(MISC_OFF + 800); if ((id) == PROBE_A) pm_[0] = (unsigned)__builtin_amdgcn_s_memrealtime(); if ((id) == PROBE_B) pm_[1] = (unsigned)__builtin_amdgcn_s_memrealtime(); } } } while (0)
#else
#define PROBE_MARK(id) do {} while (0)
#endif
struct RowArgs {
    const float* src; float* h; h16* hn; float* rstd; const float* gnorm;
    const h16* y; const int* eidp; const int* rankp; const float* gatep;
    const h16* tabh; const float* bias0; const float* bias1; float* flog;
    int* eid; int* rank; float* gate; unsigned* counts; int* list;
};
template <bool COMBINE, bool STORE_H, int NT_>
__device__ __forceinline__ void row_pass(const RowArgs& A, int g, bool valid, int lane, int ch, int wave, LAS float* xch, LAS float* scr, LAS unsigned* blk, const volatile LAS unsigned* padstart) {
    const int r = lane & 15, kq = lane >> 4; const int t = 16 * g + r;
    constexpr int NA = NT_ > 0 ? NT_ : 1;
    f32x4 acc[NA];
#pragma unroll
    for (int i = 0; i < NA; ++i) acc[i] = (f32x4){0.f, 0.f, 0.f, 0.f};
    float ss = 0.f; float bia[NA];
#pragma unroll
    for (int i = 0; i < NA; ++i) bia[i] = 0.f;
    if (NT_ == 3) { if (wave == 0) blk[lane] = 0u; }
    if (NT_ == 3) PROBE_MARK(61);
    if (valid) {
        if (NT_ == 1) bia[0] = A.bias0[r];
        if (NT_ == 3) { bia[0] = A.bias1[r]; bia[1] = A.bias1[16 + r]; bia[2] = A.bias0[r & 3]; }
        const float* srow = A.src + (size_t)t * DM + 8 * kq + 512 * ch; float* hrow = A.h + (size_t)t * DM + 8 * kq + 512 * ch; h16* nrow = A.hn + (size_t)t * DM + 8 * kq + 512 * ch;
        const h16* y0 = nullptr; const h16* y1 = nullptr; float g0 = 0.f, g1 = 0.f;
        if (COMBINE) { const int e0 = A.eidp[2 * t], e1 = A.eidp[2 * t + 1]; const int p0 = (int)padstart[e0] + A.rankp[2 * t], p1 = (int)padstart[e1] + A.rankp[2 * t + 1];
            g0 = A.gatep[2 * t]; g1 = A.gatep[2 * t + 1]; y0 = A.y + (size_t)p0 * DM + 8 * kq + 512 * ch; y1 = A.y + (size_t)p1 * DM + 8 * kq + 512 * ch; }
        const float* gnp = A.gnorm + 8 * kq + 512 * ch;
        const h16* tabp = A.tabh + ((size_t)(16 * ch) * 64 + lane) * (8 * NA);
#ifndef RP_BATCH_MODE
#define RP_BATCH_MODE 5
#endif
        if constexpr ((COMBINE && (RP_BATCH_MODE & 1)) || (!COMBINE && NT_ == 3 && (RP_BATCH_MODE & 2)) || (!COMBINE && NT_ != 3 && (RP_BATCH_MODE & 4))) {
#pragma unroll 1
        for (int itb = 0; itb < 16; itb += 4) {
            f32x4 V0[4], V1[4]; f16x8 YA[4], YB[4];
#pragma unroll
            for (int u = 0; u < 4; ++u) { const int it = itb + u; V0[u] = *(const f32x4*)(srow + 32 * it); V1[u] = *(const f32x4*)(srow + 32 * it + 4);
                if (COMBINE) { YA[u] = *(const f16x8*)(y0 + 32 * it); YB[u] = *(const f16x8*)(y1 + 32 * it); } }
#ifdef RP_WAIT
            asm volatile("s_waitcnt vmcnt(0)" ::: "memory");
#else
            asm volatile("" ::: "memory");
#endif
#pragma unroll
            for (int u = 0; u < 4; ++u) { const int it = itb + u;
                f32x4 v0 = V0[u], v1 = V1[u];
                if (COMBINE) { const f16x8 a = YA[u], b = YB[u];
#pragma unroll
                    for (int q = 0; q < 4; ++q) { v0[q] += (float)a[q] * g0 + (float)b[q] * g1; v1[q] += (float)a[4 + q] * g0 + (float)b[4 + q] * g1; } }
                if (STORE_H) { *(f32x4*)(hrow + 32 * it) = v0; *(f32x4*)(hrow + 32 * it + 4) = v1; }
                ss += (v0[0] * v0[0] + v0[1] * v0[1]) + (v0[2] * v0[2] + v0[3] * v0[3]) + (v1[0] * v1[0] + v1[1] * v1[1]) + (v1[2] * v1[2] + v1[3] * v1[3]);
                const f32x4 gn0 = *(const f32x4*)(gnp + 32 * it), gn1 = *(const f32x4*)(gnp + 32 * it + 4);
                const f32x4 a0 = v0 * gn0, a1 = v1 * gn1;
                u32x4 w; w.x = pk2h(a0[0], a0[1]); w.y = pk2h(a0[2], a0[3]); w.z = pk2h(a1[0], a1[1]); w.w = pk2h(a1[2], a1[3]);
                *(u32x4*)(nrow + 32 * it) = w;
                if (NT_ > 0) {
                    const h16* tp = tabp + (size_t)it * 64 * 8 * NA;
                    const f16x8 af = __builtin_bit_cast(f16x8, w);
#pragma unroll
                    for (int tl = 0; tl < NT_; ++tl) acc[tl] = __builtin_amdgcn_mfma_f32_16x16x32_f16(af, *(const f16x8*)(tp + 8 * tl), acc[tl], 0, 0, 0);
                }
            }
        }
        } else {
#pragma unroll 4
        for (int it = 0; it < 16; ++it) {
            f32x4 v0 = *(const f32x4*)(srow + 32 * it), v1 = *(const f32x4*)(srow + 32 * it + 4);
            if (COMBINE) { const f16x8 a = *(const f16x8*)(y0 + 32 * it), b = *(const f16x8*)(y1 + 32 * it);
#pragma unroll
                for (int q = 0; q < 4; ++q) { v0[q] += (float)a[q] * g0 + (float)b[q] * g1; v1[q] += (float)a[4 + q] * g0 + (float)b[4 + q] * g1; } }
            if (STORE_H) { *(f32x4*)(hrow + 32 * it) = v0; *(f32x4*)(hrow + 32 * it + 4) = v1; }
            ss += (v0[0] * v0[0] + v0[1] * v0[1]) + (v0[2] * v0[2] + v0[3] * v0[3]) + (v1[0] * v1[0] + v1[1] * v1[1]) + (v1[2] * v1[2] + v1[3] * v1[3]);
            const f32x4 gn0 = *(const f32x4*)(gnp + 32 * it), gn1 = *(const f32x4*)(gnp + 32 * it + 4);
            const f32x4 a0 = v0 * gn0, a1 = v1 * gn1;
            u32x4 w; w.x = pk2h(a0[0], a0[1]); w.y = pk2h(a0[2], a0[3]); w.z = pk2h(a1[0], a1[1]); w.w = pk2h(a1[2], a1[3]);
            *(u32x4*)(nrow + 32 * it) = w;
            if (NT_ > 0) {
                const h16* tp = tabp + (size_t)it * 64 * 8 * NA;
                const f16x8 af = __builtin_bit_cast(f16x8, w);
#pragma unroll
                for (int tl = 0; tl < NT_; ++tl) acc[tl] = __builtin_amdgcn_mfma_f32_16x16x32_f16(af, *(const f16x8*)(tp + 8 * tl), acc[tl], 0, 0, 0);
            }
        }
        }
        ss += shfl_idx(ss, lane ^ 16); ss += shfl_idx(ss, lane ^ 32);
        if (NT_ == 3) PROBE_MARK(62);
        if (ch == 1) { xch[lane] = ss;
#pragma unroll
            for (int tl = 0; tl < NT_; ++tl)
#pragma unroll
                for (int q = 0; q < 4; ++q) xch[64 * (1 + 4 * tl + q) + lane] = acc[tl][q]; }
    }
    __syncthreads();
    if (NT_ == 3) PROBE_MARK(63);
    int e0 = 0, e1 = 0, lr0 = 0, lr1 = 0; float ga = 0.f, gb = 0.f;
    if (valid && ch == 0) {
        ss += xch[lane];
#pragma unroll
        for (int tl = 0; tl < NT_; ++tl)
#pragma unroll
            for (int q = 0; q < 4; ++q) acc[tl][q] += xch[64 * (1 + 4 * tl + q) + lane];
        const float rs = 1.0f / sqrtf(ss * (1.0f / DM) + EPS);
        if (kq == 0) A.rstd[t] = rs;
        if (NT_ > 0) {
            float rst[4];
#pragma unroll
            for (int q = 0; q < 4; ++q) rst[q] = shfl_idx(rs, 4 * kq + q);
            if (NT_ == 1) {
#pragma unroll
                for (int q = 0; q < 4; ++q) A.flog[(size_t)(16 * g + 4 * kq + q) * 16 + r] = acc[0][q] * rst[q] + bia[0];
            } else {
#pragma unroll
                for (int tl = 0; tl < NT_; ++tl)
#pragma unroll
                    for (int q = 0; q < 4; ++q) scr[(4 * kq + q) * 48 + 16 * tl + r] = acc[tl][q] * rst[q] + bia[tl];
                LDS_WAIT(); asm volatile("" ::: "memory");
                if (lane < 16) {
                    const LAS float* sr = scr + r * 48;
                    float gl[4];
#pragma unroll
                    for (int q = 0; q < 4; ++q) gl[q] = sr[32 + q];
                    int gi = 0; float gmax = gl[0];
#pragma unroll
                    for (int q = 1; q < 4; ++q) if (gl[q] > gmax) { gmax = gl[q]; gi = q; }
                    float gs = 0.f;
#pragma unroll
                    for (int q = 0; q < 4; ++q) gs += __expf(gl[q] - gmax);
                    const float pg = 1.0f / gs;
                    float el[8];
#pragma unroll
                    for (int e = 0; e < 8; ++e) el[e] = sr[gi * 8 + e];
                    int i0 = 0; float emax = el[0];
#pragma unroll
                    for (int e = 1; e < 8; ++e) if (el[e] > emax) { emax = el[e]; i0 = e; }
                    int i1 = -1; float b1 = -3.0e38f;
#pragma unroll
                    for (int e = 0; e < 8; ++e) if (e != i0 && el[e] > b1) { b1 = el[e]; i1 = e; }
                    const float p1 = __expf(b1 - emax);
                    ga = pg / (1.0f + p1); gb = pg * p1 / (1.0f + p1);
                    e0 = gi * 8 + i0; e1 = gi * 8 + i1;
                    lr0 = (int)__hip_atomic_fetch_add(blk + e0, 1u, __ATOMIC_RELAXED, __HIP_MEMORY_SCOPE_WORKGROUP);
                    lr1 = (int)__hip_atomic_fetch_add(blk + e1, 1u, __ATOMIC_RELAXED, __HIP_MEMORY_SCOPE_WORKGROUP);
                }
            }
        }
    }
    if (NT_ == 3) {
        __syncthreads();
        if (wave == 0 && lane < NE) { const unsigned c = blk[lane]; unsigned base = 0u; if (c) base = atomicAdd(A.counts + lane, c); blk[32 + lane] = base; }
        __syncthreads();
        if (valid && ch == 0 && lane < 16) {
            const int r0 = (int)blk[32 + e0] + lr0, r1 = (int)blk[32 + e1] + lr1;
            A.list[e0 * LISTCAP + r0] = 2 * t; A.list[e1 * LISTCAP + r1] = 2 * t + 1;
            A.eid[2 * t] = e0; A.eid[2 * t + 1] = e1; A.rank[2 * t] = r0; A.rank[2 * t + 1] = r1; A.gate[2 * t] = ga; A.gate[2 * t + 1] = gb;
        }
    }
    if (NT_ == 3) PROBE_MARK(64);
    __syncthreads();
    if (NT_ == 3) PROBE_MARK(65);
}
template <bool COMBINE, bool STORE_H, int NT_>
__device__ __forceinline__ void row_pass_all(const RowArgs& A, int vcu, int G, int wave, int lane, LAS unsigned char* lds, const volatile LAS unsigned* padstart) {
    const int pr = wave & 3, ch = wave >> 2;
    LAS float* xch = (LAS float*)(lds + pr * 4096); LAS float* scr = (LAS float*)(lds + 16384 + pr * 4096); LAS unsigned* blk = (LAS unsigned*)(lds + 32768);
    for (int base = 0; base < T / 16; base += 4 * G) { const int g = base + pr * G + vcu; row_pass<COMBINE, STORE_H, NT_>(A, g, g < T / 16, lane, ch, wave, xch, scr, blk, padstart); }
}
__device__ __forceinline__ void final_row(const float* h, const h16* y, const int* eidp, const int* rankp, const float* gatep, const volatile LAS unsigned* padstart, const float* gf, float* out, int t, int lane) {
    const int e0 = eidp[2 * t], e1 = eidp[2 * t + 1]; const int p0 = (int)padstart[e0] + rankp[2 * t], p1 = (int)padstart[e1] + rankp[2 * t + 1];
    const float g0 = gatep[2 * t], g1 = gatep[2 * t + 1];
    const f32x4* hr = (const f32x4*)(h + (size_t)t * DM) + lane; const f16x4* ya = (const f16x4*)(y + (size_t)p0 * DM) + lane; const f16x4* yb = (const f16x4*)(y + (size_t)p1 * DM) + lane;
    f32x4 v[4]; float s = 0.f;
#pragma unroll
    for (int j = 0; j < 4; ++j) { const f16x4 a = ya[64 * j], b = yb[64 * j]; v[j] = hr[64 * j];
#pragma unroll
        for (int q = 0; q < 4; ++q) v[j][q] += (float)a[q] * g0 + (float)b[q] * g1;
        s += (v[j][0] * v[j][0] + v[j][1] * v[j][1]) + (v[j][2] * v[j][2] + v[j][3] * v[j][3]); }
    const float rs = 1.0f / sqrtf(wave_sum(s, lane) * (1.0f / DM) + EPS);
    f32x4* o = (f32x4*)(out + (size_t)t * DM) + lane;
#pragma unroll
    for (int j = 0; j < 4; ++j) o[64 * j] = v[j] * rs * ((const f32x4*)gf)[lane + 64 * j];
}
__device__ __forceinline__ void ret_gn_item(const h16* ro, const h16* gate, const float* gain, h16* og, int w, int lane) {
    const int t = w >> 2, h = w & 3;
    const f16x8 ov = *(const f16x8*)(ro + (size_t)t * 2048 + h * 512 + lane * 8);
    const f16x8 gv = *(const f16x8*)(gate + (size_t)(h >> 1) * T * 1024 + (size_t)t * 1024 + (h & 1) * 512 + lane * 8);
    float v[8]; float s = 0.f;
#pragma unroll
    for (int j = 0; j < 8; ++j) { v[j] = (float)ov[j]; s += v[j]; }
    const float mu = wave_sum(s, lane) * (1.0f / RET_DV); float q = 0.f;
#pragma unroll
    for (int j = 0; j < 8; ++j) { v[j] -= mu; q += v[j] * v[j]; }
    const float rs = 1.0f / sqrtf(wave_sum(q, lane) * (1.0f / RET_DV) + EPS);
    const f32x4 ga = *(const f32x4*)(gain + h * 512 + lane * 8), gb = *(const f32x4*)(gain + h * 512 + lane * 8 + 4);
    float o[8];
#pragma unroll
    for (int j = 0; j < 8; ++j) { const float gg = (float)gv[j]; const float gn = (j < 4) ? ga[j & 3] : gb[j & 3];
        o[j] = v[j] * rs * gn * gg * __builtin_amdgcn_rcpf(1.0f + __builtin_amdgcn_exp2f(-gg * LOG2E)); }
    u32x4 wv; wv.x = pk2h(o[0], o[1]); wv.y = pk2h(o[2], o[3]); wv.z = pk2h(o[4], o[5]); wv.w = pk2h(o[6], o[7]);
    *(u32x4*)(og + (size_t)t * 2048 + h * 512 + lane * 8) = wv;
}

namespace ret_body {
constexpr int KLP = 528, VLP = 144, RLP = 528;
constexpr int OFF_KL = 0, OFF_VL = 128 * KLP, OFF_VD = OFF_VL + 128 * VLP, OFF_RL = OFF_VD + 128 * VLP, END = OFF_RL + 64 * RLP, OFF_OS = 0;
static_assert(END <= RING_BYTES, "retention LDS");
#define MF16(a, b, c) __builtin_amdgcn_mfma_f32_32x32x16_f16(a, b, c, 0, 0, 0)
__device__ __forceinline__ int crow(int r, int hi) { return (r & 3) + 8 * (r >> 2) + 4 * hi; }
typedef short v4i16_t __attribute__((ext_vector_type(4)));
__device__ __forceinline__ s16x4 vtr(LAS const char* p) { return __builtin_bit_cast(s16x4, __builtin_amdgcn_ds_read_tr16_b64_v4i16((LAS v4i16_t*)p)); }
__device__ __forceinline__ f16x8 mk8(s16x4 lo, s16x4 hi) { typedef short s16x8 __attribute__((ext_vector_type(8))); s16x8 t = {lo[0], lo[1], lo[2], lo[3], hi[0], hi[1], hi[2], hi[3]}; return __builtin_bit_cast(f16x8, t); }
__device__ __forceinline__ f16x8 pack8(const f32x16& S, int b) { u32x4 w; w.x = pk2h(S[b], S[b + 1]); w.y = pk2h(S[b + 2], S[b + 3]); w.z = pk2h(S[b + 4], S[b + 5]); w.w = pk2h(S[b + 6], S[b + 7]); return __builtin_bit_cast(f16x8, w); }
__device__ __forceinline__ void s_item(int b, int h, int n, const h16* __restrict__ Qr, const h16* __restrict__ Kr, u32x4* __restrict__ SF, const int tid) {
    const int lane = tid & 63, r32 = lane & 31, hi = lane >> 5; const int wid = __builtin_amdgcn_readfirstlane(tid >> 6);
    const int wi = wid & 3, wj = wid >> 2;
    if (wj == 1 && wi < 2) return;
    const float lg2 = log2f(1.0f - exp2f(-5.0f - (float)h));
    const size_t t0 = (size_t)b * SEQ + (size_t)n * 128;
    const h16* qp = Qr + (t0 + 32 * wi + r32) * 1024 + h * 256 + 8 * hi;
    const h16* kp = Kr + (t0 + 64 * wj + r32) * 1024 + h * 256 + 8 * hi;
    f32x16 S0 = {}, S1 = {};
#pragma unroll 4
    for (int s = 0; s < 16; ++s) { const f16x8 qf = *(const f16x8*)(qp + 16 * s), a0 = *(const f16x8*)(kp + 16 * s), a1 = *(const f16x8*)(kp + 32 * 1024 + 16 * s);
        S0 = MF16(a0, qf, S0); S1 = MF16(a1, qf, S1); }
    const int ig = 32 * wi + r32;
#pragma unroll
    for (int r = 0; r < 16; ++r) { const int j0 = 64 * wj + crow(r, hi), j1 = j0 + 32;
        S0[r] = (ig >= j0) ? S0[r] * __builtin_amdgcn_exp2f(lg2 * (float)(ig - j0)) : 0.f;
        S1[r] = (ig >= j1) ? S1[r] * __builtin_amdgcn_exp2f(lg2 * (float)(ig - j1)) : 0.f; }
    u32x4* o = SF + ((size_t)((b * RET_H + h) * (SEQ / 128) + n) * 8 + wid) * 4 * 64 + lane;
    o[0] = __builtin_bit_cast(u32x4, pack8(S0, 0)); o[64] = __builtin_bit_cast(u32x4, pack8(S0, 8)); o[128] = __builtin_bit_cast(u32x4, pack8(S1, 0)); o[192] = __builtin_bit_cast(u32x4, pack8(S1, 8));
}
__device__ __forceinline__ void ret_item(int b, int h, int sl, const h16* __restrict__ Qr, const h16* __restrict__ Kr, const h16* __restrict__ Vb, const u32x4* __restrict__ SF, h16* __restrict__ O, LAS unsigned char* lds, const int tid_arg) {
    int tid_in = tid_arg; asm volatile("" : "+v"(tid_in));
    const float lg2 = log2f(1.0f - exp2f(-5.0f - (float)h));
    const float cd = exp2f(128.0f * lg2);
    f32x16 R0 = {}, R1 = {};
    u32x4 kreg[8]; f16x8 vreg[2];
    { const size_t t0 = (size_t)b * SEQ;
#pragma unroll
      for (int i = 0; i < 8; ++i) { const int p = tid_in + 512 * i, j = p >> 5, c16 = p & 31; kreg[i] = *(const u32x4*)(Kr + (t0 + j) * 1024 + h * 256 + c16 * 8); }
#pragma unroll
      for (int i = 0; i < 2; ++i) { const int p = tid_in + 512 * i, j = p >> 3, c16 = p & 7; vreg[i] = *(const f16x8*)(Vb + (t0 + j) * 1024 + c16 * 8); } }
    for (int n = 0; n < SEQ / 128; ++n) {
        int tid = tid_in; asm volatile("" : "+v"(tid));
        const int lane = tid & 63, r32 = lane & 31, hi = lane >> 5; const int wid = __builtin_amdgcn_readfirstlane(tid >> 6);
        const int wi = wid & 3, wj = wid >> 2;
        const bool act_s = !(wj == 1 && wi < 2);
        const int trq = (lane & 15) >> 2, trp = lane & 3, trg = (lane >> 4) & 1;
        const size_t t0 = (size_t)b * SEQ + (size_t)n * 128;
        if (n == 8) PROBE_MARK(71);
        f16x8 qh[8]; u32x4 sfr[4];
        if (n > 0) { const h16* qp = Qr + (t0 + 32 * wi + r32) * 1024 + h * 256 + 8 * hi + 128 * wj;
#pragma unroll
            for (int s = 0; s < 8; ++s) qh[s] = *(const f16x8*)(qp + 16 * s); }
        if (act_s) { const u32x4* sp = SF + ((size_t)((b * RET_H + h) * (SEQ / 128) + n) * 8 + wid) * 4 * 64 + lane;
#pragma unroll
            for (int f = 0; f < 4; ++f) sfr[f] = sp[64 * f]; }
#pragma unroll
        for (int i = 0; i < 8; ++i) { const int p = tid + 512 * i, j = p >> 5, c16 = p & 31; *(LAS u32x4*)(lds + OFF_KL + j * KLP + c16 * 16) = kreg[i]; }
#pragma unroll
        for (int i = 0; i < 2; ++i) { const int p = tid + 512 * i, j = p >> 3, c16 = p & 7; const f16x8 v = vreg[i];
            *(LAS f16x8*)(lds + OFF_VL + j * VLP + c16 * 16) = v;
            const float kd = __builtin_amdgcn_exp2f(lg2 * (float)(127 - j));
            u32x4 w; w.x = pk2h((float)v[0] * kd, (float)v[1] * kd); w.y = pk2h((float)v[2] * kd, (float)v[3] * kd); w.z = pk2h((float)v[4] * kd, (float)v[5] * kd); w.w = pk2h((float)v[6] * kd, (float)v[7] * kd);
            *(LAS u32x4*)(lds + OFF_VD + j * VLP + c16 * 16) = w; }
        __syncthreads();
        if (n + 1 < SEQ / 128) {
            const size_t t1 = t0 + 128;
#pragma unroll
            for (int i = 0; i < 8; ++i) { const int p = tid + 512 * i, j = p >> 5, c16 = p & 31; kreg[i] = *(const u32x4*)(Kr + (t1 + j) * 1024 + h * 256 + c16 * 8); }
#pragma unroll
            for (int i = 0; i < 2; ++i) { const int p = tid + 512 * i, j = p >> 3, c16 = p & 7; vreg[i] = *(const f16x8*)(Vb + (t1 + j) * 1024 + c16 * 8); }
        }
        __builtin_amdgcn_sched_barrier(0);
        if (n == 8) PROBE_MARK(72);
        f32x16 OT0 = {}, OT1 = {};
        if (n > 0) {
            const LAS unsigned char* rp = lds + OFF_RL + r32 * RLP + 16 * hi + 256 * wj;
#pragma unroll
            for (int s = 0; s < 8; ++s) { const f16x8 a0 = *(const LAS f16x8*)(rp + 32 * s), a1 = *(const LAS f16x8*)(rp + 32 * RLP + 32 * s);
                OT0 = MF16(a0, qh[s], OT0); OT1 = MF16(a1, qh[s], OT1); if ((s & 3) == 3) __builtin_amdgcn_sched_barrier(0); }
            const float qd = __builtin_amdgcn_exp2f(lg2 * (float)(32 * wi + r32 + 1));
#pragma unroll
            for (int r = 0; r < 16; ++r) { OT0[r] *= qd; OT1[r] *= qd; }
        }
        __builtin_amdgcn_sched_barrier(0);
        if (n == 8) PROBE_MARK(73);
        if (act_s) {
#pragma unroll
            for (int jt = 0; jt < 2; ++jt)
#pragma unroll
                for (int s2 = 0; s2 < 2; ++s2) {
                    const int jb = 64 * wj + 32 * jt + 16 * s2 + 4 * hi + trq;
                    const LAS char* vp = (const LAS char*)(lds + OFF_VL + jb * VLP + (16 * trg + 4 * trp) * 2);
                    const f16x8 v0 = mk8(vtr(vp), vtr(vp + 8 * VLP)), v1 = mk8(vtr(vp + 64), vtr(vp + 64 + 8 * VLP));
                    const f16x8 sfv = __builtin_bit_cast(f16x8, sfr[2 * jt + s2]);
                    OT0 = MF16(v0, sfv, OT0); OT1 = MF16(v1, sfv, OT1); }
        }
        __builtin_amdgcn_sched_barrier(0);
        if (n == 8) PROBE_MARK(74);
#pragma unroll
        for (int r = 0; r < 16; ++r) { R0[r] *= cd; R1[r] *= cd; }
#pragma unroll
        for (int s = 0; s < 8; ++s) {
            const int jb = 16 * s + 8 * hi + trq;
            const LAS char* kp = (const LAS char*)(lds + OFF_KL + jb * KLP + (32 * wid + 16 * trg + 4 * trp) * 2);
            const LAS char* vp = (const LAS char*)(lds + OFF_VD + jb * VLP + (16 * trg + 4 * trp) * 2);
            const f16x8 ka = mk8(vtr(kp), vtr(kp + 4 * KLP));
            const f16x8 v0 = mk8(vtr(vp), vtr(vp + 4 * VLP)), v1 = mk8(vtr(vp + 64), vtr(vp + 64 + 4 * VLP));
            R0 = MF16(ka, v0, R0); R1 = MF16(ka, v1, R1); if ((s & 1) == 1) __builtin_amdgcn_sched_barrier(0); }
        if (n == 8) PROBE_MARK(75);
        __syncthreads();
        if (n == 8) PROBE_MARK(76);
        {
#pragma unroll
            for (int g4 = 0; g4 < 4; ++g4) {
                u32x2 w; w.x = pk2h(R0[4 * g4], R0[4 * g4 + 1]); w.y = pk2h(R0[4 * g4 + 2], R0[4 * g4 + 3]);
                *(LAS u32x2*)(lds + OFF_RL + r32 * RLP + (32 * wid + 8 * g4 + 4 * hi) * 2) = w;
                w.x = pk2h(R1[4 * g4], R1[4 * g4 + 1]); w.y = pk2h(R1[4 * g4 + 2], R1[4 * g4 + 3]);
                *(LAS u32x2*)(lds + OFF_RL + (32 + r32) * RLP + (32 * wid + 8 * g4 + 4 * hi) * 2) = w; }
            LAS float* os = (LAS float*)(lds + OFF_OS) + wid * 1024 + lane;
#pragma unroll
            for (int r = 0; r < 16; ++r) os[64 * r] = wj ? OT0[r] : OT1[r];
        }
        __syncthreads();
        {
            const LAS float* os = (const LAS float*)(lds + OFF_OS) + (wid ^ 4) * 1024 + lane;
            h16* op = O + (t0 + 32 * wi + r32) * 2048 + h * 512 + sl * 64 + 32 * wj + 4 * hi;
#pragma unroll
            for (int g4 = 0; g4 < 4; ++g4) { float f[4];
#pragma unroll
                for (int q = 0; q < 4; ++q) f[q] = (wj ? OT1[4 * g4 + q] : OT0[4 * g4 + q]) + os[64 * (4 * g4 + q)];
                u32x2 w; w.x = pk2h(f[0], f[1]); w.y = pk2h(f[2], f[3]); *(u32x2*)(op + 8 * g4) = w; }
        }
        if (n == 8) PROBE_MARK(77);
        __syncthreads();
        if (n == 8) PROBE_MARK(78);
    }
}
#undef MF16
}

template <bool GATHER_> struct MoeOrderT {
    static constexpr bool GATHER = GATHER_;
    const volatile LAS unsigned* cnt; const volatile LAS unsigned* tstart; int G, c, K; const char* A; const char* Bt; size_t bstride; const int* list;
    __device__ bool next(int i, pg8::Unit& u) const {
        const int NTt = __builtin_amdgcn_readfirstlane((int)tstart[NE]); const long L = (long)i * G + c; if (L >= (long)NTt * 4) return false;
        const int mtg = (int)(L >> 2); int e = 0;
        while (e < NE - 1 && mtg >= __builtin_amdgcn_readfirstlane((int)tstart[e + 1])) ++e;
        u.pm = mtg; u.pn = (int)(L & 3); u.e = e; u.mt = mtg - __builtin_amdgcn_readfirstlane((int)tstart[e]); return true;
    }
    __device__ __forceinline__ const char* abase() const { return A; }
    __device__ __forceinline__ void aoff(const pg8::Unit& u, const int (&R)[2], const int (&C)[2], unsigned (&ao)[2][2]) const {
        const int cn = (int)cnt[u.e];
#pragma unroll
        for (int h = 0; h < 2; ++h)
#pragma unroll
            for (int i = 0; i < 2; ++i) { const int rank = u.mt * 256 + h * 128 + R[i]; int row = T; if (rank < cn) row = list[u.e * LISTCAP + rank] >> 1;
                ao[h][i] = (unsigned)(((size_t)row * K + C[i]) * 2); }
    }
    __device__ __forceinline__ const char* bbase(const pg8::Unit& u) const { return Bt + (size_t)u.e * bstride + (size_t)u.pn * 256 * K * 2; }
};
__device__ __forceinline__ void moe_setup(volatile LAS unsigned* MISC, const unsigned* counts, const int tid) {
    __syncthreads();
    if (tid < NE) MISC[16 + tid] = __hip_atomic_load(counts + tid, RLX_AGENT);
    __syncthreads();
    if (tid == 0) { unsigned a = 0; for (int e = 0; e < NE; ++e) { MISC[48 + e] = a; MISC[96 + e] = a * 256u; a += (MISC[16 + e] + 255u) >> 8; } MISC[48 + NE] = a; }
    __syncthreads();
}

__global__ void __launch_bounds__(NWAVES * 64, 2) mk_fwd(Args args) {
    extern __shared__ __attribute__((aligned(16))) unsigned char lds_raw[];
    LAS unsigned char* lds = (LAS unsigned char*)lds_raw;
    volatile LAS unsigned* MISC = (volatile LAS unsigned*)(lds + MISC_OFF);
    const int G = gridDim.x; const int bx = blockIdx.x; const int vcu = (G % 8 == 0) ? (bx % 8) * (G / 8) + bx / 8 : bx;
    { gu32* ctl0 = (gu32*)(args.ws + WS_CTL);
      for (int u = threadIdx.x; u < (LDS_BYTES - LDSCTL_OFF) / 4; u += NWAVES * 64) ((LAS unsigned*)(lds + LDSCTL_OFF))[u] = 0u;
      __syncthreads();
      (void)ctl0; }
    XcdBarrier bar; bar.bar = (unsigned*)((gu32*)(args.ws + WS_CTL) + CW_BAR) + args.li * XCD_BAR_WORDS; bar.x = 0; bar.st = nullptr;
    const bool use_bar = (args.ph_hi - args.ph_lo) > 1;
    const int wave_sgpr = __builtin_amdgcn_readfirstlane(threadIdx.x >> 6);
    if (use_bar) bar = xcd_barrier_post((unsigned*)((gu32*)(args.ws + WS_CTL) + CW_BAR) + args.li * XCD_BAR_WORDS, MISC + 8, wave_sgpr);
#ifndef PROBE_DUP
#define PROBE_DUP -1
#endif
#ifdef PROBE_T
#ifndef PROBE_AMP
#define PROBE_AMP 8
#endif
    unsigned long long probe_t0 = __builtin_amdgcn_s_memrealtime(), probe_t1 = probe_t0;
#endif
    for (int pi = args.ph_lo; pi < args.ph_hi; ++pi) {
        const int ph = (PROBE_DUP >= 0 && pi > PROBE_DUP) ? pi - 1 : pi;
        bool did = true; const bool dummy = (PROBE_DUP >= 0 && pi == PROBE_DUP + 1);
        int z32 = 0; asm volatile("" : "+s"(z32));
        int tid = ((wave_sgpr + z32) << 6) | (int)__builtin_amdgcn_mbcnt_hi(~0u, __builtin_amdgcn_mbcnt_lo(~0u, (unsigned)z32)); asm volatile("" : "+v"(tid));
        size_t zoff = 0; asm volatile("" : "+s"(zoff));
        unsigned char* ws = (unsigned char*)(GAS unsigned char*)(*(unsigned char* const __attribute__((address_space(4)))*)((const __attribute__((address_space(4))) char*)__builtin_amdgcn_kernarg_segment_ptr() + zoff + 136));
        const int lane = tid & 63, wave = __builtin_amdgcn_readfirstlane(tid >> 6);
        gu32* ctl = (gu32*)(ws + WS_CTL);
        const __attribute__((address_space(4))) char* ka = (const __attribute__((address_space(4))) char*)__builtin_amdgcn_kernarg_segment_ptr() + zoff;
#define ARG_IN(i) ((const float*)(const GAS float*)(*(const float* const __attribute__((address_space(4)))*)(ka + 8 * (i))))
        const float* x = ARG_IN(0); const float* fox_w_in = ARG_IN(1); const float* fox_b_f = ARG_IN(2); const float* fox_w_out = ARG_IN(3);
        const float* ret_w_in = ARG_IN(4); const float* ret_gn = ARG_IN(5); const float* ret_w_out = ARG_IN(6);
        const float* norm_mix = ARG_IN(7); const float* norm_ffn = ARG_IN(8);
        const float* rg_w = ARG_IN(9); const float* rg_b = ARG_IN(10); const float* re_w = ARG_IN(11); const float* re_b = ARG_IN(12);
        const float* w_gu = ARG_IN(13); const float* w_down = ARG_IN(14); const float* norm_final = ARG_IN(15);
        float* const outp = (float*)(GAS float*)(*(float* const __attribute__((address_space(4)))*)(ka + 128));
        h16* WfoxT = (h16*)(ws + WS_WFOX); h16* WfoT = (h16*)(ws + WS_WFO); h16* WretT = (h16*)(ws + WS_WRET); h16* WroT = (h16*)(ws + WS_WRO); h16* WguT = (h16*)(ws + WS_WGU); h16* WdT = (h16*)(ws + WS_WD);
        h16* RW = (h16*)(ws + WS_RW); h16* FW = (h16*)(ws + WS_FW); float* ctab = (float*)(ws + WS_ROPE); float* stab = ctab + SEQ * 128;
        float* H = (float*)(ws + WS_H); h16* HN = (h16*)(ws + WS_HN); float* RSTD = (float*)(ws + WS_RSTD); float* FLOG = (float*)(ws + WS_FLOG); float* CUM = (float*)(ws + WS_CUM);
        int* EID = (int*)(ws + WS_EID); int* RANK = (int*)(ws + WS_RANK); float* GATE = (float*)(ws + WS_GATE); int* LIST = (int*)(ws + WS_LIST);
        h16* QKVG = (h16*)(ws + WS_QKVG); h16* OG = (h16*)(ws + WS_OG); h16* RO = (h16*)(ws + WS_RO); h16* Y = (h16*)(ws + WS_Y); h16* ACT = (h16*)(ws + WS_ACT);
        unsigned* COUNTS = (unsigned*)(ctl + CW_CNT);
        const int gw = vcu * NWAVES + wave, NGW = G * NWAVES;

        if (ph == 0) {
            LAS float* scr = (LAS float*)(lds + wave * 16640);
            constexpr int I_FOX = 2 * 16 * 64, I_FO = 2 * 16 * 16, I_RET = 2 * 16 * 96, I_RO = 2 * 32 * 16, I_GU = DEPTH * NE * 16 * 16, I_D = DEPTH * NE * 8 * 16;
            constexpr int NITEMS = I_FOX + I_FO + I_RET + I_RO + I_GU + I_D;
            _Pragma("unroll 1") for (int it = gw; it < NITEMS; it += NGW) {
                int r = it;
                if (r < I_FOX) { const int j = r / (16 * 64), q = r % (16 * 64); transpose_item<false>(fox_w_in + (size_t)j * DM * FOX_IN, DM, FOX_IN, WfoxT + (size_t)j * 4096 * 1024, scr, q / 64, q % 64, lane); continue; } r -= I_FOX;
                if (r < I_FO) { const int j = r / 256, q = r % 256; transpose_item<false>(fox_w_out + (size_t)j * DM * DM, DM, DM, WfoT + (size_t)j * 1024 * 1024, scr, q / 16, q % 16, lane); continue; } r -= I_FO;
                if (r < I_RET) { const int j = r / (16 * 96), q = r % (16 * 96); transpose_item<false>(ret_w_in + (size_t)j * DM * RET_IN, DM, RET_IN, WretT + (size_t)j * 6144 * 1024, scr, q / 96, q % 96, lane); continue; } r -= I_RET;
                if (r < I_RO) { const int j = r / 512, q = r % 512; transpose_item<false>(ret_w_out + (size_t)j * 2048 * DM, 2048, DM, WroT + (size_t)j * 1024 * 2048, scr, q / 16, q % 16, lane); continue; } r -= I_RO;
                if (r < I_GU) { const int m = r / 256, q = r % 256; transpose_item<true>(w_gu + (size_t)m * DM * 1024, DM, 1024, WguT + (size_t)m * 1024 * 1024, scr, q / 16, q % 16, lane); continue; } r -= I_GU;
                { const int m = r / 128, q = r % 128; transpose_item<false>(w_down + (size_t)m * EFF * DM, EFF, DM, WdT + (size_t)m * 1024 * 512, scr, q / 16, q % 16, lane); }
            }
            const int gt = vcu * NWAVES * 64 + tid, NGT = G * NWAVES * 64;
            _Pragma("unroll 1") for (int idx = gt; idx < DEPTH * 32 * 64 * 24; idx += NGT) { const int v = idx % 24, ln = (idx / 24) % 64, it = (idx / (24 * 64)) % 32, L = idx / (24 * 64 * 32);
                const int tl = v >> 3, i = v & 7, k = 32 * it + 8 * (ln >> 4) + i, c = ln & 15;
                float val = 0.f; if (tl < 2) val = re_w[((size_t)L * DM + k) * NE + 16 * tl + c]; else if (c < 4) val = rg_w[((size_t)L * DM + k) * NG + c];
                RW[idx] = (h16)val; }
            _Pragma("unroll 1") for (int idx = gt; idx < 2 * 32 * 64 * 8; idx += NGT) { const int i = idx % 8, ln = (idx / 8) % 64, it = (idx / 512) % 32, j = idx / (512 * 32);
                const int k = 32 * it + 8 * (ln >> 4) + i, c = ln & 15; FW[idx] = (h16)fox_w_in[((size_t)j * DM + k) * FOX_IN + 4096 + c]; }
            _Pragma("unroll 1") for (int idx = gt; idx < SEQ * 128; idx += NGT) { const int pos = idx / 128, m = idx % 128;
                float c_, s_; rope_cs(pos, m, c_, s_); ctab[idx] = c_; stab[idx] = s_; }
            _Pragma("unroll 1") for (int idx = gt; idx < DM / 2; idx += NGT) ((unsigned*)(HN + (size_t)T * DM))[idx] = 0u;
        } else if (ph == 1) {
            { RowArgs A{}; A.src = x; A.h = H; A.hn = HN; A.rstd = RSTD; A.gnorm = norm_mix; A.tabh = FW; A.bias0 = fox_b_f; A.flog = FLOG;
                row_pass_all<false, true, 1>(A, vcu, G, wave, lane, lds, nullptr); }
        } else {
            const int L = (ph - 2) / NSUB, sub = (ph - 2) % NSUB, j = L >> 1; const bool fox = (L & 1) == 0;
            if (sub == 0) {
                if (fox) {
                    if (vcu < BATCH * FOX_H) {
                        const int bh = vcu, b = bh / FOX_H, hh = bh % FOX_H; float v[4]; float run = 0.f;
#pragma unroll
                        for (int i = 0; i < 4; ++i) { const float f = FLOG[((size_t)b * SEQ + 4 * tid + i) * 16 + hh]; run += fminf(f, 0.f) - log1pf(__expf(-fabsf(f))); v[i] = run; }
                        float incl = run;
#pragma unroll
                        for (int o = 1; o < 64; o <<= 1) { const float u = shfl_idx(incl, lane >= o ? lane - o : lane); if (lane >= o) incl += u; }
                        LAS float* wt = (LAS float*)lds;
                        if (lane == 63) wt[wave] = incl;
                        __syncthreads();
                        float base = incl - run;
                        for (int w = 0; w < wave; ++w) base += wt[w];
                        f32x4 o4 = {v[0] + base, v[1] + base, v[2] + base, v[3] + base};
                        *(f32x4*)(CUM + (size_t)bh * SEQ + 4 * tid) = o4;
                        __syncthreads();
                    }
                    pg8::StaticOrder S; S.init(HN, WfoxT + (size_t)j * 4096 * 1024, T, 4096, DM, G, bx);
                    pg8::EpiH16 E{QKVG, 1024, 1024, (size_t)T * 1024, RSTD, attn_body::C2, 1.f, 0, nullptr, nullptr};
                    pg8::gemm_phase<pg8::EpiH16, pg8::StaticOrder, true>(lds, DM, S, E, tid);
                } else {
                    pg8::StaticOrder S; S.init(HN, WretT + (size_t)j * 6144 * 1024, T, 6144, DM, G, bx);
                    pg8::EpiH16 E{QKVG, 1024, 1024, (size_t)T * 1024, RSTD, 1.f, 0.0625f, 1, ctab, stab};
                    pg8::gemm_phase<pg8::EpiH16, pg8::StaticOrder, true>(lds, DM, S, E, tid);
                }
            } else if (sub == 1) {
                if (fox) did = false;
                else { _Pragma("unroll 1") for (int item = vcu; item < BATCH * RET_H * (SEQ / 128); item += G) { int tu = tid; asm volatile("" : "+v"(tu));
                        ret_body::s_item(item >> 6, (item >> 4) & 3, item & 15, QKVG, QKVG + (size_t)T * 1024, (u32x4*)OG, tu); } }
            } else if (sub == 2) {
                if (fox) {
                    const h16* Q = QKVG; const h16* K = QKVG + (size_t)T * 1024; const h16* V = QKVG + (size_t)2 * T * 1024; const h16* Gt = QKVG + (size_t)3 * T * 1024;
                    for (int bh = vcu >> 1; bh < BATCH * FOX_H; bh += (G >> 1)) {
                        const int s = vcu & 1;
#pragma unroll 1
                        for (int i = 0; i < 4; ++i) { const int qb = (i == 0) ? s : (i == 1) ? 7 - s : (i == 2) ? 3 - s : 4 + s;
                            int tu = tid; asm volatile("" : "+v"(tu));
                            attn_body::attn_unit<8>(bh / FOX_H, bh % FOX_H, qb, Q, K, V, Gt, CUM, OG, (char*)lds_raw, tu); }
                    }
                } else {
                    for (int item = vcu; item < BATCH * RET_H * 8; item += G) { const int bh = item >> 3, sl = item & 7, b = bh >> 2, hh = bh & 3;
                        const h16* Vb = QKVG + (size_t)(2 + (hh >> 1)) * T * 1024 + (hh & 1) * 512 + sl * 64;
                        ret_body::ret_item(b, hh, sl, QKVG, QKVG + (size_t)T * 1024, Vb, (const u32x4*)OG, RO, lds, tid); }
                }
            } else if (sub == 3) {
                if (fox) did = false;
                else { _Pragma("unroll 1") for (int w = gw; w < T * RET_H; w += NGW) ret_gn_item(RO, QKVG + (size_t)4 * T * 1024, ret_gn + (size_t)j * 2048, OG, w, lane); }
            } else if (sub == 4) {
                const int Kd = fox ? 1024 : 2048;
                pg8::StaticOrder S; S.init(OG, fox ? (const void*)(WfoT + (size_t)j * 1024 * 1024) : (const void*)(WroT + (size_t)j * 1024 * 2048), T, DM, Kd, G, bx);
                pg8::EpiResid E{dummy ? (float*)(ws + WS_DUMMY) : H, DM};
                pg8::gemm_phase<pg8::EpiResid, pg8::StaticOrder, false>(lds, Kd, S, E, tid);
            } else if (sub == 5) {
                { RowArgs A{}; A.src = H; A.h = H; A.hn = HN; A.rstd = RSTD; A.gnorm = norm_ffn + (size_t)L * DM; A.tabh = RW + (size_t)L * 32 * 64 * 24; A.bias0 = rg_b + L * NG; A.bias1 = re_b + L * NE;
                    A.eid = EID; A.rank = RANK; A.gate = GATE; A.counts = COUNTS + L * NE; A.list = LIST;
                    if (dummy) { unsigned char* dz = ws + WS_DUMMY; A.hn = (h16*)(dz + 64 * MiB); A.rstd = (float*)(dz + 100 * MiB); A.eid = (int*)(dz + 101 * MiB); A.rank = (int*)(dz + 102 * MiB); A.gate = (float*)(dz + 103 * MiB); A.list = (int*)(dz + 104 * MiB); A.counts = (unsigned*)(ctl + CW_CNT2); }
                    row_pass_all<false, false, 3>(A, vcu, G, wave, lane, lds, nullptr); }
            } else if (sub == 6) {
                moe_setup(MISC, COUNTS + L * NE, tid);
                MoeOrderT<true> S{MISC + 16, MISC + 48, G, vcu, DM, (const char*)HN, (const char*)(WguT + (size_t)L * NE * 1024 * 1024), SZ_WGU, LIST};
                pg8::EpiSwiGLU E{ACT, RSTD, LIST, (const int*)(COUNTS + L * NE)};
                pg8::gemm_phase<pg8::EpiSwiGLU, MoeOrderT<true>, true>(lds, DM, S, E, tid);
            } else if (sub == 7) {
                moe_setup(MISC, COUNTS + L * NE, tid);
                MoeOrderT<false> S{MISC + 16, MISC + 48, G, vcu, EFF, (const char*)ACT, (const char*)(WdT + (size_t)L * NE * 1024 * 512), SZ_WD, LIST};
                pg8::EpiStoreH16 E{Y, DM};
                pg8::gemm_phase<pg8::EpiStoreH16, MoeOrderT<false>, true>(lds, EFF, S, E, tid);
            } else {
                moe_setup(MISC, COUNTS + L * NE, tid);
                if (L == DEPTH - 1) {
                    _Pragma("unroll 1") for (int t = gw; t < T; t += NGW) final_row(H, Y, EID, RANK, GATE, MISC + 96, norm_final, dummy ? (float*)(ws + WS_DUMMY) : outp, t, lane);
                } else {
                    const bool nfox = ((L + 1) & 1) == 0;
                    RowArgs A{}; A.src = H; A.h = H; A.hn = HN; A.rstd = RSTD; A.gnorm = norm_mix + (size_t)(L + 1) * DM; A.y = Y; A.eidp = EID; A.rankp = RANK; A.gatep = GATE;
                    if (dummy) { unsigned char* dz = ws + WS_DUMMY; A.h = (float*)dz; A.hn = (h16*)(dz + 64 * MiB); A.rstd = (float*)(dz + 100 * MiB); }
                    if (nfox) { A.tabh = FW + (size_t)((L + 1) >> 1) * 32 * 64 * 8; A.bias0 = fox_b_f + ((L + 1) >> 1) * FOX_H; A.flog = dummy ? (float*)(ws + WS_DUMMY + 106 * MiB) : FLOG;
                        row_pass_all<true, true, 1>(A, vcu, G, wave, lane, lds, MISC + 96); }
                    else { row_pass_all<true, true, 0>(A, vcu, G, wave, lane, lds, MISC + 96); }
                }
            }
        }
        if (did && pi + 1 < args.ph_hi) xcd_barrier(bar, tid == 0);
#ifdef PROBE_T
        if (ph == PROBE_T - 1 || (PROBE_T == 0 && pi == args.ph_lo)) { if (PROBE_T == 0) {} else probe_t0 = __builtin_amdgcn_s_memrealtime(); }
        if (ph == PROBE_T) probe_t1 = __builtin_amdgcn_s_memrealtime();
#endif
    }
#if defined(PROBE_A) && defined(PROBE_B)
    if (blockIdx.x == 0 && TID0()) { volatile LAS unsigned* pm_ = (volatile LAS unsigned*)(size_t)(MISC_OFF + 800); const unsigned long long d = (unsigned long long)(pm_[1] - pm_[0]) * (unsigned long long)PROBE_AMP2; const unsigned long long s0 = __builtin_amdgcn_s_memrealtime();
        while (__builtin_amdgcn_s_memrealtime() - s0 < d) __builtin_amdgcn_s_sleep(8); }
#endif
#ifdef PROBE_T
    if (blockIdx.x == 0 && TID0()) { const unsigned long long d = (probe_t1 - probe_t0) * PROBE_AMP; const unsigned long long s0 = __builtin_amdgcn_s_memrealtime();
        while (__builtin_amdgcn_s_memrealtime() - s0 < d) __builtin_amdgcn_s_sleep(8); }
#endif
}

extern "C" void kernel_launch(void* const* d_in, const int* in_sizes, int n_in, void* d_out, int out_size, void* d_ws, size_t ws_size, hipStream_t stream) {
    static int grid = 0;
    if (grid == 0) {
        if (n_in != 16 || out_size != T * DM || ws_size < WS_END) { fprintf(stderr, "kernel_launch: unexpected problem (n_in %d out %d ws %zu need %zu)\n", n_in, out_size, ws_size, (size_t)WS_END); grid = -1; return; }
        int dev = 0, cus = 0;
        if (hipGetDevice(&dev) != hipSuccess || hipDeviceGetAttribute(&cus, hipDeviceAttributeMultiprocessorCount, dev) != hipSuccess) { grid = -1; return; }
        if (hipFuncSetAttribute((const void*)mk_fwd, hipFuncAttributeMaxDynamicSharedMemorySize, LDS_BYTES) != hipSuccess) { fprintf(stderr, "kernel_launch: hipFuncSetAttribute failed\n"); grid = -1; return; }
        (void)hipGetLastError();
        grid = cus;
    }
    if (grid < 0) return;
    if (hipMemsetAsync((char*)d_ws + WS_CTL, 0, CTL_ZERO_BYTES, stream) != hipSuccess) return;
    Args a{};
    for (int i = 0; i < 16; ++i) a.in[i] = (const float*)d_in[i];
    a.out = (float*)d_out; a.ws = (unsigned char*)d_ws;
#if MK_N_LAUNCHES == 1
    a.ph_lo = 0; a.ph_hi = NPHASE + (PROBE_DUP >= 0 ? 1 : 0); a.li = 0;
    hipLaunchKernelGGL(mk_fwd, dim3(grid), dim3(NWAVES * 64), LDS_BYTES, stream, a);
#else
    for (int p = 0; p < NPHASE; ++p) {
        if (p >= 2 && ((((p - 2) % NSUB) == 1) || (((p - 2) % NSUB) == 3)) && ((((p - 2) / NSUB) & 1) == 0)) continue;
        a.ph_lo = p; a.ph_hi = p + 1; a.li = 0;
        hipLaunchKernelGGL(mk_fwd, dim3(grid), dim3(NWAVES * 64), LDS_BYTES, stream, a);
    }
#endif
}
```
